# Optimizing an MI355X kernel written in HIP

```python
import jax
import jax.numpy as jnp
from jax import lax
import numpy as np

D_MODEL = 2048
BATCH = 4
SEQ = 4096
DEPTH = 4

CHUNK = 64
HEAD_DIM = 128
N_MIX_HEADS = D_MODEL // HEAD_DIM
FOX_HEADS = N_MIX_HEADS // 2
RET_HEADS = N_MIX_HEADS // 4
GMLP_GROUPS = N_MIX_HEADS - FOX_HEADS - RET_HEADS
FOX_W = FOX_HEADS * HEAD_DIM
RET_W = RET_HEADS * HEAD_DIM
GMLP_W = GMLP_GROUPS * HEAD_DIM
MIX_W = FOX_W + RET_W + GMLP_W
IN_SPLIT_SIZES = (FOX_W, FOX_W, FOX_W, FOX_HEADS, RET_W, RET_W, RET_W, RET_W, GMLP_W, GMLP_W)
IN_COLS = sum(IN_SPLIT_SIZES)
FOX_Q_BLOCK = 128
GMLP_CHUNK = 128
D_FF = ((8 * D_MODEL // 3 + 255) // 256) * 256
ROPE_BASE = 10000.0
RET_GAMMA_BASE = 5.0
EPS = 1e-6

kernel_name = "hybrid_fox_retention_gmlp_macaron"


def rmsnorm(x, g):
    x32 = x.astype(jnp.float32)
    y = x32 * lax.rsqrt(jnp.mean(x32 * x32, axis=-1, keepdims=True) + EPS)
    return (y * g.astype(jnp.float32)).astype(x.dtype)


def swiglu(h, w_gate, w_up, w_down):
    return (jax.nn.silu(h @ w_gate) * (h @ w_up)) @ w_down


def rope(x, pos):
    half = x.shape[-1] // 2
    inv_freq = ROPE_BASE ** (-jnp.arange(half, dtype=jnp.float32) / half)
    ang = pos[:, None] * inv_freq[None, :]
    cos = jnp.cos(ang)[None, :, None, :]
    sin = jnp.sin(ang)[None, :, None, :]
    x1, x2 = x[..., :half], x[..., half:]
    return jnp.concatenate([x1 * cos - x2 * sin, x1 * sin + x2 * cos], axis=-1)


def forgetting_attention(q, k, v, log_f):
    S = q.shape[1]
    scale = q.shape[-1] ** -0.5
    c = jnp.transpose(jnp.cumsum(log_f, axis=1), (0, 2, 1))
    outs = []
    for i in range(S // FOX_Q_BLOCK):
        q0, q1 = i * FOX_Q_BLOCK, (i + 1) * FOX_Q_BLOCK
        s = jnp.einsum("bqhd,bkhd->bhqk", q[:, q0:q1], k[:, :q1]) * scale
        s = s + c[:, :, q0:q1, None] - c[:, :, None, :q1]
        causal = jnp.arange(q0, q1)[:, None] >= jnp.arange(q1)[None, :]
        s = jnp.where(causal[None, None], s, -jnp.inf)
        p = jax.nn.softmax(s, axis=-1)
        outs.append(jnp.einsum("bhqk,bkhd->bqhd", p, v[:, :q1]))
    return jnp.concatenate(outs, axis=1)


def retention(q, k, v):
    B, S, H, D = q.shape
    N = S // CHUNK
    log_g = jnp.log1p(-jnp.exp2(-(RET_GAMMA_BASE + jnp.arange(H, dtype=jnp.float32))))
    k = k * (D ** -0.5)
    qc = q.reshape(B, N, CHUNK, H, D)
    kc = k.reshape(B, N, CHUNK, H, D)
    vc = v.reshape(B, N, CHUNK, H, D)
    idx = jnp.arange(CHUNK, dtype=jnp.float32)
    diff = idx[:, None] - idx[None, :]
    decay_mask = jnp.where(diff[None] >= 0, jnp.exp(jnp.maximum(diff, 0.0)[None] * log_g[:, None, None]), 0.0)
    scores = jnp.einsum("bnchd,bnshd->bnhcs", qc, kc) * decay_mask[None, None]
    o_inner = jnp.einsum("bnhcs,bnshe->bnche", scores, vc)
    zeta = jnp.exp((CHUNK - 1 - idx)[:, None] * log_g[None, :])
    kv = jnp.einsum("bnshd,bnshe->nbhde", kc * zeta[None, None, :, :, None], vc)
    chunk_decay = jnp.exp(CHUNK * log_g)[None, :, None, None]

    def step(state, kv_n):
        return state * chunk_decay + kv_n, state

    _, state_prev = lax.scan(step, jnp.zeros((B, H, D, D), jnp.float32), kv)
    xi = jnp.exp((idx + 1.0)[:, None] * log_g[None, :])
    o_cross = jnp.einsum("bnchd,nbhde->bnche", qc, state_prev) * xi[None, None, :, :, None]
    return (o_inner + o_cross).reshape(B, S, H, D)


def chunk_gmlp(u, v, ln_g, ln_b, w_s, b_s):
    B, S, G, Dg = v.shape
    mu = jnp.mean(v, axis=-1, keepdims=True)
    var = jnp.mean(jnp.square(v - mu), axis=-1, keepdims=True)
    v = (v - mu) * lax.rsqrt(var + EPS) * ln_g.reshape(G, Dg) + ln_b.reshape(G, Dg)
    v = v.reshape(B, S // GMLP_CHUNK, GMLP_CHUNK, G, Dg)
    tril = jnp.tril(jnp.ones((GMLP_CHUNK, GMLP_CHUNK), jnp.float32))
    v_mix = jnp.einsum("gts,bnsgc->bntgc", w_s * tril[None], v) + jnp.transpose(b_s)[None, None, :, :, None]
    return u * v_mix.reshape(B, S, G, Dg)


def hybrid_mixer(h, w_in, fox_b_f, gmlp_ln_g, gmlp_ln_b, gmlp_w_s, gmlp_b_s, out_norm, w_out):
    B, S, _ = h.shape
    f32 = jnp.float32
    proj = (h @ w_in).astype(f32)
    splits = np.cumsum(IN_SPLIT_SIZES)[:-1].tolist()
    fq, fk, fv, fz, rq, rk, rv, rg, gu, gv = jnp.split(proj, splits, axis=-1)

    def heads(t):
        return t.reshape(B, S, -1, HEAD_DIM)

    log_f = jax.nn.log_sigmoid(fz + fox_b_f.astype(f32))
    y_a = forgetting_attention(heads(fq), heads(fk), heads(fv), log_f)
    pos = jnp.arange(S, dtype=f32)
    y_b = retention(rope(heads(rq), pos), rope(heads(rk), pos), heads(rv))
    y_c = chunk_gmlp(heads(jax.nn.gelu(gu)), heads(jax.nn.gelu(gv)), gmlp_ln_g.astype(f32),
                     gmlp_ln_b.astype(f32), gmlp_w_s.astype(f32), gmlp_b_s.astype(f32))
    y = jnp.concatenate([y_a, y_b, y_c], axis=2)
    y = y * lax.rsqrt(jnp.mean(y * y, axis=-1, keepdims=True) + EPS) * out_norm.astype(f32).reshape(N_MIX_HEADS, HEAD_DIM)
    y_a, y_b, y_c = jnp.split(y, [FOX_HEADS, FOX_HEADS + RET_HEADS], axis=2)
    y = jnp.concatenate([y_a, y_b * jax.nn.silu(heads(rg)), y_c], axis=2).reshape(B, S, MIX_W)
    return y.astype(h.dtype) @ w_out


def setup_inputs(seed: int = 0) -> dict:
    key = jax.random.key(seed)
    ks = jax.random.split(key, 20)
    f32 = jnp.float32

    def nrm(k, shape, fan_in):
        return jax.random.normal(k, shape, f32) * (fan_in ** -0.5)

    def gain(k, shape):
        return 1.0 + 0.02 * jax.random.normal(k, shape, f32)

    return {
        "x": jax.random.normal(ks[0], (BATCH, SEQ, D_MODEL), f32),
        "ffn1_norm": gain(ks[1], (DEPTH, D_MODEL)),
        "ffn1_w_gate": nrm(ks[2], (DEPTH, D_MODEL, D_FF), D_MODEL),
        "ffn1_w_up": nrm(ks[3], (DEPTH, D_MODEL, D_FF), D_MODEL),
        "ffn1_w_down": nrm(ks[4], (DEPTH, D_FF, D_MODEL), D_FF),
        "mix_norm": gain(ks[5], (DEPTH, D_MODEL)),
        "w_in": nrm(ks[6], (DEPTH, D_MODEL, IN_COLS), D_MODEL),
        "fox_b_f": jax.random.uniform(ks[7], (DEPTH, FOX_HEADS), f32, 1.0, 5.0),
        "gmlp_ln_g": gain(ks[8], (DEPTH, GMLP_W)),
        "gmlp_ln_b": 0.02 * jax.random.normal(ks[9], (DEPTH, GMLP_W), f32),
        "gmlp_w_s": nrm(ks[10], (DEPTH, GMLP_GROUPS, GMLP_CHUNK, GMLP_CHUNK), GMLP_CHUNK),
        "gmlp_b_s": 1.0 + 0.1 * jax.random.normal(ks[11], (DEPTH, GMLP_GROUPS, GMLP_CHUNK), f32),
        "out_norm": gain(ks[12], (DEPTH, MIX_W)),
        "w_out": nrm(ks[13], (DEPTH, MIX_W, D_MODEL), MIX_W),
        "ffn2_norm": gain(ks[14], (DEPTH, D_MODEL)),
        "ffn2_w_gate": nrm(ks[15], (DEPTH, D_MODEL, D_FF), D_MODEL),
        "ffn2_w_up": nrm(ks[16], (DEPTH, D_MODEL, D_FF), D_MODEL),
        "ffn2_w_down": nrm(ks[17], (DEPTH, D_FF, D_MODEL), D_FF),
        "final_norm": gain(ks[18], (D_MODEL,)),
    }


def reference(x, ffn1_norm, ffn1_w_gate, ffn1_w_up, ffn1_w_down, mix_norm, w_in, fox_b_f,
              gmlp_ln_g, gmlp_ln_b, gmlp_w_s, gmlp_b_s, out_norm, w_out, ffn2_norm,
              ffn2_w_gate, ffn2_w_up, ffn2_w_down, final_norm):
    for l in range(DEPTH):
        x = x + 0.5 * swiglu(rmsnorm(x, ffn1_norm[l]), ffn1_w_gate[l], ffn1_w_up[l], ffn1_w_down[l])
        x = x + hybrid_mixer(rmsnorm(x, mix_norm[l]), w_in[l], fox_b_f[l], gmlp_ln_g[l], gmlp_ln_b[l],
                             gmlp_w_s[l], gmlp_b_s[l], out_norm[l], w_out[l])
        x = x + 0.5 * swiglu(rmsnorm(x, ffn2_norm[l]), ffn2_w_gate[l], ffn2_w_up[l], ffn2_w_down[l])
    return rmsnorm(x, final_norm)
```

```cpp
#include <hip/hip_runtime.h>
#include <cstdio>
#include <cstdint>

#ifndef MK_SPLIT
#define MK_SPLIT 0
#endif

#ifndef PROBE_MASK
#define PROBE_MASK 0u
#endif
#ifndef NAIVE_MASK
#define NAIVE_MASK 0
#endif
#ifndef PROBE_REP
#define PROBE_REP 1
#endif
#define LAS __attribute__((address_space(3)))
#define GAS __attribute__((address_space(1)))
typedef unsigned short bf16_t;
typedef short bf16x8 __attribute__((ext_vector_type(8)));
typedef float f32x4 __attribute__((ext_vector_type(4)));
typedef float f32x2 __attribute__((ext_vector_type(2)));
typedef unsigned u32x4 __attribute__((ext_vector_type(4)));
typedef unsigned u32x2 __attribute__((ext_vector_type(2)));

constexpr int DM = 2048, NB = 4, SEQ = 4096, DEPTH = 4, MROWS = NB * SEQ, DFF = 5632, HD = 128;
constexpr int FOXH = 8, RETH = 4, GMG = 4;
constexpr int INCOLS = 6152, NWIN = 6144, NGU = 2 * DFF;
constexpr int FZ_COL = 3072;
constexpr float EPS = 1e-6f;
constexpr int NWAVES = 8, NTHREADS = 512;

constexpr size_t MiB = 1u << 20;
constexpr size_t WS_CTL = 0, CTL_ZERO_BYTES = 1 * MiB;
constexpr size_t WS_SSQ = 1 * MiB;
constexpr size_t WS_ROPE = 3 * MiB;
constexpr size_t WS_LOGF = 5 * MiB;
constexpr size_t WS_CUM = 5 * MiB + 512 * 1024;
constexpr size_t WS_WFZ = 6 * MiB;
constexpr size_t WS_WGU = 8 * MiB;
constexpr size_t SZ_WGU = (size_t)NGU * DM * 2;
constexpr size_t WS_WD = WS_WGU + 8 * SZ_WGU;
constexpr size_t SZ_WD = (size_t)DM * DFF * 2;
constexpr size_t WS_WIN = WS_WD + 8 * SZ_WD;
constexpr size_t SZ_WIN = (size_t)NWIN * DM * 2;
constexpr size_t WS_WOUT = WS_WIN + 4 * SZ_WIN;
constexpr size_t SZ_WOUT = (size_t)DM * DM * 2;
constexpr size_t WS_XB = WS_WOUT + 4 * SZ_WOUT;
constexpr size_t WS_ACT = WS_XB + (size_t)MROWS * DM * 2;
constexpr size_t WS_HID = WS_ACT;
constexpr size_t SZ_FOX = (size_t)NB * FOXH * SEQ * HD * 2;
constexpr size_t SZ_R = (size_t)NB * RETH * SEQ * HD * 2;
constexpr size_t WS_FQ = WS_ACT, WS_FK = WS_FQ + SZ_FOX, WS_FV = WS_FK + SZ_FOX;
constexpr size_t WS_RQ = WS_FV + SZ_FOX, WS_RK = WS_RQ + SZ_R, WS_RV = WS_RK + SZ_R, WS_RG = WS_RV + SZ_R;
constexpr size_t WS_GU = WS_RG + SZ_R, WS_GV = WS_GU + SZ_R;
constexpr size_t WS_Y = WS_GV + SZ_R;
constexpr size_t WS_RKV = WS_Y + (size_t)MROWS * DM * 2;
constexpr size_t SZ_RKV = (size_t)16 * 64 * 128 * 128 * 4;
constexpr size_t WS_RSP = WS_RKV + SZ_RKV;
constexpr size_t WS_END = WS_RSP + SZ_RKV;
static_assert(WS_WGU >= WS_WFZ + (size_t)DEPTH * 8 * DM * 4, "ws map");
static_assert(WS_Y + (size_t)MROWS * DM * 2 >= WS_HID + (size_t)MROWS * DFF * 2, "hid overlay fits");

constexpr int CW_BAR = 4096;

constexpr int RING_BYTES = 131072;
constexpr int LDSCTL_OFF = RING_BYTES, MISC_OFF = LDSCTL_OFF + 320;
constexpr int LDS_BYTES = 147456;
constexpr int RSL_OFF = LDSCTL_OFF + 1024;

__device__ __forceinline__ float bf2f(unsigned h) { return __uint_as_float(h << 16); }
__device__ __forceinline__ unsigned f2bf(float f) { unsigned u = __float_as_uint(f); return (u + 0x7fffu + ((u >> 16) & 1u)) >> 16; }
__device__ __forceinline__ unsigned pk2(float lo, float hi) { return f2bf(lo) | (f2bf(hi) << 16); }
__device__ __forceinline__ unsigned cvt_pk_bf16(float lo, float hi) { unsigned r; asm volatile("v_cvt_pk_bf16_f32 %0, %1, %2" : "=v"(r) : "v"(lo), "v"(hi)); return r; }
__device__ __forceinline__ float wave_sum(float v) {
#pragma unroll
    for (int o = 1; o < 64; o <<= 1) v += __shfl_xor(v, o);
    return v;
}
__device__ __forceinline__ float silu_f(float x) { return x * __builtin_amdgcn_rcpf(1.0f + __builtin_amdgcn_exp2f(-1.4426950408889634f * x)); }
__device__ __forceinline__ float gelu_tanh_f(float x) { const float u = (2.0f * 1.4426950408889634f * 0.7978845608028654f) * (x + 0.044715f * x * x * x); return x * __builtin_amdgcn_rcpf(1.0f + __builtin_amdgcn_exp2f(-u)); }
__device__ __forceinline__ float logsig_f(float z) { return fminf(z, 0.f) - log1pf(__expf(-fabsf(z))); }
__device__ __forceinline__ void unpack8(const u32x4 w, float* f) {
    f[0] = __uint_as_float(w.x << 16); f[1] = __uint_as_float(w.x & 0xffff0000u);
    f[2] = __uint_as_float(w.y << 16); f[3] = __uint_as_float(w.y & 0xffff0000u);
    f[4] = __uint_as_float(w.z << 16); f[5] = __uint_as_float(w.z & 0xffff0000u);
    f[6] = __uint_as_float(w.w << 16); f[7] = __uint_as_float(w.w & 0xffff0000u);
}
#define LDS_WAIT() asm volatile("s_waitcnt lgkmcnt(0)" ::: "memory")
#define VM_WAIT() asm volatile("s_waitcnt vmcnt(0)" ::: "memory")

#define XB_TMO      128
#define XB_XCNT(j)  (256  + 64 * (j))
#define XB_XSUB(j)  (1280 + 64 * (j))
#define XB_XGEN(j)  (2304 + 64 * (j))
#define XB_TOP      3328
#define XB_TOPGEN   3392
#define XCD_BAR_WORDS 3456
#define XB_SPIN_CAP (1u << 22)
__device__ __forceinline__ unsigned xb_ld(unsigned* p)              { return __hip_atomic_load(p, __ATOMIC_RELAXED, __HIP_MEMORY_SCOPE_AGENT); }
__device__ __forceinline__ unsigned xb_add(unsigned* p, unsigned v) { return __hip_atomic_fetch_add(p, v, __ATOMIC_RELAXED, __HIP_MEMORY_SCOPE_AGENT); }
__device__ __forceinline__ unsigned xb_xcc_id() { return (unsigned)__builtin_amdgcn_s_getreg((3 << 11) | 20) & 0xFu; }
#define XB_SPIN(cond, bar) do { unsigned _sp = 0; while (cond) { __builtin_amdgcn_s_sleep(1); \
    if ((++_sp & 255u) == 0u) { if (xb_ld(&(bar)[XB_TMO])) break; if (_sp > XB_SPIN_CAP) { atomicAdd(&(bar)[XB_TMO], 1u); break; } } } } while (0)
struct XcdBarrier { unsigned* bar; unsigned x; volatile LAS unsigned* st; };
__device__ __forceinline__ XcdBarrier xcd_barrier_post(unsigned* bar, volatile LAS unsigned* st) {
    XcdBarrier b; b.bar = bar; b.x = xb_xcc_id(); b.st = st;
    if (threadIdx.x == 0) (void)xb_add(&bar[XB_XCNT(b.x)], 1u);
    return b;
}
__device__ __forceinline__ void xcd_barrier_complete(unsigned* bar, unsigned x, unsigned& nloc, unsigned& nx) {
    const unsigned G = gridDim.x * gridDim.y * gridDim.z;
    unsigned sum, cnt, mine, sp = 0u;
    for (;;) {
        sum = 0u; cnt = 0u; mine = 0u;
#pragma unroll
        for (unsigned j = 0; j < 16; ++j) { const unsigned c = xb_ld(&bar[XB_XCNT(j)]); sum += c; cnt += (c > 0u) ? 1u : 0u; mine = (j == x) ? c : mine; }
        if (sum == G) break;
        __builtin_amdgcn_s_sleep(1);
        if ((++sp & 255u) == 0u) { if (xb_ld(&bar[XB_TMO])) break; if (sp > XB_SPIN_CAP) { atomicAdd(&bar[XB_TMO], 1u); break; } }
    }
    nloc = mine > 0u ? mine : 1u; nx = cnt > 0u ? cnt : 1u;
}
__device__ __forceinline__ void xcd_barrier(const XcdBarrier& b) {
    asm volatile("s_waitcnt vmcnt(0)" ::: "memory");
    __syncthreads();
    if (threadIdx.x == 0) {
        unsigned long long zb_ = 0ull; asm volatile("" : "+s"(zb_));
        unsigned* bar = b.bar + zb_; unsigned bx = b.x; asm volatile("" : "+s"(bx));
        __builtin_amdgcn_s_waitcnt(0);
        unsigned nloc = b.st[0], nx = b.st[1];
        if (nloc == 0u) { xcd_barrier_complete(bar, bx, nloc, nx); b.st[0] = nloc; b.st[1] = nx; }
        const unsigned old = xb_add(&bar[XB_XSUB(bx)], 1u);
        const unsigned gen = old / nloc;
        if (old + 1u == (gen + 1u) * nloc) {
            __builtin_amdgcn_fence(__ATOMIC_RELEASE, "agent");
            asm volatile("s_waitcnt vmcnt(0)" ::: "memory");
            const unsigned og = xb_add(&bar[XB_TOP], 1u);
            const unsigned tg = og / nx;
            if (og + 1u == (tg + 1u) * nx) xb_add(&bar[XB_TOPGEN], 1u);
            else XB_SPIN(xb_ld(&bar[XB_TOPGEN]) == tg, bar);
            __builtin_amdgcn_fence(__ATOMIC_ACQUIRE, "agent");
            xb_add(&bar[XB_XGEN(bx)], 1u);
            asm volatile("s_waitcnt vmcnt(0)" ::: "memory");
        } else {
            XB_SPIN(xb_ld(&bar[XB_XGEN(bx)]) == gen, bar);
            __builtin_amdgcn_fence(__ATOMIC_ACQUIRE, "agent");
            asm volatile("s_waitcnt vmcnt(0)" ::: "memory");
        }
    }
    __syncthreads();
}

namespace pg8 {
#define PG8_LAS __attribute__((address_space(3)))
constexpr int BM = 256, BK = 64, HALF = 128, HTB = HALF * BK * 2, STAGE_BYTES = 8 * HTB, NXCD = 8, WGM = 8;
__host__ __device__ __forceinline__ int lds_byte(int r, int c) { const int st = (r >> 4) * 2 + (c >> 5), rr = r & 15, cc = c & 31, ob = rr * 64 + cc * 2; return st * 1024 + (ob ^ (((ob >> 9) & 1) << 5)); }
__host__ __device__ __forceinline__ void stage_rc(int b, int& R, int& C) { const int st = b / 1024, sb = b % 1024, swz = sb ^ (((sb >> 9) & 1) << 5); R = (st >> 1) * 16 + swz / 64; C = (st & 1) * 32 + (swz % 64) / 2; }
__host__ __device__ __forceinline__ int perm32(int rho) { const int n = rho >> 4, i = rho & 15; return 8 * (i >> 2) + 4 * n + (i & 3); }
struct Unit { int pm, pn; };
struct Gemm { const bf16_t* A; const bf16_t* Bt; int M, N, K; };
struct StaticOrder {
    int nM, nN, nwg, G, c;
    __host__ __device__ void init(int M, int N, int G_, int c_) { nM = M / BM; nN = N / BM; nwg = nM * nN; G = G_; c = c_; }
    __host__ __device__ bool next(int i, Unit& u) const {
        const long L = (long)i * G + c; if (L >= nwg) return false;
        int wgid = (int)L; { const int q = nwg / NXCD, r = nwg % NXCD, xcd = wgid % NXCD, off = wgid / NXCD; wgid = (xcd < r ? xcd * (q + 1) : r * (q + 1) + (xcd - r) * q) + off; }
        const int nig = WGM * nN, gid = wgid / nig, fm = gid * WGM, gsz = (nM - fm) < WGM ? (nM - fm) : WGM;
        u.pm = fm + ((wgid % nig) % gsz); u.pn = (wgid % nig) / gsz; return true;
    }
    __device__ __forceinline__ void a_ready(const Unit&) const {}
    __device__ __forceinline__ void done(const Unit&) const {}
};
template <class Epi, class Sched, bool ALIGN_EPI = false, bool SP2 = false>
__device__ __forceinline__ void gemm_phase(PG8_LAS unsigned char* lds, const Gemm g, const Sched& S, Epi& E, const int tid) {
    const int wid = __builtin_amdgcn_readfirstlane(tid >> 6), lane = tid & 63, wr = wid >> 2, wc = wid & 3, fr = lane & 15, fq = lane >> 4;
    const int K = g.K, nt = K / BK;
    unsigned voffA[2], voffB[2];
#pragma unroll
    for (int i = 0; i < 2; ++i) { int R, C; stage_rc(tid * 16 + i * 8192, R, C); const int Rb = Epi::PERM ? ((R & ~31) + perm32(R & 31)) : R;
        voffA[i] = (unsigned)(R * K + C) * 2u; voffB[i] = (unsigned)(Rb * K + C) * 2u; }
    const size_t kstep = (size_t)(BK * 2);
    const size_t hstep = (size_t)HALF * K * 2;
    const size_t tstep = 2 * hstep;
    const unsigned ldsw = (unsigned)wid * 1024u;
    const int aoff = lds_byte(wr * 64 + fr, fq * 8), boff = lds_byte(wc * 32 + fr, fq * 8);
#define PG8_SA(b, h) (((b) * 2 + (h)) * HTB)
#define PG8_SB(b, h) ((4 + (b) * 2 + (h)) * HTB)
#define PG8_STAGE(bufoff, gbase, voff) do { _Pragma("unroll") for (int _i = 0; _i < 2; ++_i) \
        __builtin_amdgcn_global_load_lds((const unsigned*)((const char*)(gbase) + (voff)[_i]), (PG8_LAS unsigned*)(lds + (bufoff) + ldsw + _i * 8192), 16, 0, 0); } while (0)
#define PG8_LDA(dst, b, h) do { _Pragma("unroll") for (int m = 0; m < 4; ++m) _Pragma("unroll") for (int k = 0; k < 2; ++k) dst[m][k] = *(const PG8_LAS bf16x8*)(lds + PG8_SA(b, h) + aoff + m * 2048 + k * 1024); } while (0)
#define PG8_LDB(dst, b, h) do { _Pragma("unroll") for (int n = 0; n < 2; ++n) _Pragma("unroll") for (int k = 0; k < 2; ++k) dst[n][k] = *(const PG8_LAS bf16x8*)(lds + PG8_SB(b, h) + boff + n * 2048 + k * 1024); } while (0)
#define PG8_MMA(ai, bj, At, Bt) do { __builtin_amdgcn_s_setprio(1); _Pragma("unroll") for (int m = 0; m < 4; ++m) _Pragma("unroll") for (int n = 0; n < 2; ++n) _Pragma("unroll") for (int k = 0; k < 2; ++k) \
        acc[ai][bj][m][n] = __builtin_amdgcn_mfma_f32_16x16x32_bf16(Bt[n][k], At[m][k], acc[ai][bj][m][n], 0, 0, 0); __builtin_amdgcn_s_setprio(0); } while (0)
#define PG8_WAIT_V(n) asm volatile("s_waitcnt vmcnt(" #n ")" ::: "memory")
#define PG8_WAIT_L(n) asm volatile("s_waitcnt lgkmcnt(" #n ")" ::: "memory")
#define PG8_BAR __builtin_amdgcn_s_barrier()
#define PG8_SCHED __builtin_amdgcn_sched_barrier(0)
    Unit cur, nxt; int ui = 0;
    if (!S.next(0, cur)) return;
    f32x4 acc[2][2][4][2];
#pragma unroll
    for (int a = 0; a < 2; ++a)
#pragma unroll
        for (int b = 0; b < 2; ++b)
#pragma unroll
            for (int m = 0; m < 4; ++m)
#pragma unroll
                for (int n = 0; n < 2; ++n) acc[a][b][m][n] = (f32x4){0.f, 0.f, 0.f, 0.f};
    bf16x8 At[4][2], B0[2][2], B1[2][2];
    const char* cA = (const char*)g.A + (size_t)cur.pm * tstep; const char* cB = (const char*)g.Bt + (size_t)cur.pn * tstep;
    S.a_ready(cur);
    if constexpr (SP2) {
        PG8_STAGE(PG8_SB(0, 0), cB, voffB); PG8_STAGE(PG8_SB(0, 1), cB + hstep, voffB); PG8_STAGE(PG8_SA(0, 0), cA, voffA); PG8_STAGE(PG8_SA(0, 1), cA + hstep, voffA);
        if (wr == 1) PG8_BAR;
        PG8_WAIT_V(2); PG8_BAR;
        PG8_STAGE(PG8_SB(1, 0), cB + kstep, voffB); PG8_STAGE(PG8_SA(1, 0), cA + kstep, voffA); PG8_STAGE(PG8_SB(1, 1), cB + hstep + kstep, voffB);
        PG8_WAIT_V(6); PG8_BAR;
    } else {
        PG8_STAGE(PG8_SB(0, 0), cB, voffB); PG8_STAGE(PG8_SA(0, 0), cA, voffA); PG8_STAGE(PG8_SB(0, 1), cB + hstep, voffB); PG8_STAGE(PG8_SA(0, 1), cA + hstep, voffA);
        if (wr == 1) PG8_BAR;
        PG8_WAIT_V(4); PG8_BAR;
        PG8_STAGE(PG8_SB(1, 0), cB + kstep, voffB); PG8_STAGE(PG8_SA(1, 0), cA + kstep, voffA); PG8_STAGE(PG8_SB(1, 1), cB + hstep + kstep, voffB);
        PG8_WAIT_V(6); PG8_BAR;
    }
    for (;;) {
        const bool has_next = S.next(ui + 1, nxt);
        const char* nA = has_next ? (const char*)g.A + (size_t)nxt.pm * tstep : cA; const char* nB = has_next ? (const char*)g.Bt + (size_t)nxt.pn * tstep : cB;
        for (int t = 0; t < nt; t += 2) {
            const bool last = (t == nt - 2);
            const char* a1 = cA + (size_t)(t + 1) * kstep;
            const char* a2 = last ? nA : cA + (size_t)(t + 2) * kstep; const char* b2 = last ? nB : cB + (size_t)(t + 2) * kstep;
            const char* a3 = a2 + kstep; const char* b3 = b2 + kstep;
            if (last && has_next) S.a_ready(nxt);
            if constexpr (SP2) {
            PG8_LDB(B0, 0, 0); PG8_LDB(B1, 0, 1); PG8_SCHED; PG8_LDA(At, 0, 0); PG8_STAGE(PG8_SA(1, 1), a1 + hstep, voffA);
            PG8_WAIT_V(8); PG8_WAIT_L(0); PG8_BAR; PG8_MMA(0, 0, At, B0); PG8_MMA(0, 1, At, B1); PG8_BAR; PG8_SCHED;
            PG8_LDA(At, 0, 1); PG8_STAGE(PG8_SB(0, 0), b2, voffB); PG8_STAGE(PG8_SB(0, 1), b2 + hstep, voffB); PG8_STAGE(PG8_SA(0, 0), a2, voffA);
            PG8_WAIT_V(8); PG8_WAIT_L(0); PG8_BAR; PG8_MMA(1, 0, At, B0); PG8_MMA(1, 1, At, B1); PG8_BAR; PG8_SCHED;
            PG8_LDB(B0, 1, 0); PG8_LDB(B1, 1, 1); PG8_SCHED; PG8_LDA(At, 1, 0); PG8_STAGE(PG8_SA(0, 1), a2 + hstep, voffA);
            PG8_WAIT_V(8); PG8_WAIT_L(0); PG8_BAR; PG8_MMA(0, 0, At, B0); PG8_MMA(0, 1, At, B1); PG8_BAR; PG8_SCHED;
            PG8_LDA(At, 1, 1); PG8_STAGE(PG8_SB(1, 0), b3, voffB); PG8_STAGE(PG8_SB(1, 1), b3 + hstep, voffB); PG8_STAGE(PG8_SA(1, 0), a3, voffA);
            PG8_WAIT_V(8); PG8_WAIT_L(0); PG8_BAR; PG8_MMA(1, 0, At, B0); PG8_MMA(1, 1, At, B1); PG8_BAR; PG8_SCHED;
            } else {
            PG8_LDB(B0, 0, 0); PG8_SCHED; PG8_LDA(At, 0, 0); PG8_STAGE(PG8_SA(1, 1), a1 + hstep, voffA);
            PG8_WAIT_L(8); PG8_BAR; PG8_WAIT_L(0); PG8_MMA(0, 0, At, B0); PG8_BAR; PG8_SCHED;
            PG8_LDB(B1, 0, 1); PG8_STAGE(PG8_SB(0, 0), b2, voffB);
            PG8_BAR; PG8_WAIT_L(0); PG8_MMA(0, 1, At, B1); PG8_BAR;
            PG8_LDA(At, 0, 1); PG8_STAGE(PG8_SA(0, 0), a2, voffA);
            PG8_BAR; PG8_WAIT_L(0); PG8_MMA(1, 0, At, B0); PG8_BAR; PG8_SCHED;
            PG8_STAGE(PG8_SB(0, 1), b2 + hstep, voffB);
            PG8_WAIT_V(6); PG8_BAR; PG8_MMA(1, 1, At, B1); PG8_BAR;
            PG8_LDB(B0, 1, 0); PG8_SCHED; PG8_LDA(At, 1, 0); PG8_STAGE(PG8_SA(0, 1), a2 + hstep, voffA);
            PG8_WAIT_L(8); PG8_BAR; PG8_WAIT_L(0); PG8_MMA(0, 0, At, B0); PG8_BAR; PG8_SCHED;
            PG8_LDB(B1, 1, 1); PG8_STAGE(PG8_SB(1, 0), b3, voffB);
            PG8_BAR; PG8_WAIT_L(0); PG8_MMA(0, 1, At, B1); PG8_BAR;
            PG8_LDA(At, 1, 1); PG8_STAGE(PG8_SA(1, 0), a3, voffA);
            PG8_BAR; PG8_WAIT_L(0); PG8_MMA(1, 0, At, B0); PG8_BAR; PG8_SCHED;
            PG8_STAGE(PG8_SB(1, 1), b3 + hstep, voffB);
            PG8_WAIT_V(6); PG8_BAR; PG8_MMA(1, 1, At, B1); PG8_BAR;
            }
        }
        if constexpr (ALIGN_EPI) { if (wr == 0) PG8_BAR; }
        E(acc, cur, wr, wc, fr, fq, tid); S.done(cur);
        if (!has_next) break;
#pragma unroll
        for (int a = 0; a < 2; ++a)
#pragma unroll
            for (int b = 0; b < 2; ++b)
#pragma unroll
                for (int m = 0; m < 4; ++m)
#pragma unroll
                    for (int n = 0; n < 2; ++n) acc[a][b][m][n] = (f32x4){0.f, 0.f, 0.f, 0.f};
        cur = nxt; cA = nA; cB = nB; ++ui;
        if constexpr (ALIGN_EPI) { if (wr == 1) PG8_BAR; }
    }
    PG8_WAIT_V(0);
    if constexpr (!ALIGN_EPI) { if (wr == 0) PG8_BAR; }
    PG8_BAR;
#undef PG8_SA
#undef PG8_SB
#undef PG8_STAGE
#undef PG8_LDA
#undef PG8_LDB
#undef PG8_MMA
#undef PG8_WAIT_V
#undef PG8_WAIT_L
#undef PG8_BAR
#undef PG8_SCHED
}
}

__device__ __forceinline__ float row_rstd(const float* ssq, int row, int fq) {
    const f32x4* p = (const f32x4*)(ssq + (size_t)row * 32 + fq * 8);
    const f32x4 a = p[0], b = p[1];
    float s = ((a.x + a.y) + (a.z + a.w)) + ((b.x + b.y) + (b.z + b.w));
    s += __shfl_xor(s, 16); s += __shfl_xor(s, 32);
    return rsqrtf(s * (1.0f / DM) + EPS);
}
__device__ __forceinline__ void stage_rstd(const float* ssq, int pm, LAS float* rsl, int tid) {
    const int r = tid >> 1, hs = tid & 1;
    const f32x4* p = (const f32x4*)(ssq + (size_t)(pm * 256 + r) * 32 + hs * 16);
    const f32x4 a = p[0], b = p[1], c = p[2], d = p[3];
    float s = (((a.x + a.y) + (a.z + a.w)) + ((b.x + b.y) + (b.z + b.w))) + (((c.x + c.y) + (c.z + c.w)) + ((d.x + d.y) + (d.z + d.w)));
    s += __shfl_xor(s, 1);
    if (hs == 0) rsl[r] = rsqrtf(s * (1.0f / DM) + EPS);
    asm volatile("s_waitcnt lgkmcnt(0)" ::: "memory"); __builtin_amdgcn_s_barrier(); asm volatile("" ::: "memory");
}
__device__ __forceinline__ u32x4 pack8bf(const f32x4 a, const f32x4 b) {
    u32x4 w; w.x = cvt_pk_bf16(a[0], a[1]); w.y = cvt_pk_bf16(a[2], a[3]); w.z = cvt_pk_bf16(b[0], b[1]); w.w = cvt_pk_bf16(b[2], b[3]); return w;
}
struct EpiSwiGLU {
    static constexpr bool PERM = true, AFTER_DRAIN = false;
    bf16_t* H; const float* ssq; LAS float* rsl; int cur_pm;
    __device__ __forceinline__ void operator()(const f32x4 (&acc)[2][2][4][2], const pg8::Unit& u, int wr, int wc, int fr_, int fq_, int tid) {
        int fr = fr_, fq = fq_; asm volatile("" : "+v"(fr), "+v"(fq));
        const int row0 = u.pm * 256 + wr * 64 + fr, col0 = u.pn * 128 + wc * 32 + 8 * fq;
        if (u.pm != cur_pm) { stage_rstd(ssq, u.pm, rsl, tid); cur_pm = u.pm; }
#pragma unroll
        for (int ai = 0; ai < 2; ++ai)
#pragma unroll
            for (int m = 0; m < 4; ++m) {
                const int row = row0 + ai * 128 + m * 16;
                const float rs = rsl[wr * 64 + fr + ai * 128 + m * 16];
                f32x4 h[2];
#pragma unroll
                for (int n = 0; n < 2; ++n) { const f32x4 g = acc[ai][0][m][n] * rs, up = acc[ai][1][m][n] * rs;
#pragma unroll
                    for (int i = 0; i < 4; ++i) h[n][i] = silu_f(g[i]) * up[i]; }
                *(u32x4*)(H + (size_t)row * DFF + col0) = pack8bf(h[0], h[1]);
            }
    }
};
struct EpiResid {
    static constexpr bool PERM = true, AFTER_DRAIN = false;
    const float* xin; float* xout; bf16_t* xb; float* ssq; float alpha;
    __device__ __forceinline__ void operator()(const f32x4 (&acc)[2][2][4][2], const pg8::Unit& u, int wr, int wc, int fr_, int fq_, int tid) {
        int fr = fr_, fq = fq_; asm volatile("" : "+v"(fr), "+v"(fq));
        const int row0 = u.pm * 256 + wr * 64 + fr, col0 = u.pn * 256 + wc * 32 + 8 * fq;
        const size_t base = (size_t)row0 * DM + col0;
        f32x4 cur[4], nxt[4];
#define ER_LD(dst, g) do { const float* p_ = xin + base + (size_t)((((g) >> 2) * 128 + ((g) & 3) * 16)) * DM; dst[0] = *(const f32x4*)(p_); dst[1] = *(const f32x4*)(p_ + 4); dst[2] = *(const f32x4*)(p_ + 128); dst[3] = *(const f32x4*)(p_ + 132); } while (0)
        ER_LD(cur, 0);
#pragma unroll
        for (int g = 0; g < 8; ++g) {
            const int ai = g >> 2, m = g & 3;
            if (g < 7) ER_LD(nxt, g + 1);
            const size_t off = base + (size_t)(ai * 128 + m * 16) * DM; float s = 0.f;
#pragma unroll
            for (int bj = 0; bj < 2; ++bj) {
                const f32x4 n0 = cur[2 * bj] + acc[ai][bj][m][0] * alpha, n1 = cur[2 * bj + 1] + acc[ai][bj][m][1] * alpha;
                *(f32x4*)(xout + off + bj * 128) = n0; *(f32x4*)(xout + off + bj * 128 + 4) = n1;
                *(u32x4*)(xb + off + bj * 128) = pack8bf(n0, n1);
                s += (n0[0] * n0[0] + n0[1] * n0[1]) + (n0[2] * n0[2] + n0[3] * n0[3]) + (n1[0] * n1[0] + n1[1] * n1[1]) + (n1[2] * n1[2] + n1[3] * n1[3]);
            }
            s += __shfl_xor(s, 16); s += __shfl_xor(s, 32);
            if (fq == 0) ssq[(size_t)(row0 + ai * 128 + m * 16) * 32 + u.pn * 4 + wc] = s;
#pragma unroll
            for (int j = 0; j < 4; ++j) cur[j] = nxt[j];
        }
#undef ER_LD
    }
};
struct EpiWin {
    static constexpr bool PERM = true, AFTER_DRAIN = false;
    const float* ssq; LAS float* rsl; const float* __restrict__ ropec; const float* __restrict__ ropes;
    bf16_t *FQ, *RQ; int cur_pm;
    __device__ __forceinline__ void operator()(const f32x4 (&acc)[2][2][4][2], const pg8::Unit& u, int wr, int wc, int fr_, int fq_, int tid) {
        int fr = fr_, fq = fq_; asm volatile("" : "+v"(fr), "+v"(fq));
        const int pn = u.pn, b = u.pm >> 4, s0 = (u.pm & 15) * 256 + wr * 64 + fr, rl0 = wr * 64 + fr;
        if (u.pm != cur_pm) { stage_rstd(ssq, u.pm, rsl, tid); cur_pm = u.pm; }
        if (pn < 12) {
            const int t = pn >> 2; bf16_t* base = FQ + (size_t)t * (SZ_FOX / 2);
#pragma unroll
            for (int ai = 0; ai < 2; ++ai)
#pragma unroll
                for (int m = 0; m < 4; ++m) {
                    const int s = s0 + ai * 128 + m * 16; const float rs = rsl[rl0 + ai * 128 + m * 16];
#pragma unroll
                    for (int bj = 0; bj < 2; ++bj) { const int head = 2 * (pn & 3) + bj;
                        *(u32x4*)(base + ((size_t)(b * FOXH + head) * SEQ + s) * HD + wc * 32 + 8 * fq) = pack8bf(acc[ai][bj][m][0] * rs, acc[ai][bj][m][1] * rs); }
                }
        } else if (pn < 16) {
            const int seg = (pn - 12) >> 1, hh = 2 * ((pn - 12) & 1) + (wc >> 1), dp = 32 * (wc & 1) + 8 * fq;
            bf16_t* base = RQ + (size_t)seg * (SZ_R / 2); const float ksc = seg ? 0.08838834764831845f : 1.0f;
#pragma unroll
            for (int ai = 0; ai < 2; ++ai)
#pragma unroll
                for (int m = 0; m < 4; ++m) {
                    const int s = s0 + ai * 128 + m * 16; const float rs = rsl[rl0 + ai * 128 + m * 16] * ksc;
                    const f32x4 c0 = *(const f32x4*)(ropec + (size_t)s * 64 + dp), c1 = *(const f32x4*)(ropec + (size_t)s * 64 + dp + 4);
                    const f32x4 n0 = *(const f32x4*)(ropes + (size_t)s * 64 + dp), n1 = *(const f32x4*)(ropes + (size_t)s * 64 + dp + 4);
                    const f32x4 a0 = acc[ai][0][m][0] * rs, a1 = acc[ai][0][m][1] * rs, b0 = acc[ai][1][m][0] * rs, b1 = acc[ai][1][m][1] * rs;
                    bf16_t* dst = base + ((size_t)(b * RETH + hh) * SEQ + s) * HD + dp;
                    *(u32x4*)(dst) = pack8bf(a0 * c0 - b0 * n0, a1 * c1 - b1 * n1);
                    *(u32x4*)(dst + 64) = pack8bf(a0 * n0 + b0 * c0, a1 * n1 + b1 * c1);
                    if (m & 1) asm volatile("" ::: "memory");
                }
        } else {
            const int idx = pn - 16, kind = idx >> 1;
            bf16_t* base = RQ + (size_t)(2 + kind) * (SZ_R / 2);
#pragma unroll
            for (int ai = 0; ai < 2; ++ai)
#pragma unroll
                for (int m = 0; m < 4; ++m) {
                    const int s = s0 + ai * 128 + m * 16; const float rs = rsl[rl0 + ai * 128 + m * 16];
#pragma unroll
                    for (int bj = 0; bj < 2; ++bj) { const int head = 2 * (idx & 1) + bj;
                        f32x4 v0 = acc[ai][bj][m][0] * rs, v1 = acc[ai][bj][m][1] * rs;
                        if (kind == 1) {
#pragma unroll
                            for (int i = 0; i < 4; ++i) { v0[i] = silu_f(v0[i]); v1[i] = silu_f(v1[i]); } }
                        if (kind >= 2) {
#pragma unroll
                            for (int i = 0; i < 4; ++i) { v0[i] = gelu_tanh_f(v0[i]); v1[i] = gelu_tanh_f(v1[i]); } }
                        *(u32x4*)(base + ((size_t)(b * RETH + head) * SEQ + s) * HD + wc * 32 + 8 * fq) = pack8bf(v0, v1); }
                }
        }
    }
};

struct Args {
    const float* in[19]; float* out; unsigned char* ws;
    int l_lo, l_hi, ph_lo, ph_hi;
    int use_bar, pad;
};

__device__ __forceinline__ void tr_item(const float* W, int ldw, int src_col0, int k0, const float* gain, bf16_t* WT, int K, int dst_row0, LAS float* scr, int lane) {
    float v[32];
    const float* wp = W + (size_t)(k0 + (lane >> 5)) * ldw + src_col0 + (lane & 31);
#pragma unroll
    for (int i = 0; i < 32; ++i) v[i] = wp[(size_t)(2 * i) * ldw];
    if (gain) {
#pragma unroll
        for (int i = 0; i < 32; ++i) v[i] *= gain[k0 + 2 * i + (lane >> 5)]; }
#pragma unroll
    for (int i = 0; i < 32; ++i) scr[(2 * i + (lane >> 5)) * 33 + (lane & 31)] = v[i];
    LDS_WAIT(); asm volatile("" ::: "memory");
    const int c = lane & 7;
#pragma unroll
    for (int j = 0; j < 4; ++j) { const int n = (lane >> 3) + 8 * j; const LAS float* s = scr + (8 * c) * 33 + n;
        u32x4 o; o.x = pk2(s[0 * 33], s[1 * 33]); o.y = pk2(s[2 * 33], s[3 * 33]); o.z = pk2(s[4 * 33], s[5 * 33]); o.w = pk2(s[6 * 33], s[7 * 33]);
        *(u32x4*)(WT + (size_t)(dst_row0 + n) * K + k0 + 8 * c) = o; }
    LDS_WAIT(); asm volatile("" ::: "memory");
}
constexpr int IT_GU = (DM / 64) * (DFF / 32);
constexpr int IT_D = (DFF / 64) * (DM / 32);
constexpr int IT_WIN = (DM / 64) * (NWIN / 32);
constexpr int IT_WOUT = (DM / 64) * (DM / 32);
constexpr int IT_LAYER = 4 * IT_GU + 2 * IT_D + IT_WIN + IT_WOUT;
__device__ __forceinline__ int win_src_col(int db) {
    const int t = db >> 3, bb = db & 7, bj = bb >> 2, j0 = 32 * (bb & 3);
    if (t < 12) return 32 * db;
    if (t < 16) { const int seg = (t - 12) >> 1, ts = (t - 12) & 1, hh = 2 * ts + (j0 >> 6), d = 64 * bj + (j0 & 63); return 3080 + seg * 512 + hh * 128 + d; }
    return 8 + 32 * db;
}
__device__ __forceinline__ void prologue(const Args& a, unsigned char* ws, LAS unsigned char* lds, int gw, int ngw, int wave, int lane) {
    LAS float* scr = (LAS float*)(lds + wave * 16384);
    for (int it = gw; it < DEPTH * IT_LAYER; it += ngw) {
        const int l = it / IT_LAYER; int r = it - l * IT_LAYER;
        if (r < 4 * IT_GU) {
            const int which = r / IT_GU; r -= which * IT_GU; const int f = which >> 1, isup = which & 1;
            const float* W = a.in[f ? (isup ? 16 : 15) : (isup ? 3 : 2)] + (size_t)l * DM * DFF;
            const float* gain = a.in[f ? 14 : 1] + (size_t)l * DM;
            const int kb = r / (DFF / 32), nb = r % (DFF / 32), n0 = 32 * nb;
            bf16_t* WT = (bf16_t*)(ws + WS_WGU + (size_t)(l * 2 + f) * SZ_WGU);
            tr_item(W, DFF, n0, 64 * kb, gain, WT, DM, 256 * (n0 >> 7) + (n0 & 127) + 128 * isup, scr, lane);
        } else if (r < 4 * IT_GU + 2 * IT_D) {
            r -= 4 * IT_GU; const int f = r / IT_D; r -= f * IT_D;
            const float* W = a.in[f ? 17 : 4] + (size_t)l * DFF * DM;
            const int kb = r / (DM / 32), nb = r % (DM / 32);
            bf16_t* WT = (bf16_t*)(ws + WS_WD + (size_t)(l * 2 + f) * SZ_WD);
            tr_item(W, DM, 32 * nb, 64 * kb, nullptr, WT, DFF, 32 * nb, scr, lane);
        } else if (r < 4 * IT_GU + 2 * IT_D + IT_WIN) {
            r -= 4 * IT_GU + 2 * IT_D;
            const float* W = a.in[6] + (size_t)l * DM * INCOLS; const float* gain = a.in[5] + (size_t)l * DM;
            const int kb = r / (NWIN / 32), db = r % (NWIN / 32);
            bf16_t* WT = (bf16_t*)(ws + WS_WIN + (size_t)l * SZ_WIN);
            tr_item(W, INCOLS, win_src_col(db), 64 * kb, gain, WT, DM, 32 * db, scr, lane);
        } else {
            r -= 4 * IT_GU + 2 * IT_D + IT_WIN;
            const float* W = a.in[13] + (size_t)l * DM * DM; const float* gain = a.in[12] + (size_t)l * DM;
            const int kb = r / (DM / 32), nb = r % (DM / 32);
            bf16_t* WT = (bf16_t*)(ws + WS_WOUT + (size_t)l * SZ_WOUT);
            tr_item(W, DM, 32 * nb, 64 * kb, gain, WT, DM, 32 * nb, scr, lane);
        }
    }
    {
        const float* x = a.in[0]; bf16_t* xb = (bf16_t*)(ws + WS_XB); float* ssq = (float*)(ws + WS_SSQ);
        for (int m = gw; m < MROWS; m += ngw) {
            const f32x4* xr = (const f32x4*)(x + (size_t)m * DM); float s = 0.f;
#pragma unroll
            for (int j = 0; j < 4; ++j) { const f32x4 v0 = xr[(j * 64 + lane) * 2], v1 = xr[(j * 64 + lane) * 2 + 1];
                s += (v0[0] * v0[0] + v0[1] * v0[1]) + (v0[2] * v0[2] + v0[3] * v0[3]) + (v1[0] * v1[0] + v1[1] * v1[1]) + (v1[2] * v1[2] + v1[3] * v1[3]);
                u32x4 w; w.x = pk2(v0[0], v0[1]); w.y = pk2(v0[2], v0[3]); w.z = pk2(v1[0], v1[1]); w.w = pk2(v1[2], v1[3]);
                *(u32x4*)(xb + (size_t)m * DM + (j * 64 + lane) * 8) = w; }
            s = wave_sum(s);
            if (lane < 32) ssq[(size_t)m * 32 + lane] = lane == 0 ? s : 0.f;
        }
    }
    {
        float* rc = (float*)(ws + WS_ROPE); float* rs = rc + SEQ * 64;
        const int gt = gw * 64 + lane, ngt = ngw * 64;
        for (int i = gt; i < SEQ * 64; i += ngt) { const int s = i >> 6, j = i & 63;
            const float inv = exp2f(-(float)j * (13.287712379549449f / 64.0f));
            const float ang = (float)s * inv;
            const double rev = (double)ang * 0.15915494309189535; const float fr = (float)(rev - rint(rev));
            rc[i] = __builtin_amdgcn_cosf(fr); rs[i] = __builtin_amdgcn_sinf(fr); }
        for (int i = gt; i < DEPTH * 8 * DM; i += ngt) { const int l = i / (8 * DM), r = i - l * 8 * DM, h = r / DM, k = r - h * DM;
            const float v = a.in[6][((size_t)l * DM + k) * INCOLS + FZ_COL + h] * a.in[5][(size_t)l * DM + k];
            if (NAIVE_MASK & 1) ((float*)(ws + WS_WFZ))[i] = v; else ((bf16_t*)(ws + WS_WFZ))[i] = (bf16_t)f2bf(v); }
    }
}

__device__ __forceinline__ void fz_phase(const bf16_t* xb, const float* ssq, const float* wfz, const float* bf, float* logf, int blk, int nblk, int tid) {
    const int r = tid >> 3, ks = tid & 7, lane = tid & 63;
    for (int rb = blk; rb < MROWS / 64; rb += nblk) {
        const int row = rb * 64 + r;
        float acc[8];
#pragma unroll
        for (int h = 0; h < 8; ++h) acc[h] = 0.f;
        const u32x4* xp = (const u32x4*)(xb + (size_t)row * DM + ks * 256);
        for (int c = 0; c < 32; ++c) {
            float xv[8]; unpack8(xp[c], xv);
#pragma unroll
            for (int h = 0; h < 8; ++h) { const f32x4* wp = (const f32x4*)(wfz + h * DM + ks * 256 + c * 8); const f32x4 w0 = wp[0], w1 = wp[1];
                acc[h] += (xv[0] * w0[0] + xv[1] * w0[1]) + (xv[2] * w0[2] + xv[3] * w0[3]) + (xv[4] * w1[0] + xv[5] * w1[1]) + (xv[6] * w1[2] + xv[7] * w1[3]); }
        }
#pragma unroll
        for (int h = 0; h < 8; ++h) { acc[h] += __shfl_xor(acc[h], 1); acc[h] += __shfl_xor(acc[h], 2); acc[h] += __shfl_xor(acc[h], 4); }
        const f32x4 pp = *(const f32x4*)(ssq + (size_t)row * 32 + ks * 4);
        float s = (pp[0] + pp[1]) + (pp[2] + pp[3]); s += __shfl_xor(s, 1); s += __shfl_xor(s, 2); s += __shfl_xor(s, 4);
        const float rs = rsqrtf(s * (1.0f / DM) + EPS);
        float mine = acc[0];
#pragma unroll
        for (int h = 1; h < 8; ++h) mine = (ks == h) ? acc[h] : mine;
        const int b = row >> 12, sp = row & 4095;
        logf[((size_t)(b * FOXH + ks)) * SEQ + sp] = logsig_f(mine * rs + bf[ks]);
        (void)lane;
    }
}

__device__ __forceinline__ float ret_log2g(int hr) { return log2f(1.0f - exp2f(-(5.0f + (float)hr))); }

__device__ __forceinline__ void cumsum_unit(const float* lf, float* cum, LAS float* sm, int tid) {
    const int lane = tid & 63, w = tid >> 6;
    const f32x4 a = ((const f32x4*)lf)[2 * tid], b = ((const f32x4*)lf)[2 * tid + 1];
    float v0 = a[0], v1 = v0 + a[1], v2 = v1 + a[2], v3 = v2 + a[3], v4 = v3 + b[0], v5 = v4 + b[1], v6 = v5 + b[2], v7 = v6 + b[3];
    const float tot = v7; float sc = tot;
#pragma unroll
    for (int o = 1; o < 64; o <<= 1) { const float n = __shfl_up(sc, o); if (lane >= o) sc += n; }
    if (lane == 63) sm[w] = sc;
    __syncthreads();
    float base = 0.f;
    for (int i = 0; i < w; ++i) base += sm[i];
    const float ex = base + sc - tot;
    ((f32x4*)cum)[2 * tid] = (f32x4){v0 + ex, v1 + ex, v2 + ex, v3 + ex};
    ((f32x4*)cum)[2 * tid + 1] = (f32x4){v4 + ex, v5 + ex, v6 + ex, v7 + ex};
    __syncthreads();
}
__device__ __forceinline__ void retkv_unit(const bf16_t* K, const bf16_t* V, float* kv, float l2g, LAS float* lds, int tid) {
    LAS float* Kz = lds; LAS float* Vs = lds + 64 * 128;
    { const int s = tid >> 3, c0 = (tid & 7) * 16; const float z = exp2f((float)(63 - s) * l2g);
      const u32x4* kp = (const u32x4*)(K + s * 128 + c0); const u32x4* vp = (const u32x4*)(V + s * 128 + c0);
      float f[8];
#pragma unroll
      for (int j = 0; j < 2; ++j) { unpack8(kp[j], f);
#pragma unroll
          for (int i = 0; i < 8; ++i) Kz[s * 128 + c0 + j * 8 + i] = f[i] * z;
          unpack8(vp[j], f);
#pragma unroll
          for (int i = 0; i < 8; ++i) Vs[s * 128 + c0 + j * 8 + i] = f[i]; } }
    __syncthreads();
    const int e = tid & 127, dg = tid >> 7;
    float acc[32];
#pragma unroll
    for (int i = 0; i < 32; ++i) acc[i] = 0.f;
    for (int s = 0; s < 64; ++s) { const float v = Vs[s * 128 + e];
#pragma unroll
        for (int i = 0; i < 32; ++i) acc[i] += Kz[s * 128 + dg * 32 + i] * v; }
#pragma unroll
    for (int i = 0; i < 32; ++i) kv[(size_t)(dg * 32 + i) * 128 + e] = acc[i];
    __syncthreads();
}
__device__ __forceinline__ void gmlp_unit(const bf16_t* U, const bf16_t* V, const float* lng, const float* lnb, const float* wsp, const float* bsp, bf16_t* Y  , LAS float* lds, int tid) {
    LAS float* vln = lds; LAS float* Wt = lds + 128 * 128;
    const int lane = tid & 63, w = tid >> 6;
    for (int i = 0; i < 16; ++i) { const int s = 16 * w + i;
        const unsigned pr = *(const unsigned*)(V + s * 128 + 2 * lane); const float a = bf2f(pr & 0xffffu), b = bf2f(pr >> 16);
        const float mu = wave_sum(a + b) * (1.0f / 128.0f); const float da = a - mu, db = b - mu;
        const float var = wave_sum(da * da + db * db) * (1.0f / 128.0f); const float rs = rsqrtf(var + EPS);
        vln[s * 128 + 2 * lane] = da * rs * lng[2 * lane] + lnb[2 * lane]; vln[s * 128 + 2 * lane + 1] = db * rs * lng[2 * lane + 1] + lnb[2 * lane + 1]; }
    for (int i = tid; i < 128 * 128; i += NTHREADS) { const int t = i >> 7, s = i & 127; Wt[i] = (s <= t) ? wsp[i] : 0.f; }
    __syncthreads();
    const int c = tid & 127, tg = tid >> 7;
    float acc[32];
#pragma unroll
    for (int i = 0; i < 32; ++i) acc[i] = 0.f;
    for (int s4 = 0; s4 < 32; ++s4) {
        const float x0 = vln[(4 * s4) * 128 + c], x1 = vln[(4 * s4 + 1) * 128 + c], x2 = vln[(4 * s4 + 2) * 128 + c], x3 = vln[(4 * s4 + 3) * 128 + c];
#pragma unroll
        for (int i = 0; i < 32; ++i) { const f32x4 wv = *(const LAS f32x4*)(Wt + (tg * 32 + i) * 128 + 4 * s4); acc[i] += (wv[0] * x0 + wv[1] * x1) + (wv[2] * x2 + wv[3] * x3); }
    }
    __syncthreads();
#pragma unroll
    for (int i = 0; i < 32; ++i) { const int t = tg * 32 + i; const float uu = bf2f(U[t * 128 + c]); vln[t * 128 + c] = uu * (acc[i] + bsp[t]); }
    __syncthreads();
    for (int i = 0; i < 16; ++i) { const int t = 16 * w + i; const float a = vln[t * 128 + 2 * lane], b = vln[t * 128 + 2 * lane + 1];
        const float rs = rsqrtf(wave_sum(a * a + b * b) * (1.0f / 128.0f) + EPS);
        *(unsigned*)(Y + (size_t)t * DM + 2 * lane) = pk2(a * rs, b * rs); }
    __syncthreads();
}
__device__ __forceinline__ void retout_unit(const bf16_t* Q, const bf16_t* K, const bf16_t* V, const bf16_t* G, const float* sp, bf16_t* Y, float l2g, LAS float* lds, int tid) {
    LAS float* Qs = lds; LAS float* Ks = lds + 64 * 129; LAS float* Vs = lds + 2 * 64 * 129; LAS float* Sc = Vs + 64 * 128;
    const int lane = tid & 63, w = tid >> 6;
    { const int s = tid >> 3, c0 = (tid & 7) * 16; float f[8];
      const u32x4* qp = (const u32x4*)(Q + s * 128 + c0); const u32x4* kp = (const u32x4*)(K + s * 128 + c0); const u32x4* vp = (const u32x4*)(V + s * 128 + c0);
#pragma unroll
      for (int j = 0; j < 2; ++j) {
          unpack8(qp[j], f);
#pragma unroll
          for (int i = 0; i < 8; ++i) Qs[s * 129 + c0 + j * 8 + i] = f[i];
          unpack8(kp[j], f);
#pragma unroll
          for (int i = 0; i < 8; ++i) Ks[s * 129 + c0 + j * 8 + i] = f[i];
          unpack8(vp[j], f);
#pragma unroll
          for (int i = 0; i < 8; ++i) Vs[s * 128 + c0 + j * 8 + i] = f[i]; } }
    __syncthreads();
    {
        float acc[8];
#pragma unroll
        for (int j = 0; j < 8; ++j) acc[j] = 0.f;
        for (int d = 0; d < 128; ++d) { const float kk = Ks[lane * 129 + d];
#pragma unroll
            for (int j = 0; j < 8; ++j) acc[j] += Qs[(8 * w + j) * 129 + d] * kk; }
#pragma unroll
        for (int j = 0; j < 8; ++j) { const int t = 8 * w + j; Sc[t * 64 + lane] = (lane <= t) ? acc[j] * exp2f((float)(t - lane) * l2g) : 0.f; }
    }
    __syncthreads();
    const int e = tid & 127, tg = tid >> 7;
    float o[16];
#pragma unroll
    for (int j = 0; j < 16; ++j) o[j] = 0.f;
    for (int d = 0; d < 128; ++d) { const float sv = sp[(size_t)d * 128 + e];
#pragma unroll
        for (int j = 0; j < 16; ++j) o[j] += Qs[(tg * 16 + j) * 129 + d] * sv; }
#pragma unroll
    for (int j = 0; j < 16; ++j) o[j] *= exp2f((float)(tg * 16 + j + 1) * l2g);
    for (int s = 0; s < 64; ++s) { const float v = Vs[s * 128 + e];
#pragma unroll
        for (int j = 0; j < 16; ++j) o[j] += Sc[(tg * 16 + j) * 64 + s] * v; }
    __syncthreads();
#pragma unroll
    for (int j = 0; j < 16; ++j) Ks[(tg * 16 + j) * 128 + e] = o[j];
    __syncthreads();
    for (int i = 0; i < 8; ++i) { const int t = 8 * w + i; const float a = Ks[t * 128 + 2 * lane], b = Ks[t * 128 + 2 * lane + 1];
        const float rs = rsqrtf(wave_sum(a * a + b * b) * (1.0f / 128.0f) + EPS);
        const unsigned gp = *(const unsigned*)(G + t * 128 + 2 * lane);
        *(unsigned*)(Y + (size_t)t * DM + 2 * lane) = pk2(a * rs * bf2f(gp & 0xffffu), b * rs * bf2f(gp >> 16)); }
    __syncthreads();
}
__device__ __forceinline__ void attn_naive(const bf16_t* FQ, const bf16_t* FK, const bf16_t* FV, const float* cum, bf16_t* Y, int gw, int ngw, int lane) {
    const int sub = lane & 3, rl = lane >> 2;
    for (int it = gw; it < 4 * 2048; it += ngw) {
        const int vw = it & 2047, i = it >> 11;
        const int bh = (vw >> 7) + ((i >> 1) << 4), gg = vw & 127, g = (i & 1) ? 255 - gg : gg, t = g * 16 + rl;
        float q[32], o[32];
        { const u32x4* qp = (const u32x4*)(FQ + ((size_t)bh * SEQ + t) * HD + sub * 32);
#pragma unroll
          for (int j = 0; j < 4; ++j) { float f[8]; unpack8(qp[j], f);
#pragma unroll
              for (int k = 0; k < 8; ++k) q[j * 8 + k] = f[k] * 0.08838834764831845f; } }
#pragma unroll
        for (int j = 0; j < 32; ++j) o[j] = 0.f;
        float m = -1e30f, l = 0.f; const float ct = cum[(size_t)bh * SEQ + t];
        const int smax = g * 16 + 15;
        for (int s = 0; s <= smax; ++s) {
            const u32x4* kp = (const u32x4*)(FK + ((size_t)bh * SEQ + s) * HD + sub * 32);
            float d = 0.f;
#pragma unroll
            for (int j = 0; j < 4; ++j) { float f[8]; unpack8(kp[j], f);
#pragma unroll
                for (int k = 0; k < 8; ++k) d += q[j * 8 + k] * f[k]; }
            d += __shfl_xor(d, 1); d += __shfl_xor(d, 2);
            const float logit = d + ct - cum[(size_t)bh * SEQ + s];
            const bool valid = s <= t;
            const float mn = valid ? fmaxf(m, logit) : m;
            const float corr = __expf(m - mn), p = valid ? __expf(logit - mn) : 0.f;
            l = l * corr + p; m = mn;
            const u32x4* vp = (const u32x4*)(FV + ((size_t)bh * SEQ + s) * HD + sub * 32);
#pragma unroll
            for (int j = 0; j < 4; ++j) { float f[8]; unpack8(vp[j], f);
#pragma unroll
                for (int k = 0; k < 8; ++k) o[j * 8 + k] = o[j * 8 + k] * corr + p * f[k]; }
        }
        const float inv = 1.0f / l; float ss = 0.f;
#pragma unroll
        for (int j = 0; j < 32; ++j) { o[j] *= inv; ss += o[j] * o[j]; }
        ss += __shfl_xor(ss, 1); ss += __shfl_xor(ss, 2);
        const float rs = rsqrtf(ss * (1.0f / 128.0f) + EPS);
        const int b = bh >> 3, h = bh & 7;
        bf16_t* yp = Y + ((size_t)(b * SEQ + t)) * DM + h * HD + sub * 32;
#pragma unroll
        for (int j = 0; j < 4; ++j) { u32x4 wv; wv.x = pk2(o[j * 8] * rs, o[j * 8 + 1] * rs); wv.y = pk2(o[j * 8 + 2] * rs, o[j * 8 + 3] * rs); wv.z = pk2(o[j * 8 + 4] * rs, o[j * 8 + 5] * rs); wv.w = pk2(o[j * 8 + 6] * rs, o[j * 8 + 7] * rs);
            *(u32x4*)(yp + j * 8) = wv; }
    }
}


namespace fa {
constexpr int NW = 8, QBLK = 32, KVBLK = 64, QB = 256, D = 128;
constexpr int SHM_V = 16384, SHM_K = 16384;
constexpr int OFF_WS = 2 * SHM_V + 2 * SHM_K;
constexpr int OFF_CS = OFF_WS + NW * 64 * 4;
constexpr int LDS_NEED = OFF_CS + SEQ * 4;
constexpr float C2 = 1.4426950408889634f * 0.08838834764831845f;
constexpr float THR2 = 8.f * 1.4426950408889634f;
typedef float f32x16 __attribute__((ext_vector_type(16)));
typedef short s16x4 __attribute__((ext_vector_type(4)));
typedef LAS char* lptr;
#define KSWZ(row, colB) ((row) * 256 + ((colB) ^ (((row) & 7) << 4)))
#define SBAR() __builtin_amdgcn_sched_barrier(0)
__device__ __forceinline__ int v_st(int k, int c) { const int kk = (k & ~0xC) | ((k & 4) << 1) | ((k & 8) >> 1); return ((kk >> 3) * 4 + (c >> 5)) * 512 + ((kk & 7) * 32 + (c & 31)) * 2; }
__device__ __forceinline__ int v_rd_base(int lane) { return ((lane & 3) << 3) | (((lane >> 2) & 3) << 6) | (((lane >> 4) & 1) << 5) | (((lane >> 5) & 1) << 8); }
constexpr int v_rd_off(int d0, int ks, int half) { return d0 * 512 + ks * 4096 + half * 2048; }
__device__ __forceinline__ int crow(int r, int hi) { return (r & 3) + 8 * (r >> 2) + 4 * hi; }
__device__ __forceinline__ bf16x8 load8(const bf16_t* p) { return *reinterpret_cast<const bf16x8*>(p); }
__device__ __forceinline__ void bias_tile(f32x16& p0, f32x16& p1, const LAS float* cs) {
#pragma unroll
    for (int i = 0; i < 4; ++i) { const f32x4 a = *(const LAS f32x4*)(cs + 8 * i), b = *(const LAS f32x4*)(cs + 32 + 8 * i);
#pragma unroll
        for (int j = 0; j < 4; ++j) { p0[4 * i + j] = fmaf(p0[4 * i + j], C2, a[j]); p1[4 * i + j] = fmaf(p1[4 * i + j], C2, b[j]); } }
}
__device__ __forceinline__ void mask_tile(f32x16& p0, f32x16& p1, int dq) {
    const float NEG = -__builtin_inff();
#pragma unroll
    for (int r = 0; r < 16; ++r) { const int c = (r & 3) + 8 * (r >> 2);
        if (dq - c < 0) p0[r] = NEG;
        if (dq - c - 32 < 0) p1[r] = NEG; }
}
__device__ __forceinline__ void partialSM(f32x16& p0, f32x16& p1, float& m_reg, float& alpha) {
    float pmax = p0[0];
#pragma unroll
    for (int r = 1; r < 16; ++r) pmax = fmaxf(pmax, p0[r]);
#pragma unroll
    for (int r = 0; r < 16; ++r) pmax = fmaxf(pmax, p1[r]);
    { auto rr = __builtin_amdgcn_permlane32_swap(__float_as_uint(pmax), __float_as_uint(pmax), false, false);
      pmax = fmaxf(__uint_as_float(rr[0]), __uint_as_float(rr[1])); }
    float mn;
    if (__builtin_expect(__all(pmax - m_reg <= THR2), 1)) { mn = m_reg; alpha = 1.f; }
    else { mn = fmaxf(m_reg, pmax); alpha = __builtin_amdgcn_exp2f(m_reg - mn); m_reg = mn; }
#pragma unroll
    for (int r = 0; r < 16; ++r) p0[r] = p0[r] - mn;
#pragma unroll
    for (int r = 0; r < 16; ++r) p1[r] = p1[r] - mn;
#pragma unroll
    for (int r = 0; r < 16; ++r) p0[r] = __builtin_amdgcn_exp2f(p0[r]);
}
__device__ __forceinline__ void finishSM(f32x16& p0, f32x16& p1, float alpha, float& l_reg, bf16x8& pa0, bf16x8& pa1, bf16x8& pa2, bf16x8& pa3) {
#pragma unroll
    for (int r = 0; r < 16; ++r) p1[r] = __builtin_amdgcn_exp2f(p1[r]);
    float ps = 0;
#pragma unroll
    for (int r = 0; r < 16; ++r) ps += p0[r];
#pragma unroll
    for (int r = 0; r < 16; ++r) ps += p1[r];
    { auto rr = __builtin_amdgcn_permlane32_swap(__float_as_uint(ps), __float_as_uint(ps), false, false);
      ps = __uint_as_float(rr[0]) + __uint_as_float(rr[1]); }
    l_reg = l_reg * alpha + ps;
#define PK4(P, B_, OUT) do { unsigned a0 = cvt_pk_bf16(P[B_+0], P[B_+1]), a1 = cvt_pk_bf16(P[B_+2], P[B_+3]);                          \
        unsigned b0 = cvt_pk_bf16(P[B_+4], P[B_+5]), b1 = cvt_pk_bf16(P[B_+6], P[B_+7]);                                             \
        auto r0 = __builtin_amdgcn_permlane32_swap(a0, b0, false, false); auto r1 = __builtin_amdgcn_permlane32_swap(a1, b1, false, false); \
        u32x4 w = {r0[0], r1[0], r0[1], r1[1]}; OUT = *reinterpret_cast<bf16x8*>(&w); } while (0)
    PK4(p0, 0, pa0); PK4(p0, 8, pa1); PK4(p1, 0, pa2); PK4(p1, 8, pa3);
#undef PK4
}
template <int KB>
__device__ __forceinline__ void qkt(f32x16& p0, f32x16& p1, lptr K_lds, int r32, int hi, const bf16x8* qr) {
    p0 = f32x16{}; p1 = f32x16{};
    lptr kb[4];
#pragma unroll
    for (int dd = 0; dd < 4; ++dd) kb[dd] = K_lds + KB * SHM_K + KSWZ(r32, (dd * 16 + hi * 8) * 2);
#pragma unroll
    for (int d0 = 0; d0 < 8; ++d0) { lptr a = kb[d0 & 3] + (d0 >> 2) * 128;
        bf16x8 b0 = *reinterpret_cast<const LAS bf16x8*>(a);
        bf16x8 b1 = *reinterpret_cast<const LAS bf16x8*>(a + 32 * 256);
        p0 = __builtin_amdgcn_mfma_f32_32x32x16_bf16(b0, qr[d0], p0, 0, 0, 0);
        p1 = __builtin_amdgcn_mfma_f32_32x32x16_bf16(b1, qr[d0], p1, 0, 0, 0); }
}
template <int VB>
__device__ __forceinline__ void pv_tile(f32x16* o, int vb0, bf16x8 pa0, bf16x8 pa1, bf16x8 pa2, bf16x8 pa3) {
#define TRRD(dst, off) asm volatile("ds_read_b64_tr_b16 %0, %1 offset:%2" : "=&v"(dst) : "v"(vb0), "i"(off) : "memory")
#define PV_D0(d0) do { s16x4 l0, l1, l2, l3, h0, h1, h2, h3; constexpr int b_ = VB * SHM_V + v_rd_off(d0, 0, 0); \
        TRRD(l0, b_); TRRD(h0, b_ + 2048); TRRD(l1, b_ + 4096); TRRD(h1, b_ + 6144); TRRD(l2, b_ + 8192); TRRD(h2, b_ + 10240); TRRD(l3, b_ + 12288); TRRD(h3, b_ + 14336); \
        asm volatile("s_waitcnt lgkmcnt(0)" ::: "memory"); SBAR(); \
        o[d0] = __builtin_amdgcn_mfma_f32_32x32x16_bf16(pa0, (bf16x8){l0[0], l0[1], l0[2], l0[3], h0[0], h0[1], h0[2], h0[3]}, o[d0], 0, 0, 0);   \
        o[d0] = __builtin_amdgcn_mfma_f32_32x32x16_bf16(pa1, (bf16x8){l1[0], l1[1], l1[2], l1[3], h1[0], h1[1], h1[2], h1[3]}, o[d0], 0, 0, 0);   \
        o[d0] = __builtin_amdgcn_mfma_f32_32x32x16_bf16(pa2, (bf16x8){l2[0], l2[1], l2[2], l2[3], h2[0], h2[1], h2[2], h2[3]}, o[d0], 0, 0, 0);   \
        o[d0] = __builtin_amdgcn_mfma_f32_32x32x16_bf16(pa3, (bf16x8){l3[0], l3[1], l3[2], l3[3], h3[0], h3[1], h3[2], h3[3]}, o[d0], 0, 0, 0); } while (0)
    PV_D0(0); PV_D0(1); PV_D0(2); PV_D0(3);
#undef PV_D0
#undef TRRD
}
struct BlockRef { const bf16_t* Q; const bf16_t* K; const bf16_t* V; bf16_t* O; int P0; };
#define ROW(p, k0, rr) ((p) + (size_t)((k0) + (rr)) * D + sc)
#define VMW() asm volatile("s_waitcnt vmcnt(0)" ::: "memory")
#define SLOAD_H(Kp, Vp, k0) do { st_v0 = load8(ROW(Vp, k0, sr)); st_v1 = load8(ROW(Vp, k0, 32 + sr)); st_k0 = load8(ROW(Kp, k0, sr)); st_k1 = load8(ROW(Kp, k0, 32 + sr)); } while (0)
#define SWRITE_H(bf) do { *(LAS bf16x8*)(V_lds + (bf) * SHM_V + vst0) = st_v0; *(LAS bf16x8*)(V_lds + (bf) * SHM_V + vst1) = st_v1; \
                          *(LAS bf16x8*)(K_lds + (bf) * SHM_K + kws) = st_k0; *(LAS bf16x8*)(K_lds + (bf) * SHM_K + kws + 32 * 256) = st_k1; } while (0)
__device__ __forceinline__ void block(const BlockRef& cur, lptr lds, int tid) {
    const int wid = __builtin_amdgcn_readfirstlane(tid >> 6), lane = tid & 63, r32 = lane & 31, hi = lane >> 5;
    const int NT = cur.P0 / KVBLK + 4;
    const int qlo = cur.P0 + wid * QBLK, qm = qlo + r32 - 4 * hi;
    lptr V_lds = lds; lptr K_lds = lds + 2 * SHM_V;
    LAS float* wsc = (LAS float*)(lds + OFF_WS) + wid * 64; LAS float* li_l = wsc; LAS float* al_l = wsc + 32;
    const LAS float* Cs = (const LAS float*)(lds + OFF_CS) + 4 * hi;
    float m_reg = -1e30f, l_reg = 0; f32x16 o[4] = {};
    const int sr = tid >> 4, sc = (tid & 15) * 8, vst0 = v_st(sr, sc), vst1 = v_st(32 + sr, sc), kws = KSWZ(sr, sc * 2);
    const int vb0 = (int)(unsigned)(uintptr_t)V_lds + v_rd_base(lane);
    const bf16_t* Kh = cur.K; const bf16_t* Vh = cur.V;
    bf16x8 qr[8], st_v0, st_v1, st_k0, st_k1;
#pragma unroll
    for (int d0 = 0; d0 < 8; ++d0) qr[d0] = load8(cur.Q + (size_t)(wid * QBLK + r32) * D + d0 * 16 + hi * 8);
    SLOAD_H(Kh, Vh, 0); VMW(); SWRITE_H(0);
    __syncthreads();
#define RESC(a) do { if (__any((a) < 1.f)) { if (hi == 0) al_l[r32] = (a); asm volatile("s_waitcnt lgkmcnt(0)" ::: "memory");              \
                     _Pragma("unroll") for (int d_ = 0; d_ < 4; ++d_) _Pragma("unroll") for (int r = 0; r < 16; ++r) o[d_][r] *= al_l[crow(r, hi)]; } } while (0)
#define KBASE(t) ((t) * KVBLK)
#define MASKT(P0_, P1_, t) do { const int kb_ = KBASE(t); bias_tile(P0_, P1_, Cs + kb_); if (kb_ + KVBLK - 1 > qlo) mask_tile(P0_, P1_, qm - kb_); } while (0)
    f32x16 p0, p1; float al; bf16x8 pa0, pa1, pa2, pa3;
#define TILE_STEP(t, KB) do { \
        if ((t) + 1 < NT) { SLOAD_H(Kh, Vh, KBASE((t) + 1)); } SBAR(); \
        qkt<KB>(p0, p1, K_lds, r32, hi, qr); \
        MASKT(p0, p1, (t)); partialSM(p0, p1, m_reg, al); finishSM(p0, p1, al, l_reg, pa0, pa1, pa2, pa3); RESC(al); SBAR(); \
        pv_tile<KB>(o, vb0, pa0, pa1, pa2, pa3); SBAR(); \
        if ((t) + 1 < NT) { VMW(); SWRITE_H(1 - KB); } \
        __syncthreads(); } while (0)
    for (int t = 0; t < NT; t += 2) { TILE_STEP(t, 0); TILE_STEP(t + 1, 1); }
    if (hi == 0) li_l[r32] = l_reg; asm volatile("s_waitcnt lgkmcnt(0)" ::: "memory");
    bf16_t* Ow = cur.O + (size_t)(wid * QBLK) * DM;
#pragma unroll
    for (int r = 0; r < 16; ++r) { const int orow = crow(r, hi); const float rli = __builtin_amdgcn_rcpf(li_l[orow]);
        float v0 = o[0][r] * rli, v1 = o[1][r] * rli, v2 = o[2][r] * rli, v3 = o[3][r] * rli;
        float ss = (v0 * v0 + v1 * v1) + (v2 * v2 + v3 * v3);
        ss += __shfl_xor(ss, 1); ss += __shfl_xor(ss, 2); ss += __shfl_xor(ss, 4); ss += __shfl_xor(ss, 8); ss += __shfl_xor(ss, 16);
        const float rs = rsqrtf(ss * (1.0f / 128.0f) + EPS);
        v0 *= rs; v1 *= rs; v2 *= rs; v3 *= rs;
        const float n0 = __shfl_xor(v0, 1), n1 = __shfl_xor(v1, 1), n2 = __shfl_xor(v2, 1), n3 = __shfl_xor(v3, 1);
        if ((r32 & 1) == 0) { bf16_t* op = Ow + (size_t)orow * DM + r32;
            *(unsigned*)(op) = cvt_pk_bf16(v0, n0); *(unsigned*)(op + 32) = cvt_pk_bf16(v1, n1); *(unsigned*)(op + 64) = cvt_pk_bf16(v2, n2); *(unsigned*)(op + 96) = cvt_pk_bf16(v3, n3); } }
    __syncthreads();
#undef RESC
#undef KBASE
#undef MASKT
#undef TILE_STEP
}
#undef ROW
#undef VMW
#undef SLOAD_H
#undef SWRITE_H
__device__ __forceinline__ void attn_phase(const bf16_t* FQ, const bf16_t* FK, const bf16_t* FV, const float* cum, bf16_t* Y, lptr lds, int blk, int G, int tid_) {
    for (int it2 = 2 * blk; it2 < 512; it2 += (it2 & 1) ? 2 * G - 1 : 1) {
        const int item = it2 >> 1, pass = it2 & 1; int tid = tid_; asm volatile("" : "+v"(tid));
        const int bh = item >> 3, x = item & 7, b = bh >> 3, h = bh & 7, qb = pass ? 15 - x : x;
        if (pass == 0) {
            __syncthreads();
            LAS float* Cs = (LAS float*)(lds + OFF_CS); const f32x4* cp = (const f32x4*)(cum + (size_t)bh * SEQ);
#pragma unroll
            for (int j = 0; j < 2; ++j) { const f32x4 v = cp[tid + j * NTHREADS]; *(LAS f32x4*)(Cs + 4 * (tid + j * NTHREADS)) = v * (-1.4426950408889634f); }
        }
        const bf16_t* Qh = FQ + (size_t)bh * SEQ * D; const bf16_t* Kh = FK + (size_t)bh * SEQ * D; const bf16_t* Vh = FV + (size_t)bh * SEQ * D;
        bf16_t* Yh = Y + (size_t)b * SEQ * DM + h * D;
        BlockRef br{Qh + (size_t)qb * QB * D, Kh, Vh, Yh + (size_t)qb * QB * DM, qb * QB};
        block(br, lds, tid);
    }
}
#undef KSWZ
#undef SBAR
}


namespace mx {
typedef float f32x16 __attribute__((ext_vector_type(16)));
typedef short s16x4 __attribute__((ext_vector_type(4)));
typedef LAS char* lptr;
using fa::v_st; using fa::v_rd_base; using fa::crow; using fa::load8;
template <int OFF> __device__ __forceinline__ s16x4 trrd(int vb) { s16x4 d; asm volatile("ds_read_b64_tr_b16 %0, %1 offset:%2" : "=&v"(d) : "v"(vb), "i"(OFF) : "memory"); return d; }
#define MX_LWAIT() do { asm volatile("s_waitcnt lgkmcnt(0)" ::: "memory"); __builtin_amdgcn_sched_barrier(0); } while (0)
#define MX_RD(l, h, vb, D0, KS) do { l = mx::trrd<(D0) * 512 + (KS) * 4096>(vb); h = mx::trrd<(D0) * 512 + (KS) * 4096 + 2048>(vb); } while (0)
#define MX_CAT(l, h) ((bf16x8){l[0], l[1], l[2], l[3], h[0], h[1], h[2], h[3]})
#define MX_MFMA(a, b, c) __builtin_amdgcn_mfma_f32_32x32x16_bf16((a), (b), (c), 0, 0, 0)
#define MX_PK4(P, B_, OUT) do { unsigned a0 = cvt_pk_bf16(P[B_+0], P[B_+1]), a1 = cvt_pk_bf16(P[B_+2], P[B_+3]); \
        unsigned b0 = cvt_pk_bf16(P[B_+4], P[B_+5]), b1 = cvt_pk_bf16(P[B_+6], P[B_+7]); \
        auto r0 = __builtin_amdgcn_permlane32_swap(a0, b0, false, false); auto r1 = __builtin_amdgcn_permlane32_swap(a1, b1, false, false); \
        u32x4 w = {r0[0], r1[0], r0[1], r1[1]}; OUT = *reinterpret_cast<bf16x8*>(&w); } while (0)
__device__ __forceinline__ bf16x8 scale8(const bf16x8 v, float z) {
    const u32x4 w = *reinterpret_cast<const u32x4*>(&v); float f[8]; unpack8(w, f);
    u32x4 o; o.x = cvt_pk_bf16(f[0] * z, f[1] * z); o.y = cvt_pk_bf16(f[2] * z, f[3] * z); o.z = cvt_pk_bf16(f[4] * z, f[5] * z); o.w = cvt_pk_bf16(f[6] * z, f[7] * z);
    return *reinterpret_cast<const bf16x8*>(&o);
}
__device__ __forceinline__ void retkv_phase(const bf16_t* RK, const bf16_t* RV, float* kvT, lptr lds, int blk, int G, int tid_) {
    for (int unit = blk; unit < 16 * 64; unit += G) {
        int tid = tid_; asm volatile("" : "+v"(tid));
        const int wid = __builtin_amdgcn_readfirstlane(tid >> 6), lane = tid & 63, r32 = lane & 31, hi = lane >> 5;
        const int bhr = unit >> 6, n = unit & 63; const float l2g = ret_log2g(bhr & 3);
        const size_t rowbase = (size_t)bhr * SEQ + n * 64;
        __syncthreads();
        { const int sr = tid >> 4, sc = (tid & 15) * 8;
#pragma unroll
          for (int j = 0; j < 2; ++j) { const int rr = sr + 32 * j;
              const bf16x8 k8 = load8(RK + (rowbase + rr) * HD + sc), v8 = load8(RV + (rowbase + rr) * HD + sc);
              *(LAS bf16x8*)(lds + v_st(rr, sc)) = scale8(k8, exp2f((float)(63 - rr) * l2g));
              *(LAS bf16x8*)(lds + 16384 + v_st(rr, sc)) = v8; } }
        __syncthreads();
        const int eb = wid & 3, db0 = 2 * (wid >> 2);
        const int vbK = (int)(unsigned)(uintptr_t)lds + v_rd_base(lane) + db0 * 512, vbV = (int)(unsigned)(uintptr_t)lds + 16384 + v_rd_base(lane) + eb * 512;
        f32x16 c0 = {}, c1 = {};
#define KV_STEP(KS) do { s16x4 al, ah, b0l, b0h, b1l, b1h; MX_RD(al, ah, vbV, 0, KS); MX_RD(b0l, b0h, vbK, 0, KS); MX_RD(b1l, b1h, vbK, 1, KS); MX_LWAIT(); \
            c0 = MX_MFMA(MX_CAT(al, ah), MX_CAT(b0l, b0h), c0); c1 = MX_MFMA(MX_CAT(al, ah), MX_CAT(b1l, b1h), c1); } while (0)
        KV_STEP(0); KV_STEP(1); KV_STEP(2); KV_STEP(3);
#undef KV_STEP
        float* op = kvT + ((size_t)unit << 14) + 32 * db0 + r32;
#pragma unroll
        for (int r = 0; r < 16; ++r) { const int e = 32 * eb + crow(r, hi); op[e * 128] = c0[r]; op[e * 128 + 32] = c1[r]; }
    }
}
__device__ __forceinline__ void retscan_phase(const float* kvT, bf16_t* ST, int blk, int G, int tid) {
    for (int i = blk * NTHREADS + tid; i < 16 * 128 * 64; i += G * NTHREADS) {
        const int bhr = i >> 13, rem2 = (i & 8191) * 2; const float cd = exp2f(64.0f * ret_log2g(bhr & 3));
        float s0 = 0.f, s1 = 0.f;
#pragma unroll 8
        for (int n = 0; n < 64; ++n) { const size_t o = ((size_t)(bhr * 64 + n) << 14) + rem2; const f32x2 kv = *(const f32x2*)(kvT + o);
            *(unsigned*)(ST + o) = cvt_pk_bf16(s0, s1); s0 = s0 * cd + kv.x; s1 = s1 * cd + kv.y; }
    }
}
__device__ __forceinline__ void retout_phase(const bf16_t* RQ, const bf16_t* RK, const bf16_t* RV, const bf16_t* RG, const bf16_t* ST, bf16_t* Y, lptr lds, int blk, int G, int tid_) {
    for (int unit = blk; unit < 256; unit += G) {
        int tid = tid_; asm volatile("" : "+v"(tid));
        const int wid = __builtin_amdgcn_readfirstlane(tid >> 6), lane = tid & 63, r32 = lane & 31, hi = lane >> 5;
        const int ci = wid >> 1, tb = wid & 1, bhr = unit >> 4, n = (unit & 15) * 4 + ci, hr = bhr & 3, b = bhr >> 2;
        const float l2g = ret_log2g(hr);
        const size_t rowbase = (size_t)bhr * SEQ + n * 64;
        __syncthreads();
        { const int l128 = tb * 64 + lane, row = l128 >> 1, half = l128 & 1; const bf16_t* vp = RV + (rowbase + row) * HD + half * 64;
          bf16x8 v[8];
#pragma unroll
          for (int j = 0; j < 8; ++j) v[j] = load8(vp + 8 * j);
#pragma unroll
          for (int j = 0; j < 8; ++j) *(LAS bf16x8*)(lds + ci * 16384 + v_st(row, half * 64 + 8 * j)) = v[j]; }
        bf16x8 qf[8];
#pragma unroll
        for (int ks = 0; ks < 8; ++ks) qf[ks] = load8(RQ + (rowbase + 32 * tb + r32) * HD + 16 * ks + 8 * hi);
        __syncthreads();
        f32x16 p0 = {}, p1 = {};
#pragma unroll
        for (int ks = 0; ks < 8; ++ks) { const bf16x8 k0 = load8(RK + (rowbase + r32) * HD + 16 * ks + 8 * hi); p0 = MX_MFMA(k0, qf[ks], p0); }
        if (tb) {
#pragma unroll
            for (int ks = 0; ks < 8; ++ks) { const bf16x8 k1 = load8(RK + (rowbase + 32 + r32) * HD + 16 * ks + 8 * hi); p1 = MX_MFMA(k1, qf[ks], p1); } }
        const int t = 32 * tb + r32;
#pragma unroll
        for (int r = 0; r < 16; ++r) { const int d0 = t - crow(r, hi), d1 = d0 - 32;
            p0[r] = d0 >= 0 ? p0[r] * exp2f((float)d0 * l2g) : 0.f; p1[r] = d1 >= 0 ? p1[r] * exp2f((float)d1 * l2g) : 0.f; }
        bf16x8 pa0, pa1, pa2, pa3;
        MX_PK4(p0, 0, pa0); MX_PK4(p0, 8, pa1); MX_PK4(p1, 0, pa2); MX_PK4(p1, 8, pa3);
        f32x16 o[4] = {};
        const bf16_t* stp = ST + ((size_t)(bhr * 64 + n) << 14) + (size_t)r32 * HD + 8 * hi;
#pragma unroll
        for (int eb = 0; eb < 4; ++eb)
#pragma unroll
            for (int ks = 0; ks < 8; ++ks) { const bf16x8 sf = load8(stp + eb * 32 * HD + 16 * ks); o[eb] = MX_MFMA(qf[ks], sf, o[eb]); }
#pragma unroll
        for (int r = 0; r < 16; ++r) { const float xi = exp2f((float)(32 * tb + crow(r, hi) + 1) * l2g);
#pragma unroll
            for (int eb = 0; eb < 4; ++eb) o[eb][r] *= xi; }
        const int vb = (int)(unsigned)(uintptr_t)lds + ci * 16384 + v_rd_base(lane);
#define RO_STEP(EB) do { s16x4 l0, h0, l1, h1; MX_RD(l0, h0, vb, EB, 0); MX_RD(l1, h1, vb, EB, 1); MX_LWAIT(); \
            o[EB] = MX_MFMA(pa0, MX_CAT(l0, h0), o[EB]); o[EB] = MX_MFMA(pa1, MX_CAT(l1, h1), o[EB]); \
            if (tb) { s16x4 l2, h2, l3, h3; MX_RD(l2, h2, vb, EB, 2); MX_RD(l3, h3, vb, EB, 3); MX_LWAIT(); \
                o[EB] = MX_MFMA(pa2, MX_CAT(l2, h2), o[EB]); o[EB] = MX_MFMA(pa3, MX_CAT(l3, h3), o[EB]); } } while (0)
        RO_STEP(0); RO_STEP(1); RO_STEP(2); RO_STEP(3);
#undef RO_STEP
        const bf16_t* gp = RG + (rowbase + 32 * tb) * HD + r32; bf16_t* yp = Y + ((size_t)(b * SEQ + n * 64 + 32 * tb)) * DM + 1024 + hr * HD + r32;
#pragma unroll
        for (int r = 0; r < 16; ++r) { const int tr = crow(r, hi);
            float v0 = o[0][r], v1 = o[1][r], v2 = o[2][r], v3 = o[3][r];
            float ss = (v0 * v0 + v1 * v1) + (v2 * v2 + v3 * v3);
            ss += __shfl_xor(ss, 1); ss += __shfl_xor(ss, 2); ss += __shfl_xor(ss, 4); ss += __shfl_xor(ss, 8); ss += __shfl_xor(ss, 16);
            const float rs = rsqrtf(ss * (1.0f / 128.0f) + EPS);
            v0 *= rs * bf2f(gp[tr * HD]); v1 *= rs * bf2f(gp[tr * HD + 32]); v2 *= rs * bf2f(gp[tr * HD + 64]); v3 *= rs * bf2f(gp[tr * HD + 96]);
            const float n0 = __shfl_xor(v0, 1), n1 = __shfl_xor(v1, 1), n2 = __shfl_xor(v2, 1), n3 = __shfl_xor(v3, 1);
            if ((r32 & 1) == 0) { bf16_t* op = yp + (size_t)tr * DM;
                *(unsigned*)(op) = cvt_pk_bf16(v0, n0); *(unsigned*)(op + 32) = cvt_pk_bf16(v1, n1); *(unsigned*)(op + 64) = cvt_pk_bf16(v2, n2); *(unsigned*)(op + 96) = cvt_pk_bf16(v3, n3); } }
    }
}
__device__ __forceinline__ void gmlp_phase(const bf16_t* GU, const bf16_t* GV, const float* lng, const float* lnb, const float* wsp, const float* bsp, bf16_t* Y, lptr lds, int blk, int G, int tid_) {
    for (int pu = blk; pu < 256; pu += G) {
        int tid = tid_; asm volatile("" : "+v"(tid));
        const int wid = __builtin_amdgcn_readfirstlane(tid >> 6), lane = tid & 63, r32 = lane & 31, hi = lane >> 5;
        const int ui = wid >> 2, tb = wid & 3, unit = 2 * pu + ui, g = unit & 3, n = (unit >> 2) & 31, b = unit >> 7;
        const size_t ro = ((size_t)(b * GMG + g) * SEQ + n * 128) * HD;
        __syncthreads();
        {
            const int l256 = tb * 64 + lane, ch = l256 & 15, rsub = l256 >> 4;
            float gg[8], bb[8];
#pragma unroll
            for (int j = 0; j < 8; ++j) { gg[j] = lng[g * 128 + 8 * ch + j]; bb[j] = lnb[g * 128 + 8 * ch + j]; }
#pragma unroll 2
            for (int ps = 0; ps < 8; ++ps) { const int row = ps * 16 + rsub;
                const bf16x8 v8 = load8(GV + ro + (size_t)row * HD + 8 * ch); float f[8]; unpack8(*reinterpret_cast<const u32x4*>(&v8), f);
                float s = ((f[0] + f[1]) + (f[2] + f[3])) + ((f[4] + f[5]) + (f[6] + f[7]));
                s += __shfl_xor(s, 1); s += __shfl_xor(s, 2); s += __shfl_xor(s, 4); s += __shfl_xor(s, 8);
                const float mu = s * (1.0f / 128.0f); float q = 0.f;
#pragma unroll
                for (int j = 0; j < 8; ++j) { f[j] -= mu; q += f[j] * f[j]; }
                q += __shfl_xor(q, 1); q += __shfl_xor(q, 2); q += __shfl_xor(q, 4); q += __shfl_xor(q, 8);
                const float rs = rsqrtf(q * (1.0f / 128.0f) + EPS);
                u32x4 o; o.x = cvt_pk_bf16(f[0] * rs * gg[0] + bb[0], f[1] * rs * gg[1] + bb[1]); o.y = cvt_pk_bf16(f[2] * rs * gg[2] + bb[2], f[3] * rs * gg[3] + bb[3]);
                o.z = cvt_pk_bf16(f[4] * rs * gg[4] + bb[4], f[5] * rs * gg[5] + bb[5]); o.w = cvt_pk_bf16(f[6] * rs * gg[6] + bb[6], f[7] * rs * gg[7] + bb[7]);
                *(LAS u32x4*)(lds + ui * 32768 + (row >> 6) * 16384 + v_st(row & 63, 8 * ch)) = o; }
        }
        __syncthreads();
        f32x16 acc[4] = {};
        const int vb = (int)(unsigned)(uintptr_t)lds + ui * 32768 + v_rd_base(lane);
        const int t = 32 * tb + r32; const float* wrow = wsp + (size_t)g * 128 * 128 + (size_t)t * 128 + 8 * hi;
#define GM_STEP(KS) do { if ((KS) <= 2 * tb + 1) { const f32x4 w0 = *(const f32x4*)(wrow + 16 * (KS)), w1 = *(const f32x4*)(wrow + 16 * (KS) + 4); const int sb = 16 * (KS) + 8 * hi; \
            u32x4 aw; aw.x = cvt_pk_bf16(sb + 0 <= t ? w0[0] : 0.f, sb + 1 <= t ? w0[1] : 0.f); aw.y = cvt_pk_bf16(sb + 2 <= t ? w0[2] : 0.f, sb + 3 <= t ? w0[3] : 0.f); \
            aw.z = cvt_pk_bf16(sb + 4 <= t ? w1[0] : 0.f, sb + 5 <= t ? w1[1] : 0.f); aw.w = cvt_pk_bf16(sb + 6 <= t ? w1[2] : 0.f, sb + 7 <= t ? w1[3] : 0.f); \
            const bf16x8 af = *reinterpret_cast<const bf16x8*>(&aw); \
            s16x4 l0, h0, l1, h1, l2, h2, l3, h3; constexpr int TO = ((KS) >> 2) * 16384; \
            l0 = mx::trrd<TO + 0 * 512 + ((KS) & 3) * 4096>(vb); h0 = mx::trrd<TO + 0 * 512 + ((KS) & 3) * 4096 + 2048>(vb); l1 = mx::trrd<TO + 1 * 512 + ((KS) & 3) * 4096>(vb); h1 = mx::trrd<TO + 1 * 512 + ((KS) & 3) * 4096 + 2048>(vb); \
            l2 = mx::trrd<TO + 2 * 512 + ((KS) & 3) * 4096>(vb); h2 = mx::trrd<TO + 2 * 512 + ((KS) & 3) * 4096 + 2048>(vb); l3 = mx::trrd<TO + 3 * 512 + ((KS) & 3) * 4096>(vb); h3 = mx::trrd<TO + 3 * 512 + ((KS) & 3) * 4096 + 2048>(vb); \
            MX_LWAIT(); \
            acc[0] = MX_MFMA(af, MX_CAT(l0, h0), acc[0]); acc[1] = MX_MFMA(af, MX_CAT(l1, h1), acc[1]); acc[2] = MX_MFMA(af, MX_CAT(l2, h2), acc[2]); acc[3] = MX_MFMA(af, MX_CAT(l3, h3), acc[3]); } } while (0)
        GM_STEP(0); GM_STEP(1); GM_STEP(2); GM_STEP(3); GM_STEP(4); GM_STEP(5); GM_STEP(6); GM_STEP(7);
#undef GM_STEP
        const bf16_t* up = GU + ro + (size_t)(32 * tb) * HD + r32; bf16_t* yp = Y + ((size_t)(b * SEQ + n * 128 + 32 * tb)) * DM + 1536 + g * HD + r32;
        const float* bp = bsp + g * 128 + 32 * tb;
#pragma unroll
        for (int r = 0; r < 16; ++r) { const int tr = crow(r, hi); const float bt = bp[tr];
            float v0 = bf2f(up[tr * HD]) * (acc[0][r] + bt), v1 = bf2f(up[tr * HD + 32]) * (acc[1][r] + bt), v2 = bf2f(up[tr * HD + 64]) * (acc[2][r] + bt), v3 = bf2f(up[tr * HD + 96]) * (acc[3][r] + bt);
            float ss = (v0 * v0 + v1 * v1) + (v2 * v2 + v3 * v3);
            ss += __shfl_xor(ss, 1); ss += __shfl_xor(ss, 2); ss += __shfl_xor(ss, 4); ss += __shfl_xor(ss, 8); ss += __shfl_xor(ss, 16);
            const float rs = rsqrtf(ss * (1.0f / 128.0f) + EPS);
            v0 *= rs; v1 *= rs; v2 *= rs; v3 *= rs;
            const float n0 = __shfl_xor(v0, 1), n1 = __shfl_xor(v1, 1), n2 = __shfl_xor(v2, 1), n3 = __shfl_xor(v3, 1);
            if ((r32 & 1) == 0) { bf16_t* op = yp + (size_t)tr * DM;
                *(unsigned*)(op) = cvt_pk_bf16(v0, n0); *(unsigned*)(op + 32) = cvt_pk_bf16(v1, n1); *(unsigned*)(op + 64) = cvt_pk_bf16(v2, n2); *(unsigned*)(op + 96) = cvt_pk_bf16(v3, n3); } }
    }
}
__device__ __forceinline__ void fz_phase(const bf16_t* xb, const float* ssq, const bf16_t* wfz, const float* bf, float* logf, LAS float* rsl, int blk, int G, int tid_) {
    int tid = tid_; asm volatile("" : "+v"(tid));
    const int wid = __builtin_amdgcn_readfirstlane(tid >> 6), lane = tid & 63, r32 = lane & 31, hi = lane >> 5;
    if (wid < 2) {
        for (int rb = blk * 2 + wid; rb < MROWS / 32; rb += 2 * G) {
            const bf16_t* ap = xb + (size_t)(32 * rb + r32) * DM + 8 * hi; const bf16_t* bp = wfz + (size_t)(r32 & 7) * DM + 8 * hi;
            f32x16 c = {};
#pragma unroll 8
            for (int ks = 0; ks < DM / 16; ++ks) { const bf16x8 a = load8(ap + 16 * ks); bf16x8 bv = load8(bp + 16 * ks); if (r32 >= 8) bv = (bf16x8){0, 0, 0, 0, 0, 0, 0, 0}; c = MX_MFMA(a, bv, c); }
            { const int row = lane >> 1, hs = lane & 1; const f32x4* p = (const f32x4*)(ssq + (size_t)(32 * rb + row) * 32 + hs * 16);
              const f32x4 a0 = p[0], a1 = p[1], a2 = p[2], a3 = p[3];
              float s = (((a0.x + a0.y) + (a0.z + a0.w)) + ((a1.x + a1.y) + (a1.z + a1.w))) + (((a2.x + a2.y) + (a2.z + a2.w)) + ((a3.x + a3.y) + (a3.z + a3.w)));
              s += __shfl_xor(s, 1); if (hs == 0) rsl[wid * 32 + row] = rsqrtf(s * (1.0f / DM) + EPS); }
            asm volatile("s_waitcnt lgkmcnt(0)" ::: "memory");
            if (r32 < 8) { const float bh = bf[r32];
#pragma unroll
                for (int r = 0; r < 16; ++r) { const int row = 32 * rb + crow(r, hi); const float rs = rsl[wid * 32 + crow(r, hi)];
                    logf[((size_t)((row >> 12) * FOXH + r32)) * SEQ + (row & 4095)] = logsig_f(c[r] * rs + bh); } }
            asm volatile("s_waitcnt lgkmcnt(0)" ::: "memory");
        }
    }
}
#undef MX_LWAIT
#undef MX_RD
#undef MX_CAT
#undef MX_MFMA
#undef MX_PK4
}

template <unsigned PHMASK> __global__ void __launch_bounds__(NTHREADS, 2) fwd(Args a) {
    extern __shared__ __attribute__((aligned(16))) unsigned char lds_raw[];
    LAS unsigned char* lds = (LAS unsigned char*)lds_raw;
    const int tid0 = threadIdx.x, G0 = gridDim.x, blk0 = blockIdx.x;
    unsigned char* ws0 = a.ws;
    for (int u = tid0; u < (LDS_BYTES - LDSCTL_OFF) / 4; u += NTHREADS) ((LAS unsigned*)(lds + LDSCTL_OFF))[u] = 0u;
    __syncthreads();
    XcdBarrier bar; bar.bar = (unsigned*)(ws0 + WS_CTL) + CW_BAR; bar.x = 0; bar.st = nullptr;
    if (a.use_bar) bar = xcd_barrier_post((unsigned*)(ws0 + WS_CTL) + CW_BAR, (volatile LAS unsigned*)(lds + MISC_OFF) + 8);
#define GRID_BAR() do { if (a.use_bar) xcd_barrier(bar); } while (0)
#define IN(k) (((PHMASK >> (k)) & 1u) != 0u && a.ph_lo <= (k) && (k) < a.ph_hi)
#define REP(k) for (int rep_ = 0; rep_ < (((PROBE_MASK >> (k)) & 1u) ? 1 + PROBE_REP : 1); ++rep_)

#define LV(x) asm volatile("" : "+v"(x))
#define LS(x) asm volatile("" : "+s"(x))
#define PH_ENTER() int tid = tid0, blk = blk0, G = G0; unsigned long long zoff_ = 0ull; LV(tid); LS(blk); LS(G); LS(zoff_); unsigned char* ws = ws0 + zoff_; \
        const int lane = tid & 63, wave = __builtin_amdgcn_readfirstlane(tid >> 6), gw = blk * NWAVES + wave, ngw = G * NWAVES; (void)lane; (void)gw; (void)ngw

    if (a.l_lo == 0 && IN(0)) REP(0) { PH_ENTER(); prologue(a, ws, lds, gw, ngw, wave, lane); GRID_BAR(); }

    for (int l0 = a.l_lo; l0 < a.l_hi; ++l0) {
#define FFN_PAIR(f, PU, PD) do { \
        if (IN(PU)) REP(PU) { PH_ENTER(); int l = l0; LS(l); \
            pg8::Gemm g{(const bf16_t*)(ws + WS_XB), (const bf16_t*)(ws + WS_WGU + (size_t)(l * 2 + (f)) * SZ_WGU), MROWS, NGU, DM}; pg8::StaticOrder S; S.init(MROWS, NGU, G, blk); \
            EpiSwiGLU E{(bf16_t*)(ws + WS_HID), (const float*)(ws + WS_SSQ), (LAS float*)(lds + RSL_OFF), -1}; \
            pg8::gemm_phase<EpiSwiGLU, pg8::StaticOrder, true, true>(lds, g, S, E, tid); \
            GRID_BAR(); \
        } \
        if (IN(PD)) REP(PD) { PH_ENTER(); int l = l0; LS(l); \
            pg8::Gemm g{(const bf16_t*)(ws + WS_HID), (const bf16_t*)(ws + WS_WD + (size_t)(l * 2 + (f)) * SZ_WD), MROWS, DM, DFF}; pg8::StaticOrder S; S.init(MROWS, DM, G, blk); \
            EpiResid E{(l == 0 && (f) == 0 && rep_ == 0) ? a.in[0] : a.out, a.out, (bf16_t*)(ws + WS_XB), (float*)(ws + WS_SSQ), rep_ == 0 ? 0.5f : 0.f}; \
            pg8::gemm_phase<EpiResid, pg8::StaticOrder, true, true>(lds, g, S, E, tid); \
            GRID_BAR(); \
        } } while (0)
        FFN_PAIR(0, 1, 2);
        if (IN(3)) REP(3) { PH_ENTER(); int l = l0; LS(l);
            pg8::Gemm g{(const bf16_t*)(ws + WS_XB), (const bf16_t*)(ws + WS_WIN + (size_t)l * SZ_WIN), MROWS, NWIN, DM}; pg8::StaticOrder S; S.init(MROWS, NWIN, G, blk);
            const float* ropec = (const float*)(ws + WS_ROPE);
            EpiWin E{(const float*)(ws + WS_SSQ), (LAS float*)(lds + RSL_OFF), ropec, ropec + SEQ * 64, (bf16_t*)(ws + WS_FQ), (bf16_t*)(ws + WS_RQ), -1};
            pg8::gemm_phase<EpiWin, pg8::StaticOrder, true, true>(lds, g, S, E, tid);
            if (NAIVE_MASK & 1) fz_phase((const bf16_t*)(ws + WS_XB), (const float*)(ws + WS_SSQ), (const float*)(ws + WS_WFZ) + (size_t)l * 8 * DM, a.in[7] + l * 8, (float*)(ws + WS_LOGF), blk, G, tid);
            else mx::fz_phase((const bf16_t*)(ws + WS_XB), (const float*)(ws + WS_SSQ), (const bf16_t*)(ws + WS_WFZ) + (size_t)l * 8 * DM, a.in[7] + l * 8, (float*)(ws + WS_LOGF), (LAS float*)(lds + RSL_OFF), blk, G, tid);
            GRID_BAR();
        }
        if (IN(4)) REP(4) { PH_ENTER(); int l = l0; LS(l);
            float* logf = (float*)(ws + WS_LOGF); float* cum = (float*)(ws + WS_CUM); float* rkv = (float*)(ws + WS_RKV);
            bf16_t *RK = (bf16_t*)(ws + WS_RK), *RV = (bf16_t*)(ws + WS_RV), *GU = (bf16_t*)(ws + WS_GU), *GV = (bf16_t*)(ws + WS_GV), *Y = (bf16_t*)(ws + WS_Y);
            for (int bh = blk; bh < NB * FOXH; bh += G) cumsum_unit(logf + (size_t)bh * SEQ, cum + (size_t)bh * SEQ, (LAS float*)lds, tid);
            if (NAIVE_MASK & 2) { for (int un = blk; un < 16 * 64; un += G) { const int bhr = un >> 6, n = un & 63; const size_t ro = ((size_t)bhr * SEQ + n * 64) * HD;
                retkv_unit(RK + ro, RV + ro, rkv + (size_t)un * 128 * 128, ret_log2g(bhr & 3), (LAS float*)lds, tid); } }
            else mx::retkv_phase(RK, RV, rkv, (mx::lptr)lds, blk, G, tid);
            if (NAIVE_MASK & 4) { for (int un = blk; un < NB * 32 * GMG; un += G) { const int g = un & 3, n = (un >> 2) & 31, b = un >> 7; const size_t ro = ((size_t)(b * GMG + g) * SEQ + n * 128) * HD;
                gmlp_unit(GU + ro, GV + ro, a.in[8] + l * 512 + g * 128, a.in[9] + l * 512 + g * 128, a.in[10] + ((size_t)l * 4 + g) * 128 * 128, a.in[11] + (l * 4 + g) * 128,
                          Y + ((size_t)(b * SEQ + n * 128)) * DM + 1536 + g * 128, (LAS float*)lds, tid); } }
            else mx::gmlp_phase(GU, GV, a.in[8] + l * 512, a.in[9] + l * 512, a.in[10] + (size_t)l * 4 * 128 * 128, a.in[11] + l * 4 * 128, Y, (mx::lptr)lds, blk, G, tid);
            GRID_BAR();
        }
        if (IN(5)) REP(5) { PH_ENTER();
            float* rkv = (float*)(ws + WS_RKV); float* rsp = (float*)(ws + WS_RSP);
            if (NAIVE_MASK & 2) { for (int i = blk * NTHREADS + tid; i < 16 * 128 * 128; i += G * NTHREADS) { const int bhr = i >> 14, de = i & 16383;
                const float cd = exp2f(64.0f * ret_log2g(bhr & 3)); float st = 0.f;
                for (int n = 0; n < 64; ++n) { const size_t o = ((size_t)(bhr * 64 + n) << 14) + de; rsp[o] = st; st = st * cd + rkv[o]; } } }
            else mx::retscan_phase(rkv, (bf16_t*)rsp, blk, G, tid);
            GRID_BAR();
        }
        if (IN(6)) REP(6) {
            { PH_ENTER();
              bf16_t *RQ = (bf16_t*)(ws + WS_RQ), *RK = (bf16_t*)(ws + WS_RK), *RV = (bf16_t*)(ws + WS_RV), *RG = (bf16_t*)(ws + WS_RG), *Y = (bf16_t*)(ws + WS_Y);
              float* rsp = (float*)(ws + WS_RSP);
              if (NAIVE_MASK & 2) { for (int un = blk; un < 16 * 64; un += G) { const int bhr = un >> 6, n = un & 63, b = bhr >> 2, hr = bhr & 3; const size_t ro = ((size_t)bhr * SEQ + n * 64) * HD;
                  retout_unit(RQ + ro, RK + ro, RV + ro, RG + ro, rsp + (size_t)un * 128 * 128, Y + ((size_t)(b * SEQ + n * 64)) * DM + 1024 + hr * 128, ret_log2g(hr), (LAS float*)lds, tid); } }
              else mx::retout_phase(RQ, RK, RV, RG, (const bf16_t*)rsp, Y, (mx::lptr)lds, blk, G, tid); }
            { PH_ENTER();
              fa::attn_phase((const bf16_t*)(ws + WS_FQ), (const bf16_t*)(ws + WS_FK), (const bf16_t*)(ws + WS_FV), (const float*)(ws + WS_CUM), (bf16_t*)(ws + WS_Y), (fa::lptr)lds, blk, G, tid); }
            GRID_BAR();
        }
        if (IN(7)) REP(7) { PH_ENTER(); int l = l0; LS(l);
            pg8::Gemm g{(const bf16_t*)(ws + WS_Y), (const bf16_t*)(ws + WS_WOUT + (size_t)l * SZ_WOUT), MROWS, DM, DM}; pg8::StaticOrder S; S.init(MROWS, DM, G, blk);
            EpiResid E{a.out, a.out, (bf16_t*)(ws + WS_XB), (float*)(ws + WS_SSQ), rep_ == 0 ? 1.0f : 0.f};
            pg8::gemm_phase<EpiResid, pg8::StaticOrder, true, true>(lds, g, S, E, tid);
            GRID_BAR();
        }
        FFN_PAIR(1, 8, 9);
#undef FFN_PAIR
    }
    if (a.l_hi == DEPTH && IN(10)) { PH_ENTER();
        const float* fn = a.in[18]; const float* ssq = (const float*)(ws + WS_SSQ);
        for (int m = gw; m < MROWS; m += ngw) {
            float s = lane < 32 ? ssq[(size_t)m * 32 + lane] : 0.f; s = wave_sum(s);
            const float rs = rsqrtf(s * (1.0f / DM) + EPS);
            f32x4* xr = (f32x4*)(a.out + (size_t)m * DM);
#pragma unroll
            for (int j = 0; j < 8; ++j) { const f32x4 v = xr[j * 64 + lane], gn = ((const f32x4*)fn)[j * 64 + lane]; xr[j * 64 + lane] = v * rs * gn; }
        }
    }
#undef PH_ENTER
#undef LV
#undef LS
#undef IN
#undef GRID_BAR
}

extern "C" void kernel_launch(void* const* d_in, const int* in_sizes, int n_in, void* d_out, int out_size, void* d_ws, size_t ws_size, hipStream_t stream) {
    static int grid = 0;
    if (grid == 0) {
        if (n_in != 19 || in_sizes[0] != MROWS * DM || out_size != MROWS * DM || ws_size < WS_END) { fprintf(stderr, "kernel_launch: unexpected shapes (n_in %d, in0 %d, out %d, ws %zu < %zu)\n", n_in, n_in > 0 ? in_sizes[0] : -1, out_size, ws_size, (size_t)WS_END); grid = -1; return; }
        int dev = 0, cus = 0;
        if (hipGetDevice(&dev) != hipSuccess || hipDeviceGetAttribute(&cus, hipDeviceAttributeMultiprocessorCount, dev) != hipSuccess) { grid = -1; return; }
#define SETATTR(K) do { if (hipFuncSetAttribute((const void*)(K), hipFuncAttributeMaxDynamicSharedMemorySize, LDS_BYTES) != hipSuccess) { fprintf(stderr, "kernel_launch: hipFuncSetAttribute failed\n"); grid = -1; return; } } while (0)
#if MK_SPLIT
        SETATTR(fwd<1u << 0>); SETATTR(fwd<1u << 1>); SETATTR(fwd<1u << 2>); SETATTR(fwd<1u << 3>); SETATTR(fwd<1u << 4>); SETATTR(fwd<1u << 5>);
        SETATTR(fwd<1u << 6>); SETATTR(fwd<1u << 7>); SETATTR(fwd<1u << 8>); SETATTR(fwd<1u << 9>); SETATTR(fwd<1u << 10>);
#else
        SETATTR(fwd<0x7ffu>);
        int per_cu = 0;
        if (hipOccupancyMaxActiveBlocksPerMultiprocessor(&per_cu, (const void*)fwd<0x7ffu>, NTHREADS, LDS_BYTES) != hipSuccess || per_cu < 1) fprintf(stderr, "kernel_launch: occupancy query reports %d\n", per_cu);
        (void)hipGetLastError();
#endif
        grid = cus;
    }
    if (grid < 0) return;
    (void)hipMemsetAsync((char*)d_ws + WS_CTL, 0, CTL_ZERO_BYTES, stream);
    Args a{};
    for (int i = 0; i < 19; ++i) a.in[i] = (const float*)d_in[i];
    a.out = (float*)d_out; a.ws = (unsigned char*)d_ws; a.pad = 0;
#if MK_SPLIT
    a.use_bar = 0;
#define LAUNCH1(PH, LL, LH) do { Args p = a; p.l_lo = (LL); p.l_hi = (LH); p.ph_lo = (PH); p.ph_hi = (PH) + 1; hipLaunchKernelGGL(fwd<(1u << (PH))>, dim3(grid), dim3(NTHREADS), LDS_BYTES, stream, p); } while (0)
    LAUNCH1(0, 0, 0);
    for (int l = 0; l < DEPTH; ++l) { LAUNCH1(1, l, l + 1); LAUNCH1(2, l, l + 1); LAUNCH1(3, l, l + 1); LAUNCH1(4, l, l + 1); LAUNCH1(5, l, l + 1); LAUNCH1(6, l, l + 1); LAUNCH1(7, l, l + 1); LAUNCH1(8, l, l + 1); LAUNCH1(9, l, l + 1); }
    LAUNCH1(10, DEPTH, DEPTH);
#else
    a.use_bar = 1; a.l_lo = 0; a.l_hi = DEPTH; a.ph_lo = 0; a.ph_hi = 11;
    hipLaunchKernelGGL(fwd<0x7ffu>, dim3(grid), dim3(NTHREADS), LDS_BYTES, stream, a);
#endif
}
```

```cpp
#include <hip/hip_runtime.h>
#include <cstdio>
#include <cstdint>

#ifndef MK_SPLIT
#define MK_SPLIT 0
#endif

#ifndef PROBE_MASK
#define PROBE_MASK 0u
#endif
#ifndef NAIVE_MASK
#define NAIVE_MASK 0
#endif
#ifndef PROBE_NULLEPI
#define PROBE_NULLEPI 0
#endif
#ifndef PROBE_REP
#define PROBE_REP 1
#endif
#define LAS __attribute__((address_space(3)))
#define GAS __attribute__((address_space(1)))
typedef unsigned short bf16_t;
typedef short bf16x8 __attribute__((ext_vector_type(8)));
typedef float f32x4 __attribute__((ext_vector_type(4)));
typedef float f32x2 __attribute__((ext_vector_type(2)));
typedef unsigned u32x4 __attribute__((ext_vector_type(4)));
typedef unsigned u32x2 __attribute__((ext_vector_type(2)));

constexpr int DM = 2048, NB = 4, SEQ = 4096, DEPTH = 4, MROWS = NB * SEQ, DFF = 5632, HD = 128;
constexpr int FOXH = 8, RETH = 4, GMG = 4;
constexpr int INCOLS = 6152, NWIN = 6144, NGU = 2 * DFF;
constexpr int FZ_COL = 3072;
constexpr float EPS = 1e-6f;
constexpr int NWAVES = 8, NTHREADS = 512;

constexpr size_t MiB = 1u << 20;
constexpr size_t WS_CTL = 0, CTL_ZERO_BYTES = 1 * MiB;
constexpr size_t WS_SSQ = 1 * MiB;
constexpr size_t WS_ROPE = 3 * MiB;
constexpr size_t WS_LOGF = 5 * MiB;
constexpr size_t WS_CUM = 5 * MiB + 512 * 1024;
constexpr size_t WS_WFZ = 6 * MiB;
constexpr size_t WS_WGU = 8 * MiB;
constexpr size_t SZ_WGU = (size_t)NGU * DM * 2;
constexpr size_t WS_WD = WS_WGU + 8 * SZ_WGU;
constexpr size_t SZ_WD = (size_t)DM * DFF * 2;
constexpr size_t WS_WIN = WS_WD + 8 * SZ_WD;
constexpr size_t SZ_WIN = (size_t)NWIN * DM * 2;
constexpr size_t WS_WOUT = WS_WIN + 4 * SZ_WIN;
constexpr size_t SZ_WOUT = (size_t)DM * DM * 2;
constexpr size_t WS_XB = WS_WOUT + 4 * SZ_WOUT;
constexpr size_t WS_ACT = WS_XB + (size_t)MROWS * DM * 2;
constexpr size_t WS_HID = WS_ACT;
constexpr size_t SZ_FOX = (size_t)NB * FOXH * SEQ * HD * 2;
constexpr size_t SZ_R = (size_t)NB * RETH * SEQ * HD * 2;
constexpr size_t WS_FQ = WS_ACT, WS_FK = WS_FQ + SZ_FOX, WS_FV = WS_FK + SZ_FOX;
constexpr size_t WS_RQ = WS_FV + SZ_FOX, WS_RK = WS_RQ + SZ_R, WS_RV = WS_RK + SZ_R, WS_RG = WS_RV + SZ_R;
constexpr size_t WS_GU = WS_RG + SZ_R, WS_GV = WS_GU + SZ_R;
constexpr size_t WS_Y = WS_GV + SZ_R;
constexpr size_t WS_RKV = WS_Y + (size_t)MROWS * DM * 2;
constexpr size_t SZ_RKV = (size_t)16 * 64 * 128 * 128 * 4;
constexpr size_t WS_RSP = WS_RKV + SZ_RKV;
constexpr size_t WS_END = WS_RSP + SZ_RKV;
static_assert(WS_WGU >= WS_WFZ + (size_t)DEPTH * 8 * DM * 4, "ws map");
static_assert(WS_Y + (size_t)MROWS * DM * 2 >= WS_HID + (size_t)MROWS * DFF * 2, "hid overlay fits");

constexpr int CW_BAR = 4096;

constexpr int RING_BYTES = 131072;
constexpr int LDSCTL_OFF = RING_BYTES, MISC_OFF = LDSCTL_OFF + 320;
constexpr int LDS_BYTES = 147456;
constexpr int RSL_OFF = LDSCTL_OFF + 1024;

__device__ __forceinline__ float bf2f(unsigned h) { return __uint_as_float(h << 16); }
__device__ __forceinline__ unsigned f2bf(float f) { unsigned u = __float_as_uint(f); return (u + 0x7fffu + ((u >> 16) & 1u)) >> 16; }
__device__ __forceinline__ unsigned pk2(float lo, float hi) { return f2bf(lo) | (f2bf(hi) << 16); }
__device__ __forceinline__ unsigned cvt_pk_bf16(float lo, float hi) { unsigned r; asm volatile("v_cvt_pk_bf16_f32 %0, %1, %2" : "=v"(r) : "v"(lo), "v"(hi)); return r; }
__device__ __forceinline__ float wave_sum(float v) {
#pragma unroll
    for (int o = 1; o < 64; o <<= 1) v += __shfl_xor(v, o);
    return v;
}
__device__ __forceinline__ float silu_f(float x) { return x * __builtin_amdgcn_rcpf(1.0f + __builtin_amdgcn_exp2f(-1.4426950408889634f * x)); }
__device__ __forceinline__ float gelu_tanh_f(float x) { const float u = (2.0f * 1.4426950408889634f * 0.7978845608028654f) * (x + 0.044715f * x * x * x); return x * __builtin_amdgcn_rcpf(1.0f + __builtin_amdgcn_exp2f(-u)); }
__device__ __forceinline__ float logsig_f(float z) { return fminf(z, 0.f) - log1pf(__expf(-fabsf(z))); }
__device__ __forceinline__ void unpack8(const u32x4 w, float* f) {
    f[0] = __uint_as_float(w.x << 16); f[1] = __uint_as_float(w.x & 0xffff0000u);
    f[2] = __uint_as_float(w.y << 16); f[3] = __uint_as_float(w.y & 0xffff0000u);
    f[4] = __uint_as_float(w.z << 16); f[5] = __uint_as_float(w.z & 0xffff0000u);
    f[6] = __uint_as_float(w.w << 16); f[7] = __uint_as_float(w.w & 0xffff0000u);
}
#define LDS_WAIT() asm volatile("s_waitcnt lgkmcnt(0)" ::: "memory")
#define VM_WAIT() asm volatile("s_waitcnt vmcnt(0)" ::: "memory")

#define XB_TMO      128
#define XB_XCNT(j)  (256  + 64 * (j))
#define XB_XSUB(j)  (1280 + 64 * (j))
#define XB_XGEN(j)  (2304 + 64 * (j))
#define XB_TOP      3328
#define XB_TOPGEN   3392
#define XCD_BAR_WORDS 3456
#define XB_SPIN_CAP (1u << 22)
__device__ __forceinline__ unsigned xb_ld(unsigned* p)              { return __hip_atomic_load(p, __ATOMIC_RELAXED, __HIP_MEMORY_SCOPE_AGENT); }
__device__ __forceinline__ unsigned xb_add(unsigned* p, unsigned v) { return __hip_atomic_fetch_add(p, v, __ATOMIC_RELAXED, __HIP_MEMORY_SCOPE_AGENT); }
__device__ __forceinline__ unsigned xb_xcc_id() { return (unsigned)__builtin_amdgcn_s_getreg((3 << 11) | 20) & 0xFu; }
#define XB_SPIN(cond, bar) do { unsigned _sp = 0; while (cond) { __builtin_amdgcn_s_sleep(1); \
    if ((++_sp & 255u) == 0u) { if (xb_ld(&(bar)[XB_TMO])) break; if (_sp > XB_SPIN_CAP) { atomicAdd(&(bar)[XB_TMO], 1u); break; } } } } while (0)
struct XcdBarrier { unsigned* bar; unsigned x; volatile LAS unsigned* st; };
__device__ __forceinline__ XcdBarrier xcd_barrier_post(unsigned* bar, volatile LAS unsigned* st) {
    XcdBarrier b; b.bar = bar; b.x = xb_xcc_id(); b.st = st;
    if (threadIdx.x == 0) (void)xb_add(&bar[XB_XCNT(b.x)], 1u);
    return b;
}
__device__ __forceinline__ void xcd_barrier_complete(unsigned* bar, unsigned x, unsigned& nloc, unsigned& nx) {
    const unsigned G = gridDim.x * gridDim.y * gridDim.z;
    unsigned sum, cnt, mine, sp = 0u;
    for (;;) {
        sum = 0u; cnt = 0u; mine = 0u;
#pragma unroll
        for (unsigned j = 0; j < 16; ++j) { const unsigned c = xb_ld(&bar[XB_XCNT(j)]); sum += c; cnt += (c > 0u) ? 1u : 0u; mine = (j == x) ? c : mine; }
        if (sum == G) break;
        __builtin_amdgcn_s_sleep(1);
        if ((++sp & 255u) == 0u) { if (xb_ld(&bar[XB_TMO])) break; if (sp > XB_SPIN_CAP) { atomicAdd(&bar[XB_TMO], 1u); break; } }
    }
    nloc = mine > 0u ? mine : 1u; nx = cnt > 0u ? cnt : 1u;
}
__device__ __forceinline__ void xcd_barrier(const XcdBarrier& b) {
    asm volatile("s_waitcnt vmcnt(0)" ::: "memory");
    __syncthreads();
    if (threadIdx.x == 0) {
        unsigned long long zb_ = 0ull; asm volatile("" : "+s"(zb_));
        unsigned* bar = b.bar + zb_; unsigned bx = b.x; asm volatile("" : "+s"(bx));
        __builtin_amdgcn_s_waitcnt(0);
        unsigned nloc = b.st[0], nx = b.st[1];
        if (nloc == 0u) { xcd_barrier_complete(bar, bx, nloc, nx); b.st[0] = nloc; b.st[1] = nx; }
        const unsigned old = xb_add(&bar[XB_XSUB(bx)], 1u);
        const unsigned gen = old / nloc;
        if (old + 1u == (gen + 1u) * nloc) {
            __builtin_amdgcn_fence(__ATOMIC_RELEASE, "agent");
            asm volatile("s_waitcnt vmcnt(0)" ::: "memory");
            const unsigned og = xb_add(&bar[XB_TOP], 1u);
            const unsigned tg = og / nx;
            if (og + 1u == (tg + 1u) * nx) xb_add(&bar[XB_TOPGEN], 1u);
            else XB_SPIN(xb_ld(&bar[XB_TOPGEN]) == tg, bar);
            __builtin_amdgcn_fence(__ATOMIC_ACQUIRE, "agent");
            xb_add(&bar[XB_XGEN(bx)], 1u);
            asm volatile("s_waitcnt vmcnt(0)" ::: "memory");
        } else {
            XB_SPIN(xb_ld(&bar[XB_XGEN(bx)]) == gen, bar);
            __builtin_amdgcn_fence(__ATOMIC_ACQUIRE, "agent");
            asm volatile("s_waitcnt vmcnt(0)" ::: "memory");
        }
    }
    __syncthreads();
}

namespace pg8 {
#define PG8_LAS __attribute__((address_space(3)))
constexpr int BM = 256, BK = 64, HALF = 128, HTB = HALF * BK * 2, STAGE_BYTES = 8 * HTB, NXCD = 8, WGM = 8;
__host__ __device__ __forceinline__ int lds_byte(int r, int c) { const int st = (r >> 4) * 2 + (c >> 5), rr = r & 15, cc = c & 31, ob = rr * 64 + cc * 2; return st * 1024 + (ob ^ (((ob >> 9) & 1) << 5)); }
__host__ __device__ __forceinline__ void stage_rc(int b, int& R, int& C) { const int st = b / 1024, sb = b % 1024, swz = sb ^ (((sb >> 9) & 1) << 5); R = (st >> 1) * 16 + swz / 64; C = (st & 1) * 32 + (swz % 64) / 2; }
__host__ __device__ __forceinline__ int perm32(int rho) { const int n = rho >> 4, i = rho & 15; return 8 * (i >> 2) + 4 * n + (i & 3); }
struct Unit { int pm, pn; };
struct Gemm { const bf16_t* A; const bf16_t* Bt; int M, N, K; };
struct StaticOrder {
    int nM, nN, nwg, G, c;
    __host__ __device__ void init(int M, int N, int G_, int c_) { nM = M / BM; nN = N / BM; nwg = nM * nN; G = G_; c = c_; }
    __host__ __device__ bool next(int i, Unit& u) const {
        const long L = (long)i * G + c; if (L >= nwg) return false;
        int wgid = (int)L; { const int q = nwg / NXCD, r = nwg % NXCD, xcd = wgid % NXCD, off = wgid / NXCD; wgid = (xcd < r ? xcd * (q + 1) : r * (q + 1) + (xcd - r) * q) + off; }
        const int nig = WGM * nN, gid = wgid / nig, fm = gid * WGM, gsz = (nM - fm) < WGM ? (nM - fm) : WGM;
        u.pm = fm + ((wgid % nig) % gsz); u.pn = (wgid % nig) / gsz; return true;
    }
    __device__ __forceinline__ void a_ready(const Unit&) const {}
    __device__ __forceinline__ void done(const Unit&) const {}
};
template <class Epi, class Sched, bool ALIGN_EPI = false, bool SP2 = false>
__device__ __forceinline__ void gemm_phase(PG8_LAS unsigned char* lds, const Gemm g, const Sched& S, Epi& E, const int tid) {
    const int wid = __builtin_amdgcn_readfirstlane(tid >> 6), lane = tid & 63, wr = wid >> 2, wc = wid & 3, fr = lane & 15, fq = lane >> 4;
    const int K = g.K, nt = K / BK;
    unsigned voffA[2], voffB[2];
#pragma unroll
    for (int i = 0; i < 2; ++i) { int R, C; stage_rc(tid * 16 + i * 8192, R, C); const int Rb = Epi::PERM ? ((R & ~31) + perm32(R & 31)) : R;
        voffA[i] = (unsigned)(R * K + C) * 2u; voffB[i] = (unsigned)(Rb * K + C) * 2u; }
    const size_t kstep = (size_t)(BK * 2);
    const size_t hstep = (size_t)HALF * K * 2;
    const size_t tstep = 2 * hstep;
    const unsigned ldsw = (unsigned)wid * 1024u;
    const int aoff = lds_byte(wr * 64 + fr, fq * 8), boff = lds_byte(wc * 32 + fr, fq * 8);
#define PG8_SA(b, h) (((b) * 2 + (h)) * HTB)
#define PG8_SB(b, h) ((4 + (b) * 2 + (h)) * HTB)
#define PG8_STAGE(bufoff, gbase, voff) do { _Pragma("unroll") for (int _i = 0; _i < 2; ++_i) \
        __builtin_amdgcn_global_load_lds((const unsigned*)((const char*)(gbase) + (voff)[_i]), (PG8_LAS unsigned*)(lds + (bufoff) + ldsw + _i * 8192), 16, 0, 0); } while (0)
#define PG8_LDA(dst, b, h) do { _Pragma("unroll") for (int m = 0; m < 4; ++m) _Pragma("unroll") for (int k = 0; k < 2; ++k) dst[m][k] = *(const PG8_LAS bf16x8*)(lds + PG8_SA(b, h) + aoff + m * 2048 + k * 1024); } while (0)
#define PG8_LDB(dst, b, h) do { _Pragma("unroll") for (int n = 0; n < 2; ++n) _Pragma("unroll") for (int k = 0; k < 2; ++k) dst[n][k] = *(const PG8_LAS bf16x8*)(lds + PG8_SB(b, h) + boff + n * 2048 + k * 1024); } while (0)
#define PG8_MMA(ai, bj, At, Bt) do { __builtin_amdgcn_s_setprio(1); _Pragma("unroll") for (int m = 0; m < 4; ++m) _Pragma("unroll") for (int n = 0; n < 2; ++n) _Pragma("unroll") for (int k = 0; k < 2; ++k) \
        acc[ai][bj][m][n] = __builtin_amdgcn_mfma_f32_16x16x32_bf16(Bt[n][k], At[m][k], acc[ai][bj][m][n], 0, 0, 0); __builtin_amdgcn_s_setprio(0); } while (0)
#define PG8_WAIT_V(n) asm volatile("s_waitcnt vmcnt(" #n ")" ::: "memory")
#define PG8_WAIT_L(n) asm volatile("s_waitcnt lgkmcnt(" #n ")" ::: "memory")
#define PG8_BAR __builtin_amdgcn_s_barrier()
#define PG8_SCHED __builtin_amdgcn_sched_barrier(0)
    Unit cur, nxt; int ui = 0;
    if (!S.next(0, cur)) return;
    f32x4 acc[2][2][4][2];
#pragma unroll
    for (int a = 0; a < 2; ++a)
#pragma unroll
        for (int b = 0; b < 2; ++b)
#pragma unroll
            for (int m = 0; m < 4; ++m)
#pragma unroll
                for (int n = 0; n < 2; ++n) acc[a][b][m][n] = (f32x4){0.f, 0.f, 0.f, 0.f};
    bf16x8 At[4][2], B0[2][2], B1[2][2];
    const char* cA = (const char*)g.A + (size_t)cur.pm * tstep; const char* cB = (const char*)g.Bt + (size_t)cur.pn * tstep;
    S.a_ready(cur);
    if constexpr (SP2) {
        PG8_STAGE(PG8_SB(0, 0), cB, voffB); PG8_STAGE(PG8_SB(0, 1), cB + hstep, voffB); PG8_STAGE(PG8_SA(0, 0), cA, voffA); PG8_STAGE(PG8_SA(0, 1), cA + hstep, voffA);
        if (wr == 1) PG8_BAR;
        PG8_WAIT_V(2); PG8_BAR;
        PG8_STAGE(PG8_SB(1, 0), cB + kstep, voffB); PG8_STAGE(PG8_SA(1, 0), cA + kstep, voffA); PG8_STAGE(PG8_SB(1, 1), cB + hstep + kstep, voffB);
        PG8_WAIT_V(6); PG8_BAR;
    } else {
        PG8_STAGE(PG8_SB(0, 0), cB, voffB); PG8_STAGE(PG8_SA(0, 0), cA, voffA); PG8_STAGE(PG8_SB(0, 1), cB + hstep, voffB); PG8_STAGE(PG8_SA(0, 1), cA + hstep, voffA);
        if (wr == 1) PG8_BAR;
        PG8_WAIT_V(4); PG8_BAR;
        PG8_STAGE(PG8_SB(1, 0), cB + kstep, voffB); PG8_STAGE(PG8_SA(1, 0), cA + kstep, voffA); PG8_STAGE(PG8_SB(1, 1), cB + hstep + kstep, voffB);
        PG8_WAIT_V(6); PG8_BAR;
    }
    for (;;) {
        const bool has_next = S.next(ui + 1, nxt);
        const char* nA = has_next ? (const char*)g.A + (size_t)nxt.pm * tstep : cA; const char* nB = has_next ? (const char*)g.Bt + (size_t)nxt.pn * tstep : cB;
        for (int t = 0; t < nt; t += 2) {
            const bool last = (t == nt - 2);
            const char* a1 = cA + (size_t)(t + 1) * kstep;
            const char* a2 = last ? nA : cA + (size_t)(t + 2) * kstep; const char* b2 = last ? nB : cB + (size_t)(t + 2) * kstep;
            const char* a3 = a2 + kstep; const char* b3 = b2 + kstep;
            if (last && has_next) S.a_ready(nxt);
            if constexpr (SP2) {
            PG8_LDB(B0, 0, 0); PG8_LDB(B1, 0, 1); PG8_SCHED; PG8_LDA(At, 0, 0); PG8_STAGE(PG8_SA(1, 1), a1 + hstep, voffA);
            PG8_WAIT_V(8); PG8_WAIT_L(0); PG8_BAR; PG8_MMA(0, 0, At, B0); PG8_MMA(0, 1, At, B1); PG8_BAR; PG8_SCHED;
            PG8_LDA(At, 0, 1); PG8_STAGE(PG8_SB(0, 0), b2, voffB); PG8_STAGE(PG8_SB(0, 1), b2 + hstep, voffB); PG8_STAGE(PG8_SA(0, 0), a2, voffA);
            PG8_WAIT_V(8); PG8_WAIT_L(0); PG8_BAR; PG8_MMA(1, 0, At, B0); PG8_MMA(1, 1, At, B1); PG8_BAR; PG8_SCHED;
            PG8_LDB(B0, 1, 0); PG8_LDB(B1, 1, 1); PG8_SCHED; PG8_LDA(At, 1, 0); PG8_STAGE(PG8_SA(0, 1), a2 + hstep, voffA);
            PG8_WAIT_V(8); PG8_WAIT_L(0); PG8_BAR; PG8_MMA(0, 0, At, B0); PG8_MMA(0, 1, At, B1); PG8_BAR; PG8_SCHED;
            PG8_LDA(At, 1, 1); PG8_STAGE(PG8_SB(1, 0), b3, voffB); PG8_STAGE(PG8_SB(1, 1), b3 + hstep, voffB); PG8_STAGE(PG8_SA(1, 0), a3, voffA);
            PG8_WAIT_V(8); PG8_WAIT_L(0); PG8_BAR; PG8_MMA(1, 0, At, B0); PG8_MMA(1, 1, At, B1); PG8_BAR; PG8_SCHED;
            } else {
            PG8_LDB(B0, 0, 0); PG8_SCHED; PG8_LDA(At, 0, 0); PG8_STAGE(PG8_SA(1, 1), a1 + hstep, voffA);
            PG8_WAIT_L(8); PG8_BAR; PG8_WAIT_L(0); PG8_MMA(0, 0, At, B0); PG8_BAR; PG8_SCHED;
            PG8_LDB(B1, 0, 1); PG8_STAGE(PG8_SB(0, 0), b2, voffB);
            PG8_BAR; PG8_WAIT_L(0); PG8_MMA(0, 1, At, B1); PG8_BAR;
            PG8_LDA(At, 0, 1); PG8_STAGE(PG8_SA(0, 0), a2, voffA);
            PG8_BAR; PG8_WAIT_L(0); PG8_MMA(1, 0, At, B0); PG8_BAR; PG8_SCHED;
            PG8_STAGE(PG8_SB(0, 1), b2 + hstep, voffB);
            PG8_WAIT_V(6); PG8_BAR; PG8_MMA(1, 1, At, B1); PG8_BAR;
            PG8_LDB(B0, 1, 0); PG8_SCHED; PG8_LDA(At, 1, 0); PG8_STAGE(PG8_SA(0, 1), a2 + hstep, voffA);
            PG8_WAIT_L(8); PG8_BAR; PG8_WAIT_L(0); PG8_MMA(0, 0, At, B0); PG8_BAR; PG8_SCHED;
            PG8_LDB(B1, 1, 1); PG8_STAGE(PG8_SB(1, 0), b3, voffB);
            PG8_BAR; PG8_WAIT_L(0); PG8_MMA(0, 1, At, B1); PG8_BAR;
            PG8_LDA(At, 1, 1); PG8_STAGE(PG8_SA(1, 0), a3, voffA);
            PG8_BAR; PG8_WAIT_L(0); PG8_MMA(1, 0, At, B0); PG8_BAR; PG8_SCHED;
            PG8_STAGE(PG8_SB(1, 1), b3 + hstep, voffB);
            PG8_WAIT_V(6); PG8_BAR; PG8_MMA(1, 1, At, B1); PG8_BAR;
            }
        }
        if constexpr (ALIGN_EPI) { if (wr == 0) PG8_BAR; }
        E(acc, cur, wr, wc, fr, fq, tid); S.done(cur);
        if (!has_next) break;
#pragma unroll
        for (int a = 0; a < 2; ++a)
#pragma unroll
            for (int b = 0; b < 2; ++b)
#pragma unroll
                for (int m = 0; m < 4; ++m)
#pragma unroll
                    for (int n = 0; n < 2; ++n) acc[a][b][m][n] = (f32x4){0.f, 0.f, 0.f, 0.f};
        cur = nxt; cA = nA; cB = nB; ++ui;
        if constexpr (ALIGN_EPI) { if (wr == 1) PG8_BAR; }
    }
    PG8_WAIT_V(0);
    if constexpr (!ALIGN_EPI) { if (wr == 0) PG8_BAR; }
    PG8_BAR;
#undef PG8_SA
#undef PG8_SB
#undef PG8_STAGE
#undef PG8_LDA
#undef PG8_LDB
#undef PG8_MMA
#undef PG8_WAIT_V
#undef PG8_WAIT_L
#undef PG8_BAR
#undef PG8_SCHED
}
}

__device__ __forceinline__ float row_rstd(const float* ssq, int row, int fq) {
    const f32x4* p = (const f32x4*)(ssq + (size_t)row * 32 + fq * 8);
    const f32x4 a = p[0], b = p[1];
    float s = ((a.x + a.y) + (a.z + a.w)) + ((b.x + b.y) + (b.z + b.w));
    s += __shfl_xor(s, 16); s += __shfl_xor(s, 32);
    return rsqrtf(s * (1.0f / DM) + EPS);
}
__device__ __forceinline__ void stage_rstd(const float* ssq, int pm, LAS float* rsl, int tid) {
    const int r = tid >> 1, hs = tid & 1;
    const f32x4* p = (const f32x4*)(ssq + (size_t)(pm * 256 + r) * 32 + hs * 16);
    const f32x4 a = p[0], b = p[1], c = p[2], d = p[3];
    float s = (((a.x + a.y) + (a.z + a.w)) + ((b.x + b.y) + (b.z + b.w))) + (((c.x + c.y) + (c.z + c.w)) + ((d.x + d.y) + (d.z + d.w)));
    s += __shfl_xor(s, 1);
    if (hs == 0) rsl[r] = rsqrtf(s * (1.0f / DM) + EPS);
    asm volatile("s_waitcnt lgkmcnt(0)" ::: "memory"); __builtin_amdgcn_s_barrier(); asm volatile("" ::: "memory");
}
__device__ __forceinline__ u32x4 pack8bf(const f32x4 a, const f32x4 b) {
    u32x4 w; w.x = cvt_pk_bf16(a[0], a[1]); w.y = cvt_pk_bf16(a[2], a[3]); w.z = cvt_pk_bf16(b[0], b[1]); w.w = cvt_pk_bf16(b[2], b[3]); return w;
}
struct EpiSwiGLU {
    static constexpr bool PERM = true, AFTER_DRAIN = false;
    bf16_t* H; const float* ssq; LAS float* rsl; int cur_pm; int skip;
    __device__ __forceinline__ void operator()(const f32x4 (&acc)[2][2][4][2], const pg8::Unit& u, int wr, int wc, int fr_, int fq_, int tid) {
        int fr = fr_, fq = fq_; asm volatile("" : "+v"(fr), "+v"(fq));
        if (skip) return;
        const int row0 = u.pm * 256 + wr * 64 + fr, col0 = u.pn * 128 + wc * 32 + 8 * fq;
        if (u.pm != cur_pm) { stage_rstd(ssq, u.pm, rsl, tid); cur_pm = u.pm; }
#pragma unroll
        for (int ai = 0; ai < 2; ++ai)
#pragma unroll
            for (int m = 0; m < 4; ++m) {
                const int row = row0 + ai * 128 + m * 16;
                const float rs = rsl[wr * 64 + fr + ai * 128 + m * 16];
                f32x4 h[2];
#pragma unroll
                for (int n = 0; n < 2; ++n) { const f32x4 g = acc[ai][0][m][n] * rs, up = acc[ai][1][m][n] * rs;
#pragma unroll
                    for (int i = 0; i < 4; ++i) h[n][i] = silu_f(g[i]) * up[i]; }
                *(u32x4*)(H + (size_t)row * DFF + col0) = pack8bf(h[0], h[1]);
            }
    }
};
struct EpiResid {
    static constexpr bool PERM = true, AFTER_DRAIN = false;
    const float* xin32; bf16_t* xb; float* ssq; float alpha; int skip;
    __device__ __forceinline__ void operator()(const f32x4 (&acc)[2][2][4][2], const pg8::Unit& u, int wr, int wc, int fr_, int fq_, int tid) {
        int fr = fr_, fq = fq_; asm volatile("" : "+v"(fr), "+v"(fq));
        if (skip) return;
        const int row0 = u.pm * 256 + wr * 64 + fr, col0 = u.pn * 256 + wc * 32 + 8 * fq;
        const size_t base = (size_t)row0 * DM + col0;
        f32x4 cur[4], nxt[4];
#define ER_LD(dst, g) do { const size_t o_ = base + (size_t)((((g) >> 2) * 128 + ((g) & 3) * 16)) * DM; \
            if (xin32) { const float* p_ = xin32 + o_; dst[0] = *(const f32x4*)(p_); dst[1] = *(const f32x4*)(p_ + 4); dst[2] = *(const f32x4*)(p_ + 128); dst[3] = *(const f32x4*)(p_ + 132); } \
            else { const u32x4 w0 = *(const u32x4*)(xb + o_), w1 = *(const u32x4*)(xb + o_ + 128); float f_[8]; unpack8(w0, f_); dst[0] = (f32x4){f_[0], f_[1], f_[2], f_[3]}; dst[1] = (f32x4){f_[4], f_[5], f_[6], f_[7]}; \
                   unpack8(w1, f_); dst[2] = (f32x4){f_[0], f_[1], f_[2], f_[3]}; dst[3] = (f32x4){f_[4], f_[5], f_[6], f_[7]}; } } while (0)
        ER_LD(cur, 0);
#pragma unroll
        for (int g = 0; g < 8; ++g) {
            const int ai = g >> 2, m = g & 3;
            if (g < 7) ER_LD(nxt, g + 1);
            const size_t off = base + (size_t)(ai * 128 + m * 16) * DM; float s = 0.f;
#pragma unroll
            for (int bj = 0; bj < 2; ++bj) {
                const f32x4 n0 = cur[2 * bj] + acc[ai][bj][m][0] * alpha, n1 = cur[2 * bj + 1] + acc[ai][bj][m][1] * alpha;
                const u32x4 w = pack8bf(n0, n1);
                *(u32x4*)(xb + off + bj * 128) = w;
                float q[8]; unpack8(w, q);
                s += ((q[0] * q[0] + q[1] * q[1]) + (q[2] * q[2] + q[3] * q[3])) + ((q[4] * q[4] + q[5] * q[5]) + (q[6] * q[6] + q[7] * q[7]));
            }
            s += __shfl_xor(s, 16); s += __shfl_xor(s, 32);
            if (fq == 0) ssq[(size_t)(row0 + ai * 128 + m * 16) * 32 + u.pn * 4 + wc] = s;
#pragma unroll
            for (int j = 0; j < 4; ++j) cur[j] = nxt[j];
        }
#undef ER_LD
    }
};
struct EpiWin {
    static constexpr bool PERM = true, AFTER_DRAIN = false;
    const float* ssq; LAS float* rsl; const float* __restrict__ ropec; const float* __restrict__ ropes;
    bf16_t *FQ, *RQ; int cur_pm;
    __device__ __forceinline__ void operator()(const f32x4 (&acc)[2][2][4][2], const pg8::Unit& u, int wr, int wc, int fr_, int fq_, int tid) {
        int fr = fr_, fq = fq_; asm volatile("" : "+v"(fr), "+v"(fq));
        const int pn = u.pn, b = u.pm >> 4, s0 = (u.pm & 15) * 256 + wr * 64 + fr, rl0 = wr * 64 + fr;
        if (u.pm != cur_pm) { stage_rstd(ssq, u.pm, rsl, tid); cur_pm = u.pm; }
        if (pn < 12) {
            const int t = pn >> 2; bf16_t* base = FQ + (size_t)t * (SZ_FOX / 2);
#pragma unroll
            for (int ai = 0; ai < 2; ++ai)
#pragma unroll
                for (int m = 0; m < 4; ++m) {
                    const int s = s0 + ai * 128 + m * 16; const float rs = rsl[rl0 + ai * 128 + m * 16];
#pragma unroll
                    for (int bj = 0; bj < 2; ++bj) { const int head = 2 * (pn & 3) + bj;
                        *(u32x4*)(base + ((size_t)(b * FOXH + head) * SEQ + s) * HD + wc * 32 + 8 * fq) = pack8bf(acc[ai][bj][m][0] * rs, acc[ai][bj][m][1] * rs); }
                }
        } else if (pn < 16) {
            const int seg = (pn - 12) >> 1, hh = 2 * ((pn - 12) & 1) + (wc >> 1), dp = 32 * (wc & 1) + 8 * fq;
            bf16_t* base = RQ + (size_t)seg * (SZ_R / 2); const float ksc = seg ? 0.08838834764831845f : 1.0f;
#pragma unroll
            for (int ai = 0; ai < 2; ++ai)
#pragma unroll
                for (int m = 0; m < 4; ++m) {
                    const int s = s0 + ai * 128 + m * 16; const float rs = rsl[rl0 + ai * 128 + m * 16] * ksc;
                    const f32x4 c0 = *(const f32x4*)(ropec + (size_t)s * 64 + dp), c1 = *(const f32x4*)(ropec + (size_t)s * 64 + dp + 4);
                    const f32x4 n0 = *(const f32x4*)(ropes + (size_t)s * 64 + dp), n1 = *(const f32x4*)(ropes + (size_t)s * 64 + dp + 4);
                    const f32x4 a0 = acc[ai][0][m][0] * rs, a1 = acc[ai][0][m][1] * rs, b0 = acc[ai][1][m][0] * rs, b1 = acc[ai][1][m][1] * rs;
                    bf16_t* dst = base + ((size_t)(b * RETH + hh) * SEQ + s) * HD + dp;
                    *(u32x4*)(dst) = pack8bf(a0 * c0 - b0 * n0, a1 * c1 - b1 * n1);
                    *(u32x4*)(dst + 64) = pack8bf(a0 * n0 + b0 * c0, a1 * n1 + b1 * c1);
                    if (m & 1) asm volatile("" ::: "memory");
                }
        } else {
            const int idx = pn - 16, kind = idx >> 1;
            bf16_t* base = RQ + (size_t)(2 + kind) * (SZ_R / 2);
#pragma unroll
            for (int ai = 0; ai < 2; ++ai)
#pragma unroll
                for (int m = 0; m < 4; ++m) {
                    const int s = s0 + ai * 128 + m * 16; const float rs = rsl[rl0 + ai * 128 + m * 16];
#pragma unroll
                    for (int bj = 0; bj < 2; ++bj) { const int head = 2 * (idx & 1) + bj;
                        f32x4 v0 = acc[ai][bj][m][0] * rs, v1 = acc[ai][bj][m][1] * rs;
                        if (kind == 1) {
#pragma unroll
                            for (int i = 0; i < 4; ++i) { v0[i] = silu_f(v0[i]); v1[i] = silu_f(v1[i]); } }
                        if (kind >= 2) {
#pragma unroll
                            for (int i = 0; i < 4; ++i) { v0[i] = gelu_tanh_f(v0[i]); v1[i] = gelu_tanh_f(v1[i]); } }
                        *(u32x4*)(base + ((size_t)(b * RETH + head) * SEQ + s) * HD + wc * 32 + 8 * fq) = pack8bf(v0, v1); }
                }
        }
    }
};

struct Args {
    const float* in[19]; float* out; unsigned char* ws;
    int l_lo, l_hi, ph_lo, ph_hi;
    int use_bar, pad;
};

__device__ __forceinline__ void tr_item(const float* W, int ldw, int src_col0, int k0, const float* gain, bf16_t* WT, int K, int dst_row0, LAS float* scr, int lane) {
    float v[32];
    const float* wp = W + (size_t)(k0 + (lane >> 5)) * ldw + src_col0 + (lane & 31);
#pragma unroll
    for (int i = 0; i < 32; ++i) v[i] = wp[(size_t)(2 * i) * ldw];
    if (gain) {
#pragma unroll
        for (int i = 0; i < 32; ++i) v[i] *= gain[k0 + 2 * i + (lane >> 5)]; }
#pragma unroll
    for (int i = 0; i < 32; ++i) scr[(2 * i + (lane >> 5)) * 33 + (lane & 31)] = v[i];
    LDS_WAIT(); asm volatile("" ::: "memory");
    const int c = lane & 7;
#pragma unroll
    for (int j = 0; j < 4; ++j) { const int n = (lane >> 3) + 8 * j; const LAS float* s = scr + (8 * c) * 33 + n;
        u32x4 o; o.x = pk2(s[0 * 33], s[1 * 33]); o.y = pk2(s[2 * 33], s[3 * 33]); o.z = pk2(s[4 * 33], s[5 * 33]); o.w = pk2(s[6 * 33], s[7 * 33]);
        *(u32x4*)(WT + (size_t)(dst_row0 + n) * K + k0 + 8 * c) = o; }
    LDS_WAIT(); asm volatile("" ::: "memory");
}
constexpr int IT_GU = (DM / 64) * (DFF / 32);
constexpr int IT_D = (DFF / 64) * (DM / 32);
constexpr int IT_WIN = (DM / 64) * (NWIN / 32);
constexpr int IT_WOUT = (DM / 64) * (DM / 32);
constexpr int IT_LAYER = 4 * IT_GU + 2 * IT_D + IT_WIN + IT_WOUT;
__device__ __forceinline__ int win_src_col(int db) {
    const int t = db >> 3, bb = db & 7, bj = bb >> 2, j0 = 32 * (bb & 3);
    if (t < 12) return 32 * db;
    if (t < 16) { const int seg = (t - 12) >> 1, ts = (t - 12) & 1, hh = 2 * ts + (j0 >> 6), d = 64 * bj + (j0 & 63); return 3080 + seg * 512 + hh * 128 + d; }
    return 8 + 32 * db;
}
__device__ __forceinline__ void prologue(const Args& a, unsigned char* ws, LAS unsigned char* lds, int gw, int ngw, int wave, int lane) {
    LAS float* scr = (LAS float*)(lds + wave * 16384);
    for (int it = gw; it < DEPTH * IT_LAYER; it += ngw) {
        const int l = it / IT_LAYER; int r = it - l * IT_LAYER;
        if (r < 4 * IT_GU) {
            const int which = r / IT_GU; r -= which * IT_GU; const int f = which >> 1, isup = which & 1;
            const float* W = a.in[f ? (isup ? 16 : 15) : (isup ? 3 : 2)] + (size_t)l * DM * DFF;
            const float* gain = a.in[f ? 14 : 1] + (size_t)l * DM;
            const int kb = r / (DFF / 32), nb = r % (DFF / 32), n0 = 32 * nb;
            bf16_t* WT = (bf16_t*)(ws + WS_WGU + (size_t)(l * 2 + f) * SZ_WGU);
            tr_item(W, DFF, n0, 64 * kb, gain, WT, DM, 256 * (n0 >> 7) + (n0 & 127) + 128 * isup, scr, lane);
        } else if (r < 4 * IT_GU + 2 * IT_D) {
            r -= 4 * IT_GU; const int f = r / IT_D; r -= f * IT_D;
            const float* W = a.in[f ? 17 : 4] + (size_t)l * DFF * DM;
            const int kb = r / (DM / 32), nb = r % (DM / 32);
            bf16_t* WT = (bf16_t*)(ws + WS_WD + (size_t)(l * 2 + f) * SZ_WD);
            tr_item(W, DM, 32 * nb, 64 * kb, nullptr, WT, DFF, 32 * nb, scr, lane);
        } else if (r < 4 * IT_GU + 2 * IT_D + IT_WIN) {
            r -= 4 * IT_GU + 2 * IT_D;
            const float* W = a.in[6] + (size_t)l * DM * INCOLS; const float* gain = a.in[5] + (size_t)l * DM;
            const int kb = r / (NWIN / 32), db = r % (NWIN / 32);
            bf16_t* WT = (bf16_t*)(ws + WS_WIN + (size_t)l * SZ_WIN);
            tr_item(W, INCOLS, win_src_col(db), 64 * kb, gain, WT, DM, 32 * db, scr, lane);
        } else {
            r -= 4 * IT_GU + 2 * IT_D + IT_WIN;
            const float* W = a.in[13] + (size_t)l * DM * DM; const float* gain = a.in[12] + (size_t)l * DM;
            const int kb = r / (DM / 32), nb = r % (DM / 32);
            bf16_t* WT = (bf16_t*)(ws + WS_WOUT + (size_t)l * SZ_WOUT);
            tr_item(W, DM, 32 * nb, 64 * kb, gain, WT, DM, 32 * nb, scr, lane);
        }
    }
    {
        const float* x = a.in[0]; bf16_t* xb = (bf16_t*)(ws + WS_XB); float* ssq = (float*)(ws + WS_SSQ);
        for (int m = gw; m < MROWS; m += ngw) {
            const f32x4* xr = (const f32x4*)(x + (size_t)m * DM); float s = 0.f;
#pragma unroll
            for (int j = 0; j < 4; ++j) { const f32x4 v0 = xr[(j * 64 + lane) * 2], v1 = xr[(j * 64 + lane) * 2 + 1];
                s += (v0[0] * v0[0] + v0[1] * v0[1]) + (v0[2] * v0[2] + v0[3] * v0[3]) + (v1[0] * v1[0] + v1[1] * v1[1]) + (v1[2] * v1[2] + v1[3] * v1[3]);
                u32x4 w; w.x = pk2(v0[0], v0[1]); w.y = pk2(v0[2], v0[3]); w.z = pk2(v1[0], v1[1]); w.w = pk2(v1[2], v1[3]);
                *(u32x4*)(xb + (size_t)m * DM + (j * 64 + lane) * 8) = w; }
            s = wave_sum(s);
            if (lane < 32) ssq[(size_t)m * 32 + lane] = lane == 0 ? s : 0.f;
        }
    }
    {
        float* rc = (float*)(ws + WS_ROPE); float* rs = rc + SEQ * 64;
        const int gt = gw * 64 + lane, ngt = ngw * 64;
        for (int i = gt; i < SEQ * 64; i += ngt) { const int s = i >> 6, j = i & 63;
            const float inv = exp2f(-(float)j * (13.287712379549449f / 64.0f));
            const float ang = (float)s * inv;
            const double rev = (double)ang * 0.15915494309189535; const float fr = (float)(rev - rint(rev));
            rc[i] = __builtin_amdgcn_cosf(fr); rs[i] = __builtin_amdgcn_sinf(fr); }
        for (int i = gt; i < DEPTH * 8 * DM; i += ngt) { const int l = i / (8 * DM), r = i - l * 8 * DM, h = r / DM, k = r - h * DM;
            const float v = a.in[6][((size_t)l * DM + k) * INCOLS + FZ_COL + h] * a.in[5][(size_t)l * DM + k];
            if (NAIVE_MASK & 1) ((float*)(ws + WS_WFZ))[i] = v; else ((bf16_t*)(ws + WS_WFZ))[i] = (bf16_t)f2bf(v); }
    }
}

__device__ __forceinline__ void fz_phase(const bf16_t* xb, const float* ssq, const float* wfz, const float* bf, float* logf, int blk, int nblk, int tid) {
    const int r = tid >> 3, ks = tid & 7, lane = tid & 63;
    for (int rb = blk; rb < MROWS / 64; rb += nblk) {
        const int row = rb * 64 + r;
        float acc[8];
#pragma unroll
        for (int h = 0; h < 8; ++h) acc[h] = 0.f;
        const u32x4* xp = (const u32x4*)(xb + (size_t)row * DM + ks * 256);
        for (int c = 0; c < 32; ++c) {
            float xv[8]; unpack8(xp[c], xv);
#pragma unroll
            for (int h = 0; h < 8; ++h) { const f32x4* wp = (const f32x4*)(wfz + h * DM + ks * 256 + c * 8); const f32x4 w0 = wp[0], w1 = wp[1];
                acc[h] += (xv[0] * w0[0] + xv[1] * w0[1]) + (xv[2] * w0[2] + xv[3] * w0[3]) + (xv[4] * w1[0] + xv[5] * w1[1]) + (xv[6] * w1[2] + xv[7] * w1[3]); }
        }
#pragma unroll
        for (int h = 0; h < 8; ++h) { acc[h] += __shfl_xor(acc[h], 1); acc[h] += __shfl_xor(acc[h], 2); acc[h] += __shfl_xor(acc[h], 4); }
        const f32x4 pp = *(const f32x4*)(ssq + (size_t)row * 32 + ks * 4);
        float s = (pp[0] + pp[1]) + (pp[2] + pp[3]); s += __shfl_xor(s, 1); s += __shfl_xor(s, 2); s += __shfl_xor(s, 4);
        const float rs = rsqrtf(s * (1.0f / DM) + EPS);
        float mine = acc[0];
#pragma unroll
        for (int h = 1; h < 8; ++h) mine = (ks == h) ? acc[h] : mine;
        const int b = row >> 12, sp = row & 4095;
        logf[((size_t)(b * FOXH + ks)) * SEQ + sp] = logsig_f(mine * rs + bf[ks]);
        (void)lane;
    }
}

__device__ __forceinline__ float ret_log2g(int hr) { return log2f(1.0f - exp2f(-(5.0f + (float)hr))); }

__device__ __forceinline__ void cumsum_unit(const float* lf, float* cum, LAS float* sm, int tid) {
    const int lane = tid & 63, w = tid >> 6;
    const f32x4 a = ((const f32x4*)lf)[2 * tid], b = ((const f32x4*)lf)[2 * tid + 1];
    float v0 = a[0], v1 = v0 + a[1], v2 = v1 + a[2], v3 = v2 + a[3], v4 = v3 + b[0], v5 = v4 + b[1], v6 = v5 + b[2], v7 = v6 + b[3];
    const float tot = v7; float sc = tot;
#pragma unroll
    for (int o = 1; o < 64; o <<= 1) { const float n = __shfl_up(sc, o); if (lane >= o) sc += n; }
    if (lane == 63) sm[w] = sc;
    __syncthreads();
    float base = 0.f;
    for (int i = 0; i < w; ++i) base += sm[i];
    const float ex = base + sc - tot;
    ((f32x4*)cum)[2 * tid] = (f32x4){v0 + ex, v1 + ex, v2 + ex, v3 + ex};
    ((f32x4*)cum)[2 * tid + 1] = (f32x4){v4 + ex, v5 + ex, v6 + ex, v7 + ex};
    __syncthreads();
}
__device__ __forceinline__ void retkv_unit(const bf16_t* K, const bf16_t* V, float* kv, float l2g, LAS float* lds, int tid) {
    LAS float* Kz = lds; LAS float* Vs = lds + 64 * 128;
    { const int s = tid >> 3, c0 = (tid & 7) * 16; const float z = exp2f((float)(63 - s) * l2g);
      const u32x4* kp = (const u32x4*)(K + s * 128 + c0); const u32x4* vp = (const u32x4*)(V + s * 128 + c0);
      float f[8];
#pragma unroll
      for (int j = 0; j < 2; ++j) { unpack8(kp[j], f);
#pragma unroll
          for (int i = 0; i < 8; ++i) Kz[s * 128 + c0 + j * 8 + i] = f[i] * z;
          unpack8(vp[j], f);
#pragma unroll
          for (int i = 0; i < 8; ++i) Vs[s * 128 + c0 + j * 8 + i] = f[i]; } }
    __syncthreads();
    const int e = tid & 127, dg = tid >> 7;
    float acc[32];
#pragma unroll
    for (int i = 0; i < 32; ++i) acc[i] = 0.f;
    for (int s = 0; s < 64; ++s) { const float v = Vs[s * 128 + e];
#pragma unroll
        for (int i = 0; i < 32; ++i) acc[i] += Kz[s * 128 + dg * 32 + i] * v; }
#pragma unroll
    for (int i = 0; i < 32; ++i) kv[(size_t)(dg * 32 + i) * 128 + e] = acc[i];
    __syncthreads();
}
__device__ __forceinline__ void gmlp_unit(const bf16_t* U, const bf16_t* V, const float* lng, const float* lnb, const float* wsp, const float* bsp, bf16_t* Y  , LAS float* lds, int tid) {
    LAS float* vln = lds; LAS float* Wt = lds + 128 * 128;
    const int lane = tid & 63, w = tid >> 6;
    for (int i = 0; i < 16; ++i) { const int s = 16 * w + i;
        const unsigned pr = *(const unsigned*)(V + s * 128 + 2 * lane); const float a = bf2f(pr & 0xffffu), b = bf2f(pr >> 16);
        const float mu = wave_sum(a + b) * (1.0f / 128.0f); const float da = a - mu, db = b - mu;
        const float var = wave_sum(da * da + db * db) * (1.0f / 128.0f); const float rs = rsqrtf(var + EPS);
        vln[s * 128 + 2 * lane] = da * rs * lng[2 * lane] + lnb[2 * lane]; vln[s * 128 + 2 * lane + 1] = db * rs * lng[2 * lane + 1] + lnb[2 * lane + 1]; }
    for (int i = tid; i < 128 * 128; i += NTHREADS) { const int t = i >> 7, s = i & 127; Wt[i] = (s <= t) ? wsp[i] : 0.f; }
    __syncthreads();
    const int c = tid & 127, tg = tid >> 7;
    float acc[32];
#pragma unroll
    for (int i = 0; i < 32; ++i) acc[i] = 0.f;
    for (int s4 = 0; s4 < 32; ++s4) {
        const float x0 = vln[(4 * s4) * 128 + c], x1 = vln[(4 * s4 + 1) * 128 + c], x2 = vln[(4 * s4 + 2) * 128 + c], x3 = vln[(4 * s4 + 3) * 128 + c];
#pragma unroll
        for (int i = 0; i < 32; ++i) { const f32x4 wv = *(const LAS f32x4*)(Wt + (tg * 32 + i) * 128 + 4 * s4); acc[i] += (wv[0] * x0 + wv[1] * x1) + (wv[2] * x2 + wv[3] * x3); }
    }
    __syncthreads();
#pragma unroll
    for (int i = 0; i < 32; ++i) { const int t = tg * 32 + i; const float uu = bf2f(U[t * 128 + c]); vln[t * 128 + c] = uu * (acc[i] + bsp[t]); }
    __syncthreads();
    for (int i = 0; i < 16; ++i) { const int t = 16 * w + i; const float a = vln[t * 128 + 2 * lane], b = vln[t * 128 + 2 * lane + 1];
        const float rs = rsqrtf(wave_sum(a * a + b * b) * (1.0f / 128.0f) + EPS);
        *(unsigned*)(Y + (size_t)t * DM + 2 * lane) = pk2(a * rs, b * rs); }
    __syncthreads();
}
__device__ __forceinline__ void retout_unit(const bf16_t* Q, const bf16_t* K, const bf16_t* V, const bf16_t* G, const float* sp, bf16_t* Y, float l2g, LAS float* lds, int tid) {
    LAS float* Qs = lds; LAS float* Ks = lds + 64 * 129; LAS float* Vs = lds + 2 * 64 * 129; LAS float* Sc = Vs + 64 * 128;
    const int lane = tid & 63, w = tid >> 6;
    { const int s = tid >> 3, c0 = (tid & 7) * 16; float f[8];
      const u32x4* qp = (const u32x4*)(Q + s * 128 + c0); const u32x4* kp = (const u32x4*)(K + s * 128 + c0); const u32x4* vp = (const u32x4*)(V + s * 128 + c0);
#pragma unroll
      for (int j = 0; j < 2; ++j) {
          unpack8(qp[j], f);
#pragma unroll
          for (int i = 0; i < 8; ++i) Qs[s * 129 + c0 + j * 8 + i] = f[i];
          unpack8(kp[j], f);
#pragma unroll
          for (int i = 0; i < 8; ++i) Ks[s * 129 + c0 + j * 8 + i] = f[i];
          unpack8(vp[j], f);
#pragma unroll
          for (int i = 0; i < 8; ++i) Vs[s * 128 + c0 + j * 8 + i] = f[i]; } }
    __syncthreads();
    {
        float acc[8];
#pragma unroll
        for (int j = 0; j < 8; ++j) acc[j] = 0.f;
        for (int d = 0; d < 128; ++d) { const float kk = Ks[lane * 129 + d];
#pragma unroll
            for (int j = 0; j < 8; ++j) acc[j] += Qs[(8 * w + j) * 129 + d] * kk; }
#pragma unroll
        for (int j = 0; j < 8; ++j) { const int t = 8 * w + j; Sc[t * 64 + lane] = (lane <= t) ? acc[j] * exp2f((float)(t - lane) * l2g) : 0.f; }
    }
    __syncthreads();
    const int e = tid & 127, tg = tid >> 7;
    float o[16];
#pragma unroll
    for (int j = 0; j < 16; ++j) o[j] = 0.f;
    for (int d = 0; d < 128; ++d) { const float sv = sp[(size_t)d * 128 + e];
#pragma unroll
        for (int j = 0; j < 16; ++j) o[j] += Qs[(tg * 16 + j) * 129 + d] * sv; }
#pragma unroll
    for (int j = 0; j < 16; ++j) o[j] *= exp2f((float)(tg * 16 + j + 1) * l2g);
    for (int s = 0; s < 64; ++s) { const float v = Vs[s * 128 + e];
#pragma unroll
        for (int j = 0; j < 16; ++j) o[j] += Sc[(tg * 16 + j) * 64 + s] * v; }
    __syncthreads();
#pragma unroll
    for (int j = 0; j < 16; ++j) Ks[(tg * 16 + j) * 128 + e] = o[j];
    __syncthreads();
    for (int i = 0; i < 8; ++i) { const int t = 8 * w + i; const float a = Ks[t * 128 + 2 * lane], b = Ks[t * 128 + 2 * lane + 1];
        const float rs = rsqrtf(wave_sum(a * a + b * b) * (1.0f / 128.0f) + EPS);
        const unsigned gp = *(const unsigned*)(G + t * 128 + 2 * lane);
        *(unsigned*)(Y + (size_t)t * DM + 2 * lane) = pk2(a * rs * bf2f(gp & 0xffffu), b * rs * bf2f(gp >> 16)); }
    __syncthreads();
}
__device__ __forceinline__ void attn_naive(const bf16_t* FQ, const bf16_t* FK, const bf16_t* FV, const float* cum, bf16_t* Y, int gw, int ngw, int lane) {
    const int sub = lane & 3, rl = lane >> 2;
    for (int it = gw; it < 4 * 2048; it += ngw) {
        const int vw = it & 2047, i = it >> 11;
        const int bh = (vw >> 7) + ((i >> 1) << 4), gg = vw & 127, g = (i & 1) ? 255 - gg : gg, t = g * 16 + rl;
        float q[32], o[32];
        { const u32x4* qp = (const u32x4*)(FQ + ((size_t)bh * SEQ + t) * HD + sub * 32);
#pragma unroll
          for (int j = 0; j < 4; ++j) { float f[8]; unpack8(qp[j], f);
#pragma unroll
              for (int k = 0; k < 8; ++k) q[j * 8 + k] = f[k] * 0.08838834764831845f; } }
#pragma unroll
        for (int j = 0; j < 32; ++j) o[j] = 0.f;
        float m = -1e30f, l = 0.f; const float ct = cum[(size_t)bh * SEQ + t];
        const int smax = g * 16 + 15;
        for (int s = 0; s <= smax; ++s) {
            const u32x4* kp = (const u32x4*)(FK + ((size_t)bh * SEQ + s) * HD + sub * 32);
            float d = 0.f;
#pragma unroll
            for (int j = 0; j < 4; ++j) { float f[8]; unpack8(kp[j], f);
#pragma unroll
                for (int k = 0; k < 8; ++k) d += q[j * 8 + k] * f[k]; }
            d += __shfl_xor(d, 1); d += __shfl_xor(d, 2);
            const float logit = d + ct - cum[(size_t)bh * SEQ + s];
            const bool valid = s <= t;
            const float mn = valid ? fmaxf(m, logit) : m;
            const float corr = __expf(m - mn), p = valid ? __expf(logit - mn) : 0.f;
            l = l * corr + p; m = mn;
            const u32x4* vp = (const u32x4*)(FV + ((size_t)bh * SEQ + s) * HD + sub * 32);
#pragma unroll
            for (int j = 0; j < 4; ++j) { float f[8]; unpack8(vp[j], f);
#pragma unroll
                for (int k = 0; k < 8; ++k) o[j * 8 + k] = o[j * 8 + k] * corr + p * f[k]; }
        }
        const float inv = 1.0f / l; float ss = 0.f;
#pragma unroll
        for (int j = 0; j < 32; ++j) { o[j] *= inv; ss += o[j] * o[j]; }
        ss += __shfl_xor(ss, 1); ss += __shfl_xor(ss, 2);
        const float rs = rsqrtf(ss * (1.0f / 128.0f) + EPS);
        const int b = bh >> 3, h = bh & 7;
        bf16_t* yp = Y + ((size_t)(b * SEQ + t)) * DM + h * HD + sub * 32;
#pragma unroll
        for (int j = 0; j < 4; ++j) { u32x4 wv; wv.x = pk2(o[j * 8] * rs, o[j * 8 + 1] * rs); wv.y = pk2(o[j * 8 + 2] * rs, o[j * 8 + 3] * rs); wv.z = pk2(o[j * 8 + 4] * rs, o[j * 8 + 5] * rs); wv.w = pk2(o[j * 8 + 6] * rs, o[j * 8 + 7] * rs);
            *(u32x4*)(yp + j * 8) = wv; }
    }
}


namespace fa {
constexpr int NW = 8, QBLK = 32, KVBLK = 64, QB = 256, D = 128;
constexpr int SHM_V = 16384, SHM_K = 16384;
constexpr int OFF_WS = 2 * SHM_V + 2 * SHM_K;
constexpr int OFF_CS = OFF_WS + NW * 64 * 4;
constexpr int LDS_NEED = OFF_CS + SEQ * 4;
constexpr float C2 = 1.4426950408889634f * 0.08838834764831845f;
constexpr float THR2 = 8.f * 1.4426950408889634f;
typedef float f32x16 __attribute__((ext_vector_type(16)));
typedef short s16x4 __attribute__((ext_vector_type(4)));
typedef LAS char* lptr;
#define KSWZ(row, colB) ((row) * 256 + ((colB) ^ (((row) & 7) << 4)))
#define SBAR() __builtin_amdgcn_sched_barrier(0)
__device__ __forceinline__ int v_st(int k, int c) { const int kk = (k & ~0xC) | ((k & 4) << 1) | ((k & 8) >> 1); return ((kk >> 3) * 4 + (c >> 5)) * 512 + ((kk & 7) * 32 + (c & 31)) * 2; }
__device__ __forceinline__ int v_rd_base(int lane) { return ((lane & 3) << 3) | (((lane >> 2) & 3) << 6) | (((lane >> 4) & 1) << 5) | (((lane >> 5) & 1) << 8); }
constexpr int v_rd_off(int d0, int ks, int half) { return d0 * 512 + ks * 4096 + half * 2048; }
__device__ __forceinline__ int crow(int r, int hi) { return (r & 3) + 8 * (r >> 2) + 4 * hi; }
__device__ __forceinline__ bf16x8 load8(const bf16_t* p) { return *reinterpret_cast<const bf16x8*>(p); }
__device__ __forceinline__ void bias_tile(f32x16& p0, f32x16& p1, const LAS float* cs) {
#pragma unroll
    for (int i = 0; i < 4; ++i) { const f32x4 a = *(const LAS f32x4*)(cs + 8 * i), b = *(const LAS f32x4*)(cs + 32 + 8 * i);
#pragma unroll
        for (int j = 0; j < 4; ++j) { p0[4 * i + j] = fmaf(p0[4 * i + j], C2, a[j]); p1[4 * i + j] = fmaf(p1[4 * i + j], C2, b[j]); } }
}
__device__ __forceinline__ void mask_tile(f32x16& p0, f32x16& p1, int dq) {
    const float NEG = -__builtin_inff();
#pragma unroll
    for (int r = 0; r < 16; ++r) { const int c = (r & 3) + 8 * (r >> 2);
        if (dq - c < 0) p0[r] = NEG;
        if (dq - c - 32 < 0) p1[r] = NEG; }
}
__device__ __forceinline__ void partialSM(f32x16& p0, f32x16& p1, float& m_reg, float& alpha) {
    float pmax = p0[0];
#pragma unroll
    for (int r = 1; r < 16; ++r) pmax = fmaxf(pmax, p0[r]);
#pragma unroll
    for (int r = 0; r < 16; ++r) pmax = fmaxf(pmax, p1[r]);
    { auto rr = __builtin_amdgcn_permlane32_swap(__float_as_uint(pmax), __float_as_uint(pmax), false, false);
      pmax = fmaxf(__uint_as_float(rr[0]), __uint_as_float(rr[1])); }
    float mn;
    if (__builtin_expect(__all(pmax - m_reg <= THR2), 1)) { mn = m_reg; alpha = 1.f; }
    else { mn = fmaxf(m_reg, pmax); alpha = __builtin_amdgcn_exp2f(m_reg - mn); m_reg = mn; }
#pragma unroll
    for (int r = 0; r < 16; ++r) p0[r] = p0[r] - mn;
#pragma unroll
    for (int r = 0; r < 16; ++r) p1[r] = p1[r] - mn;
#pragma unroll
    for (int r = 0; r < 16; ++r) p0[r] = __builtin_amdgcn_exp2f(p0[r]);
}
__device__ __forceinline__ void finishSM(f32x16& p0, f32x16& p1, float alpha, float& l_reg, bf16x8& pa0, bf16x8& pa1, bf16x8& pa2, bf16x8& pa3) {
#pragma unroll
    for (int r = 0; r < 16; ++r) p1[r] = __builtin_amdgcn_exp2f(p1[r]);
    float ps = 0;
#pragma unroll
    for (int r = 0; r < 16; ++r) ps += p0[r];
#pragma unroll
    for (int r = 0; r < 16; ++r) ps += p1[r];
    { auto rr = __builtin_amdgcn_permlane32_swap(__float_as_uint(ps), __float_as_uint(ps), false, false);
      ps = __uint_as_float(rr[0]) + __uint_as_float(rr[1]); }
    l_reg = l_reg * alpha + ps;
#define PK4(P, B_, OUT) do { unsigned a0 = cvt_pk_bf16(P[B_+0], P[B_+1]), a1 = cvt_pk_bf16(P[B_+2], P[B_+3]);                          \
        unsigned b0 = cvt_pk_bf16(P[B_+4], P[B_+5]), b1 = cvt_pk_bf16(P[B_+6], P[B_+7]);                                             \
        auto r0 = __builtin_amdgcn_permlane32_swap(a0, b0, false, false); auto r1 = __builtin_amdgcn_permlane32_swap(a1, b1, false, false); \
        u32x4 w = {r0[0], r1[0], r0[1], r1[1]}; OUT = *reinterpret_cast<bf16x8*>(&w); } while (0)
    PK4(p0, 0, pa0); PK4(p0, 8, pa1); PK4(p1, 0, pa2); PK4(p1, 8, pa3);
#undef PK4
}
template <int KB>
__device__ __forceinline__ void qkt(f32x16& p0, f32x16& p1, lptr K_lds, int r32, int hi, const bf16x8* qr) {
    p0 = f32x16{}; p1 = f32x16{};
    lptr kb[4];
#pragma unroll
    for (int dd = 0; dd < 4; ++dd) kb[dd] = K_lds + KB * SHM_K + KSWZ(r32, (dd * 16 + hi * 8) * 2);
#pragma unroll
    for (int d0 = 0; d0 < 8; ++d0) { lptr a = kb[d0 & 3] + (d0 >> 2) * 128;
        bf16x8 b0 = *reinterpret_cast<const LAS bf16x8*>(a);
        bf16x8 b1 = *reinterpret_cast<const LAS bf16x8*>(a + 32 * 256);
        p0 = __builtin_amdgcn_mfma_f32_32x32x16_bf16(b0, qr[d0], p0, 0, 0, 0);
        p1 = __builtin_amdgcn_mfma_f32_32x32x16_bf16(b1, qr[d0], p1, 0, 0, 0); }
}
template <int VB>
__device__ __forceinline__ void pv_tile(f32x16* o, int vb0, bf16x8 pa0, bf16x8 pa1, bf16x8 pa2, bf16x8 pa3) {
#define TRRD(dst, off) asm volatile("ds_read_b64_tr_b16 %0, %1 offset:%2" : "=&v"(dst) : "v"(vb0), "i"(off) : "memory")
#define PV_D0(d0) do { s16x4 l0, l1, l2, l3, h0, h1, h2, h3; constexpr int b_ = VB * SHM_V + v_rd_off(d0, 0, 0); \
        TRRD(l0, b_); TRRD(h0, b_ + 2048); TRRD(l1, b_ + 4096); TRRD(h1, b_ + 6144); TRRD(l2, b_ + 8192); TRRD(h2, b_ + 10240); TRRD(l3, b_ + 12288); TRRD(h3, b_ + 14336); \
        asm volatile("s_waitcnt lgkmcnt(0)" ::: "memory"); SBAR(); \
        o[d0] = __builtin_amdgcn_mfma_f32_32x32x16_bf16(pa0, (bf16x8){l0[0], l0[1], l0[2], l0[3], h0[0], h0[1], h0[2], h0[3]}, o[d0], 0, 0, 0);   \
        o[d0] = __builtin_amdgcn_mfma_f32_32x32x16_bf16(pa1, (bf16x8){l1[0], l1[1], l1[2], l1[3], h1[0], h1[1], h1[2], h1[3]}, o[d0], 0, 0, 0);   \
        o[d0] = __builtin_amdgcn_mfma_f32_32x32x16_bf16(pa2, (bf16x8){l2[0], l2[1], l2[2], l2[3], h2[0], h2[1], h2[2], h2[3]}, o[d0], 0, 0, 0);   \
        o[d0] = __builtin_amdgcn_mfma_f32_32x32x16_bf16(pa3, (bf16x8){l3[0], l3[1], l3[2], l3[3], h3[0], h3[1], h3[2], h3[3]}, o[d0], 0, 0, 0); } while (0)
    PV_D0(0); PV_D0(1); PV_D0(2); PV_D0(3);
#undef PV_D0
#undef TRRD
}
struct BlockRef { const bf16_t* Q; const bf16_t* K; const bf16_t* V; bf16_t* O; int P0; };
#define ROW(p, k0, rr) ((p) + (size_t)((k0) + (rr)) * D + sc)
#define VMW() asm volatile("s_waitcnt vmcnt(0)" ::: "memory")
#define SLOAD_H(Kp, Vp, k0) do { st_v0 = load8(ROW(Vp, k0, sr)); st_v1 = load8(ROW(Vp, k0, 32 + sr)); st_k0 = load8(ROW(Kp, k0, sr)); st_k1 = load8(ROW(Kp, k0, 32 + sr)); } while (0)
#define SWRITE_H(bf) do { *(LAS bf16x8*)(V_lds + (bf) * SHM_V + vst0) = st_v0; *(LAS bf16x8*)(V_lds + (bf) * SHM_V + vst1) = st_v1; \
                          *(LAS bf16x8*)(K_lds + (bf) * SHM_K + kws) = st_k0; *(LAS bf16x8*)(K_lds + (bf) * SHM_K + kws + 32 * 256) = st_k1; } while (0)
__device__ __forceinline__ void block(const BlockRef& cur, lptr lds, int tid) {
    const int wid = __builtin_amdgcn_readfirstlane(tid >> 6), lane = tid & 63, r32 = lane & 31, hi = lane >> 5;
    const int NT = cur.P0 / KVBLK + 4;
    const int qlo = cur.P0 + wid * QBLK, qm = qlo + r32 - 4 * hi;
    lptr V_lds = lds; lptr K_lds = lds + 2 * SHM_V;
    LAS float* wsc = (LAS float*)(lds + OFF_WS) + wid * 64; LAS float* li_l = wsc; LAS float* al_l = wsc + 32;
    const LAS float* Cs = (const LAS float*)(lds + OFF_CS) + 4 * hi;
    float m_reg = -1e30f, l_reg = 0; f32x16 o[4] = {};
    const int sr = tid >> 4, sc = (tid & 15) * 8, vst0 = v_st(sr, sc), vst1 = v_st(32 + sr, sc), kws = KSWZ(sr, sc * 2);
    const int vb0 = (int)(unsigned)(uintptr_t)V_lds + v_rd_base(lane);
    const bf16_t* Kh = cur.K; const bf16_t* Vh = cur.V;
    bf16x8 qr[8], st_v0, st_v1, st_k0, st_k1;
#pragma unroll
    for (int d0 = 0; d0 < 8; ++d0) qr[d0] = load8(cur.Q + (size_t)(wid * QBLK + r32) * D + d0 * 16 + hi * 8);
    SLOAD_H(Kh, Vh, 0); VMW(); SWRITE_H(0);
    __syncthreads();
#define RESC(a) do { if (__any((a) < 1.f)) { if (hi == 0) al_l[r32] = (a); asm volatile("s_waitcnt lgkmcnt(0)" ::: "memory");              \
                     _Pragma("unroll") for (int d_ = 0; d_ < 4; ++d_) _Pragma("unroll") for (int r = 0; r < 16; ++r) o[d_][r] *= al_l[crow(r, hi)]; } } while (0)
#define KBASE(t) ((t) * KVBLK)
#define MASKT(P0_, P1_, t) do { const int kb_ = KBASE(t); bias_tile(P0_, P1_, Cs + kb_); if (kb_ + KVBLK - 1 > qlo) mask_tile(P0_, P1_, qm - kb_); } while (0)
    f32x16 p0, p1; float al; bf16x8 pa0, pa1, pa2, pa3;
#define TILE_STEP(t, KB) do { \
        if ((t) + 1 < NT) { SLOAD_H(Kh, Vh, KBASE((t) + 1)); } SBAR(); \
        qkt<KB>(p0, p1, K_lds, r32, hi, qr); \
        MASKT(p0, p1, (t)); partialSM(p0, p1, m_reg, al); finishSM(p0, p1, al, l_reg, pa0, pa1, pa2, pa3); RESC(al); SBAR(); \
        pv_tile<KB>(o, vb0, pa0, pa1, pa2, pa3); SBAR(); \
        if ((t) + 1 < NT) { VMW(); SWRITE_H(1 - KB); } \
        __syncthreads(); } while (0)
    for (int t = 0; t < NT; t += 2) { TILE_STEP(t, 0); TILE_STEP(t + 1, 1); }
    if (hi == 0) li_l[r32] = l_reg; asm volatile("s_waitcnt lgkmcnt(0)" ::: "memory");
    bf16_t* Ow = cur.O + (size_t)(wid * QBLK) * DM;
#pragma unroll
    for (int r = 0; r < 16; ++r) { const int orow = crow(r, hi); const float rli = __builtin_amdgcn_rcpf(li_l[orow]);
        float v0 = o[0][r] * rli, v1 = o[1][r] * rli, v2 = o[2][r] * rli, v3 = o[3][r] * rli;
        float ss = (v0 * v0 + v1 * v1) + (v2 * v2 + v3 * v3);
        ss += __shfl_xor(ss, 1); ss += __shfl_xor(ss, 2); ss += __shfl_xor(ss, 4); ss += __shfl_xor(ss, 8); ss += __shfl_xor(ss, 16);
        const float rs = rsqrtf(ss * (1.0f / 128.0f) + EPS);
        v0 *= rs; v1 *= rs; v2 *= rs; v3 *= rs;
        const float n0 = __shfl_xor(v0, 1), n1 = __shfl_xor(v1, 1), n2 = __shfl_xor(v2, 1), n3 = __shfl_xor(v3, 1);
        if ((r32 & 1) == 0) { bf16_t* op = Ow + (size_t)orow * DM + r32;
            *(unsigned*)(op) = cvt_pk_bf16(v0, n0); *(unsigned*)(op + 32) = cvt_pk_bf16(v1, n1); *(unsigned*)(op + 64) = cvt_pk_bf16(v2, n2); *(unsigned*)(op + 96) = cvt_pk_bf16(v3, n3); } }
    __syncthreads();
#undef RESC
#undef KBASE
#undef MASKT
#undef TILE_STEP
}
#undef ROW
#undef VMW
#undef SLOAD_H
#undef SWRITE_H
__device__ __forceinline__ void attn_phase(const bf16_t* FQ, const bf16_t* FK, const bf16_t* FV, const float* cum, bf16_t* Y, lptr lds, int blk, int G, int tid_) {
    for (int it2 = 2 * blk; it2 < 512; it2 += (it2 & 1) ? 2 * G - 1 : 1) {
        const int item = it2 >> 1, pass = it2 & 1; int tid = tid_; asm volatile("" : "+v"(tid));
        const int bh = item >> 3, x = item & 7, b = bh >> 3, h = bh & 7, qb = pass ? 15 - x : x;
        if (pass == 0) {
            __syncthreads();
            LAS float* Cs = (LAS float*)(lds + OFF_CS); const f32x4* cp = (const f32x4*)(cum + (size_t)bh * SEQ);
#pragma unroll
            for (int j = 0; j < 2; ++j) { const f32x4 v = cp[tid + j * NTHREADS]; *(LAS f32x4*)(Cs + 4 * (tid + j * NTHREADS)) = v * (-1.4426950408889634f); }
        }
        const bf16_t* Qh = FQ + (size_t)bh * SEQ * D; const bf16_t* Kh = FK + (size_t)bh * SEQ * D; const bf16_t* Vh = FV + (size_t)bh * SEQ * D;
        bf16_t* Yh = Y + (size_t)b * SEQ * DM + h * D;
        BlockRef br{Qh + (size_t)qb * QB * D, Kh, Vh, Yh + (size_t)qb * QB * DM, qb * QB};
        block(br, lds, tid);
    }
}
#undef KSWZ
#undef SBAR
}


namespace mx {
typedef float f32x16 __attribute__((ext_vector_type(16)));
typedef short s16x4 __attribute__((ext_vector_type(4)));
typedef LAS char* lptr;
using fa::v_st; using fa::v_rd_base; using fa::crow; using fa::load8;
template <int OFF> __device__ __forceinline__ s16x4 trrd(int vb) { s16x4 d; asm volatile("ds_read_b64_tr_b16 %0, %1 offset:%2" : "=&v"(d) : "v"(vb), "i"(OFF) : "memory"); return d; }
#define MX_LWAIT() do { asm volatile("s_waitcnt lgkmcnt(0)" ::: "memory"); __builtin_amdgcn_sched_barrier(0); } while (0)
#define MX_RD(l, h, vb, D0, KS) do { l = mx::trrd<(D0) * 512 + (KS) * 4096>(vb); h = mx::trrd<(D0) * 512 + (KS) * 4096 + 2048>(vb); } while (0)
#define MX_CAT(l, h) ((bf16x8){l[0], l[1], l[2], l[3], h[0], h[1], h[2], h[3]})
#define MX_MFMA(a, b, c) __builtin_amdgcn_mfma_f32_32x32x16_bf16((a), (b), (c), 0, 0, 0)
#define MX_PK4(P, B_, OUT) do { unsigned a0 = cvt_pk_bf16(P[B_+0], P[B_+1]), a1 = cvt_pk_bf16(P[B_+2], P[B_+3]); \
        unsigned b0 = cvt_pk_bf16(P[B_+4], P[B_+5]), b1 = cvt_pk_bf16(P[B_+6], P[B_+7]); \
        auto r0 = __builtin_amdgcn_permlane32_swap(a0, b0, false, false); auto r1 = __builtin_amdgcn_permlane32_swap(a1, b1, false, false); \
        u32x4 w = {r0[0], r1[0], r0[1], r1[1]}; OUT = *reinterpret_cast<bf16x8*>(&w); } while (0)
__device__ __forceinline__ bf16x8 scale8(const bf16x8 v, float z) {
    const u32x4 w = *reinterpret_cast<const u32x4*>(&v); float f[8]; unpack8(w, f);
    u32x4 o; o.x = cvt_pk_bf16(f[0] * z, f[1] * z); o.y = cvt_pk_bf16(f[2] * z, f[3] * z); o.z = cvt_pk_bf16(f[4] * z, f[5] * z); o.w = cvt_pk_bf16(f[6] * z, f[7] * z);
    return *reinterpret_cast<const bf16x8*>(&o);
}
__device__ __forceinline__ void retkv_phase(const bf16_t* RK, const bf16_t* RV, float* kvT, lptr lds, int blk, int G, int tid_) {
    for (int unit = blk; unit < 16 * 64; unit += G) {
        int tid = tid_; asm volatile("" : "+v"(tid));
        const int wid = __builtin_amdgcn_readfirstlane(tid >> 6), lane = tid & 63, r32 = lane & 31, hi = lane >> 5;
        const int bhr = unit >> 6, n = unit & 63; const float l2g = ret_log2g(bhr & 3);
        const size_t rowbase = (size_t)bhr * SEQ + n * 64;
        __syncthreads();
        { const int sr = tid >> 4, sc = (tid & 15) * 8;
#pragma unroll
          for (int j = 0; j < 2; ++j) { const int rr = sr + 32 * j;
              const bf16x8 k8 = load8(RK + (rowbase + rr) * HD + sc), v8 = load8(RV + (rowbase + rr) * HD + sc);
              *(LAS bf16x8*)(lds + v_st(rr, sc)) = scale8(k8, exp2f((float)(63 - rr) * l2g));
              *(LAS bf16x8*)(lds + 16384 + v_st(rr, sc)) = v8; } }
        __syncthreads();
        const int eb = wid & 3, db0 = 2 * (wid >> 2);
        const int vbK = (int)(unsigned)(uintptr_t)lds + v_rd_base(lane) + db0 * 512, vbV = (int)(unsigned)(uintptr_t)lds + 16384 + v_rd_base(lane) + eb * 512;
        f32x16 c0 = {}, c1 = {};
#define KV_STEP(KS) do { s16x4 al, ah, b0l, b0h, b1l, b1h; MX_RD(al, ah, vbV, 0, KS); MX_RD(b0l, b0h, vbK, 0, KS); MX_RD(b1l, b1h, vbK, 1, KS); MX_LWAIT(); \
            c0 = MX_MFMA(MX_CAT(al, ah), MX_CAT(b0l, b0h), c0); c1 = MX_MFMA(MX_CAT(al, ah), MX_CAT(b1l, b1h), c1); } while (0)
        KV_STEP(0); KV_STEP(1); KV_STEP(2); KV_STEP(3);
#undef KV_STEP
        float* op = kvT + ((size_t)unit << 14) + 32 * db0 + r32;
#pragma unroll
        for (int r = 0; r < 16; ++r) { const int e = 32 * eb + crow(r, hi); op[e * 128] = c0[r]; op[e * 128 + 32] = c1[r]; }
    }
}
__device__ __forceinline__ void retscan_phase(const float* kvT, bf16_t* ST, int blk, int G, int tid) {
    for (int i = blk * NTHREADS + tid; i < 16 * 128 * 64; i += G * NTHREADS) {
        const int bhr = i >> 13, rem2 = (i & 8191) * 2; const float cd = exp2f(64.0f * ret_log2g(bhr & 3));
        float s0 = 0.f, s1 = 0.f;
#pragma unroll 8
        for (int n = 0; n < 64; ++n) { const size_t o = ((size_t)(bhr * 64 + n) << 14) + rem2; const f32x2 kv = *(const f32x2*)(kvT + o);
            *(unsigned*)(ST + o) = cvt_pk_bf16(s0, s1); s0 = s0 * cd + kv.x; s1 = s1 * cd + kv.y; }
    }
}
__device__ __forceinline__ void retout_phase(const bf16_t* RQ, const bf16_t* RK, const bf16_t* RV, const bf16_t* RG, const bf16_t* ST, bf16_t* Y, lptr lds, int blk, int G, int tid_) {
    for (int unit = blk; unit < 256; unit += G) {
        int tid = tid_; asm volatile("" : "+v"(tid));
        const int wid = __builtin_amdgcn_readfirstlane(tid >> 6), lane = tid & 63, r32 = lane & 31, hi = lane >> 5;
        const int ci = wid >> 1, tb = wid & 1, bhr = unit >> 4, n = (unit & 15) * 4 + ci, hr = bhr & 3, b = bhr >> 2;
        const float l2g = ret_log2g(hr);
        const size_t rowbase = (size_t)bhr * SEQ + n * 64;
        __syncthreads();
        { const int l128 = tb * 64 + lane, row = l128 >> 1, half = l128 & 1; const bf16_t* vp = RV + (rowbase + row) * HD + half * 64;
          bf16x8 v[8];
#pragma unroll
          for (int j = 0; j < 8; ++j) v[j] = load8(vp + 8 * j);
#pragma unroll
          for (int j = 0; j < 8; ++j) *(LAS bf16x8*)(lds + ci * 16384 + v_st(row, half * 64 + 8 * j)) = v[j]; }
        bf16x8 qf[8];
#pragma unroll
        for (int ks = 0; ks < 8; ++ks) qf[ks] = load8(RQ + (rowbase + 32 * tb + r32) * HD + 16 * ks + 8 * hi);
        __syncthreads();
        f32x16 p0 = {}, p1 = {};
#pragma unroll
        for (int ks = 0; ks < 8; ++ks) { const bf16x8 k0 = load8(RK + (rowbase + r32) * HD + 16 * ks + 8 * hi); p0 = MX_MFMA(k0, qf[ks], p0); }
        if (tb) {
#pragma unroll
            for (int ks = 0; ks < 8; ++ks) { const bf16x8 k1 = load8(RK + (rowbase + 32 + r32) * HD + 16 * ks + 8 * hi); p1 = MX_MFMA(k1, qf[ks], p1); } }
        const int t = 32 * tb + r32;
#pragma unroll
        for (int r = 0; r < 16; ++r) { const int d0 = t - crow(r, hi), d1 = d0 - 32;
            p0[r] = d0 >= 0 ? p0[r] * exp2f((float)d0 * l2g) : 0.f; p1[r] = d1 >= 0 ? p1[r] * exp2f((float)d1 * l2g) : 0.f; }
        bf16x8 pa0, pa1, pa2, pa3;
        MX_PK4(p0, 0, pa0); MX_PK4(p0, 8, pa1); MX_PK4(p1, 0, pa2); MX_PK4(p1, 8, pa3);
        f32x16 o[4] = {};
        const bf16_t* stp = ST + ((size_t)(bhr * 64 + n) << 14) + (size_t)r32 * HD + 8 * hi;
#pragma unroll
        for (int eb = 0; eb < 4; ++eb)
#pragma unroll
            for (int ks = 0; ks < 8; ++ks) { const bf16x8 sf = load8(stp + eb * 32 * HD + 16 * ks); o[eb] = MX_MFMA(qf[ks], sf, o[eb]); }
#pragma unroll
        for (int r = 0; r < 16; ++r) { const float xi = exp2f((float)(32 * tb + crow(r, hi) + 1) * l2g);
#pragma unroll
            for (int eb = 0; eb < 4; ++eb) o[eb][r] *= xi; }
        const int vb = (int)(unsigned)(uintptr_t)lds + ci * 16384 + v_rd_base(lane);
#define RO_STEP(EB) do { s16x4 l0, h0, l1, h1; MX_RD(l0, h0, vb, EB, 0); MX_RD(l1, h1, vb, EB, 1); MX_LWAIT(); \
            o[EB] = MX_MFMA(pa0, MX_CAT(l0, h0), o[EB]); o[EB] = MX_MFMA(pa1, MX_CAT(l1, h1), o[EB]); \
            if (tb) { s16x4 l2, h2, l3, h3; MX_RD(l2, h2, vb, EB, 2); MX_RD(l3, h3, vb, EB, 3); MX_LWAIT(); \
                o[EB] = MX_MFMA(pa2, MX_CAT(l2, h2), o[EB]); o[EB] = MX_MFMA(pa3, MX_CAT(l3, h3), o[EB]); } } while (0)
        RO_STEP(0); RO_STEP(1); RO_STEP(2); RO_STEP(3);
#undef RO_STEP
        const bf16_t* gp = RG + (rowbase + 32 * tb) * HD + r32; bf16_t* yp = Y + ((size_t)(b * SEQ + n * 64 + 32 * tb)) * DM + 1024 + hr * HD + r32;
#pragma unroll
        for (int r = 0; r < 16; ++r) { const int tr = crow(r, hi);
            float v0 = o[0][r], v1 = o[1][r], v2 = o[2][r], v3 = o[3][r];
            float ss = (v0 * v0 + v1 * v1) + (v2 * v2 + v3 * v3);
            ss += __shfl_xor(ss, 1); ss += __shfl_xor(ss, 2); ss += __shfl_xor(ss, 4); ss += __shfl_xor(ss, 8); ss += __shfl_xor(ss, 16);
            const float rs = rsqrtf(ss * (1.0f / 128.0f) + EPS);
            v0 *= rs * bf2f(gp[tr * HD]); v1 *= rs * bf2f(gp[tr * HD + 32]); v2 *= rs * bf2f(gp[tr * HD + 64]); v3 *= rs * bf2f(gp[tr * HD + 96]);
            const float n0 = __shfl_xor(v0, 1), n1 = __shfl_xor(v1, 1), n2 = __shfl_xor(v2, 1), n3 = __shfl_xor(v3, 1);
            if ((r32 & 1) == 0) { bf16_t* op = yp + (size_t)tr * DM;
                *(unsigned*)(op) = cvt_pk_bf16(v0, n0); *(unsigned*)(op + 32) = cvt_pk_bf16(v1, n1); *(unsigned*)(op + 64) = cvt_pk_bf16(v2, n2); *(unsigned*)(op + 96) = cvt_pk_bf16(v3, n3); } }
    }
}
__device__ __forceinline__ void gmlp_phase(const bf16_t* GU, const bf16_t* GV, const float* lng, const float* lnb, const float* wsp, const float* bsp, bf16_t* Y, lptr lds, int blk, int G, int tid_) {
    for (int pu = blk; pu < 256; pu += G) {
        int tid = tid_; asm volatile("" : "+v"(tid));
        const int wid = __builtin_amdgcn_readfirstlane(tid >> 6), lane = tid & 63, r32 = lane & 31, hi = lane >> 5;
        const int ui = wid >> 2, tb = wid & 3, unit = 2 * pu + ui, g = unit & 3, n = (unit >> 2) & 31, b = unit >> 7;
        const size_t ro = ((size_t)(b * GMG + g) * SEQ + n * 128) * HD;
        __syncthreads();
        {
            const int l256 = tb * 64 + lane, ch = l256 & 15, rsub = l256 >> 4;
            float gg[8], bb[8];
#pragma unroll
            for (int j = 0; j < 8; ++j) { gg[j] = lng[g * 128 + 8 * ch + j]; bb[j] = lnb[g * 128 + 8 * ch + j]; }
#pragma unroll 2
            for (int ps = 0; ps < 8; ++ps) { const int row = ps * 16 + rsub;
                const bf16x8 v8 = load8(GV + ro + (size_t)row * HD + 8 * ch); float f[8]; unpack8(*reinterpret_cast<const u32x4*>(&v8), f);
                float s = ((f[0] + f[1]) + (f[2] + f[3])) + ((f[4] + f[5]) + (f[6] + f[7]));
                s += __shfl_xor(s, 1); s += __shfl_xor(s, 2); s += __shfl_xor(s, 4); s += __shfl_xor(s, 8);
                const float mu = s * (1.0f / 128.0f); float q = 0.f;
#pragma unroll
                for (int j = 0; j < 8; ++j) { f[j] -= mu; q += f[j] * f[j]; }
                q += __shfl_xor(q, 1); q += __shfl_xor(q, 2); q += __shfl_xor(q, 4); q += __shfl_xor(q, 8);
                const float rs = rsqrtf(q * (1.0f / 128.0f) + EPS);
                u32x4 o; o.x = cvt_pk_bf16(f[0] * rs * gg[0] + bb[0], f[1] * rs * gg[1] + bb[1]); o.y = cvt_pk_bf16(f[2] * rs * gg[2] + bb[2], f[3] * rs * gg[3] + bb[3]);
                o.z = cvt_pk_bf16(f[4] * rs * gg[4] + bb[4], f[5] * rs * gg[5] + bb[5]); o.w = cvt_pk_bf16(f[6] * rs * gg[6] + bb[6], f[7] * rs * gg[7] + bb[7]);
                *(LAS u32x4*)(lds + ui * 32768 + (row >> 6) * 16384 + v_st(row & 63, 8 * ch)) = o; }
        }
        __syncthreads();
        f32x16 acc[4] = {};
        const int vb = (int)(unsigned)(uintptr_t)lds + ui * 32768 + v_rd_base(lane);
        const int t = 32 * tb + r32; const float* wrow = wsp + (size_t)g * 128 * 128 + (size_t)t * 128 + 8 * hi;
#define GM_STEP(KS) do { if ((KS) <= 2 * tb + 1) { const f32x4 w0 = *(const f32x4*)(wrow + 16 * (KS)), w1 = *(const f32x4*)(wrow + 16 * (KS) + 4); const int sb = 16 * (KS) + 8 * hi; \
            u32x4 aw; aw.x = cvt_pk_bf16(sb + 0 <= t ? w0[0] : 0.f, sb + 1 <= t ? w0[1] : 0.f); aw.y = cvt_pk_bf16(sb + 2 <= t ? w0[2] : 0.f, sb + 3 <= t ? w0[3] : 0.f); \
            aw.z = cvt_pk_bf16(sb + 4 <= t ? w1[0] : 0.f, sb + 5 <= t ? w1[1] : 0.f); aw.w = cvt_pk_bf16(sb + 6 <= t ? w1[2] : 0.f, sb + 7 <= t ? w1[3] : 0.f); \
            const bf16x8 af = *reinterpret_cast<const bf16x8*>(&aw); \
            s16x4 l0, h0, l1, h1, l2, h2, l3, h3; constexpr int TO = ((KS) >> 2) * 16384; \
            l0 = mx::trrd<TO + 0 * 512 + ((KS) & 3) * 4096>(vb); h0 = mx::trrd<TO + 0 * 512 + ((KS) & 3) * 4096 + 2048>(vb); l1 = mx::trrd<TO + 1 * 512 + ((KS) & 3) * 4096>(vb); h1 = mx::trrd<TO + 1 * 512 + ((KS) & 3) * 4096 + 2048>(vb); \
            l2 = mx::trrd<TO + 2 * 512 + ((KS) & 3) * 4096>(vb); h2 = mx::trrd<TO + 2 * 512 + ((KS) & 3) * 4096 + 2048>(vb); l3 = mx::trrd<TO + 3 * 512 + ((KS) & 3) * 4096>(vb); h3 = mx::trrd<TO + 3 * 512 + ((KS) & 3) * 4096 + 2048>(vb); \
            MX_LWAIT(); \
            acc[0] = MX_MFMA(af, MX_CAT(l0, h0), acc[0]); acc[1] = MX_MFMA(af, MX_CAT(l1, h1), acc[1]); acc[2] = MX_MFMA(af, MX_CAT(l2, h2), acc[2]); acc[3] = MX_MFMA(af, MX_CAT(l3, h3), acc[3]); } } while (0)
        GM_STEP(0); GM_STEP(1); GM_STEP(2); GM_STEP(3); GM_STEP(4); GM_STEP(5); GM_STEP(6); GM_STEP(7);
#undef GM_STEP
        const bf16_t* up = GU + ro + (size_t)(32 * tb) * HD + r32; bf16_t* yp = Y + ((size_t)(b * SEQ + n * 128 + 32 * tb)) * DM + 1536 + g * HD + r32;
        const float* bp = bsp + g * 128 + 32 * tb;
#pragma unroll
        for (int r = 0; r < 16; ++r) { const int tr = crow(r, hi); const float bt = bp[tr];
            float v0 = bf2f(up[tr * HD]) * (acc[0][r] + bt), v1 = bf2f(up[tr * HD + 32]) * (acc[1][r] + bt), v2 = bf2f(up[tr * HD + 64]) * (acc[2][r] + bt), v3 = bf2f(up[tr * HD + 96]) * (acc[3][r] + bt);
            float ss = (v0 * v0 + v1 * v1) + (v2 * v2 + v3 * v3);
            ss += __shfl_xor(ss, 1); ss += __shfl_xor(ss, 2); ss += __shfl_xor(ss, 4); ss += __shfl_xor(ss, 8); ss += __shfl_xor(ss, 16);
            const float rs = rsqrtf(ss * (1.0f / 128.0f) + EPS);
            v0 *= rs; v1 *= rs; v2 *= rs; v3 *= rs;
            const float n0 = __shfl_xor(v0, 1), n1 = __shfl_xor(v1, 1), n2 = __shfl_xor(v2, 1), n3 = __shfl_xor(v3, 1);
            if ((r32 & 1) == 0) { bf16_t* op = yp + (size_t)tr * DM;
                *(unsigned*)(op) = cvt_pk_bf16(v0, n0); *(unsigned*)(op + 32) = cvt_pk_bf16(v1, n1); *(unsigned*)(op + 64) = cvt_pk_bf16(v2, n2); *(unsigned*)(op + 96) = cvt_pk_bf16(v3, n3); } }
    }
}
__device__ __forceinline__ void fz_phase(const bf16_t* xb, const float* ssq, const bf16_t* wfz, const float* bf, float* logf, LAS float* rsl, int blk, int G, int tid_) {
    int tid = tid_; asm volatile("" : "+v"(tid));
    const int wid = __builtin_amdgcn_readfirstlane(tid >> 6), lane = tid & 63, r32 = lane & 31, hi = lane >> 5;
    if (wid < 2) {
        for (int rb = blk * 2 + wid; rb < MROWS / 32; rb += 2 * G) {
            const bf16_t* ap = xb + (size_t)(32 * rb + r32) * DM + 8 * hi; const bf16_t* bp = wfz + (size_t)(r32 & 7) * DM + 8 * hi;
            f32x16 c = {};
#pragma unroll 8
            for (int ks = 0; ks < DM / 16; ++ks) { const bf16x8 a = load8(ap + 16 * ks); bf16x8 bv = load8(bp + 16 * ks); if (r32 >= 8) bv = (bf16x8){0, 0, 0, 0, 0, 0, 0, 0}; c = MX_MFMA(a, bv, c); }
            { const int row = lane >> 1, hs = lane & 1; const f32x4* p = (const f32x4*)(ssq + (size_t)(32 * rb + row) * 32 + hs * 16);
              const f32x4 a0 = p[0], a1 = p[1], a2 = p[2], a3 = p[3];
              float s = (((a0.x + a0.y) + (a0.z + a0.w)) + ((a1.x + a1.y) + (a1.z + a1.w))) + (((a2.x + a2.y) + (a2.z + a2.w)) + ((a3.x + a3.y) + (a3.z + a3.w)));
              s += __shfl_xor(s, 1); if (hs == 0) rsl[wid * 32 + row] = rsqrtf(s * (1.0f / DM) + EPS); }
            asm volatile("s_waitcnt lgkmcnt(0)" ::: "memory");
            if (r32 < 8) { const float bh = bf[r32];
#pragma unroll
                for (int r = 0; r < 16; ++r) { const int row = 32 * rb + crow(r, hi); const float rs = rsl[wid * 32 + crow(r, hi)];
                    logf[((size_t)((row >> 12) * FOXH + r32)) * SEQ + (row & 4095)] = logsig_f(c[r] * rs + bh); } }
            asm volatile("s_waitcnt lgkmcnt(0)" ::: "memory");
        }
    }
}
#undef MX_LWAIT
#undef MX_RD
#undef MX_CAT
#undef MX_MFMA
#undef MX_PK4
}

template <unsigned PHMASK> __global__ void __launch_bounds__(NTHREADS, 2) fwd(Args a) {
    extern __shared__ __attribute__((aligned(16))) unsigned char lds_raw[];
    LAS unsigned char* lds = (LAS unsigned char*)lds_raw;
    const int tid0 = threadIdx.x, G0 = gridDim.x, blk0 = blockIdx.x;
    unsigned char* ws0 = a.ws;
    for (int u = tid0; u < (LDS_BYTES - LDSCTL_OFF) / 4; u += NTHREADS) ((LAS unsigned*)(lds + LDSCTL_OFF))[u] = 0u;
    __syncthreads();
    XcdBarrier bar; bar.bar = (unsigned*)(ws0 + WS_CTL) + CW_BAR; bar.x = 0; bar.st = nullptr;
    if (a.use_bar) bar = xcd_barrier_post((unsigned*)(ws0 + WS_CTL) + CW_BAR, (volatile LAS unsigned*)(lds + MISC_OFF) + 8);
#define GRID_BAR() do { if (a.use_bar) xcd_barrier(bar); } while (0)
#define IN(k) (((PHMASK >> (k)) & 1u) != 0u && a.ph_lo <= (k) && (k) < a.ph_hi)
#define REP(k) for (int rep_ = 0; rep_ < (((PROBE_MASK >> (k)) & 1u) ? 1 + PROBE_REP : 1); ++rep_)

#define LV(x) asm volatile("" : "+v"(x))
#define LS(x) asm volatile("" : "+s"(x))
#define PH_ENTER() int tid = tid0, blk = blk0, G = G0; unsigned long long zoff_ = 0ull; LV(tid); LS(blk); LS(G); LS(zoff_); unsigned char* ws = ws0 + zoff_; \
        const int lane = tid & 63, wave = __builtin_amdgcn_readfirstlane(tid >> 6), gw = blk * NWAVES + wave, ngw = G * NWAVES; (void)lane; (void)gw; (void)ngw

    if (a.l_lo == 0 && IN(0)) REP(0) { PH_ENTER(); prologue(a, ws, lds, gw, ngw, wave, lane); GRID_BAR(); }

    for (int l0 = a.l_lo; l0 < a.l_hi; ++l0) {
#define FFN_PAIR(f, PU, PD) do { \
        if (IN(PU)) REP(PU) { PH_ENTER(); int l = l0; LS(l); \
            pg8::Gemm g{(const bf16_t*)(ws + WS_XB), (const bf16_t*)(ws + WS_WGU + (size_t)(l * 2 + (f)) * SZ_WGU), MROWS, NGU, DM}; pg8::StaticOrder S; S.init(MROWS, NGU, G, blk); \
            EpiSwiGLU E{(bf16_t*)(ws + WS_HID), (const float*)(ws + WS_SSQ), (LAS float*)(lds + RSL_OFF), -1, (PROBE_NULLEPI && rep_ > 0) ? 1 : 0}; \
            pg8::gemm_phase<EpiSwiGLU, pg8::StaticOrder, true, true>(lds, g, S, E, tid); \
            GRID_BAR(); \
        } \
        if (IN(PD)) REP(PD) { PH_ENTER(); int l = l0; LS(l); \
            pg8::Gemm g{(const bf16_t*)(ws + WS_HID), (const bf16_t*)(ws + WS_WD + (size_t)(l * 2 + (f)) * SZ_WD), MROWS, DM, DFF}; pg8::StaticOrder S; S.init(MROWS, DM, G, blk); \
            EpiResid E{(l == 0 && (f) == 0 && rep_ == 0) ? a.in[0] : (const float*)nullptr, (bf16_t*)(ws + WS_XB), (float*)(ws + WS_SSQ), rep_ == 0 ? 0.5f : 0.f, (PROBE_NULLEPI && rep_ > 0) ? 1 : 0}; \
            pg8::gemm_phase<EpiResid, pg8::StaticOrder, true, true>(lds, g, S, E, tid); \
            GRID_BAR(); \
        } } while (0)
        FFN_PAIR(0, 1, 2);
        if (IN(3)) REP(3) { PH_ENTER(); int l = l0; LS(l);
            pg8::Gemm g{(const bf16_t*)(ws + WS_XB), (const bf16_t*)(ws + WS_WIN + (size_t)l * SZ_WIN), MROWS, NWIN, DM}; pg8::StaticOrder S; S.init(MROWS, NWIN, G, blk);
            const float* ropec = (const float*)(ws + WS_ROPE);
            EpiWin E{(const float*)(ws + WS_SSQ), (LAS float*)(lds + RSL_OFF), ropec, ropec + SEQ * 64, (bf16_t*)(ws + WS_FQ), (bf16_t*)(ws + WS_RQ), -1};
            pg8::gemm_phase<EpiWin, pg8::StaticOrder, true, true>(lds, g, S, E, tid);
            if (NAIVE_MASK & 1) fz_phase((const bf16_t*)(ws + WS_XB), (const float*)(ws + WS_SSQ), (const float*)(ws + WS_WFZ) + (size_t)l * 8 * DM, a.in[7] + l * 8, (float*)(ws + WS_LOGF), blk, G, tid);
            else mx::fz_phase((const bf16_t*)(ws + WS_XB), (const float*)(ws + WS_SSQ), (const bf16_t*)(ws + WS_WFZ) + (size_t)l * 8 * DM, a.in[7] + l * 8, (float*)(ws + WS_LOGF), (LAS float*)(lds + RSL_OFF), blk, G, tid);
            GRID_BAR();
        }
        if (IN(4)) REP(4) { PH_ENTER(); int l = l0; LS(l);
            float* logf = (float*)(ws + WS_LOGF); float* cum = (float*)(ws + WS_CUM); float* rkv = (float*)(ws + WS_RKV);
            bf16_t *RK = (bf16_t*)(ws + WS_RK), *RV = (bf16_t*)(ws + WS_RV), *GU = (bf16_t*)(ws + WS_GU), *GV = (bf16_t*)(ws + WS_GV), *Y = (bf16_t*)(ws + WS_Y);
            for (int bh = blk; bh < NB * FOXH; bh += G) cumsum_unit(logf + (size_t)bh * SEQ, cum + (size_t)bh * SEQ, (LAS float*)lds, tid);
            if (NAIVE_MASK & 2) { for (int un = blk; un < 16 * 64; un += G) { const int bhr = un >> 6, n = un & 63; const size_t ro = ((size_t)bhr * SEQ + n * 64) * HD;
                retkv_unit(RK + ro, RV + ro, rkv + (size_t)un * 128 * 128, ret_log2g(bhr & 3), (LAS float*)lds, tid); } }
            else mx::retkv_phase(RK, RV, rkv, (mx::lptr)lds, blk, G, tid);
            if (NAIVE_MASK & 4) { for (int un = blk; un < NB * 32 * GMG; un += G) { const int g = un & 3, n = (un >> 2) & 31, b = un >> 7; const size_t ro = ((size_t)(b * GMG + g) * SEQ + n * 128) * HD;
                gmlp_unit(GU + ro, GV + ro, a.in[8] + l * 512 + g * 128, a.in[9] + l * 512 + g * 128, a.in[10] + ((size_t)l * 4 + g) * 128 * 128, a.in[11] + (l * 4 + g) * 128,
                          Y + ((size_t)(b * SEQ + n * 128)) * DM + 1536 + g * 128, (LAS float*)lds, tid); } }
            else mx::gmlp_phase(GU, GV, a.in[8] + l * 512, a.in[9] + l * 512, a.in[10] + (size_t)l * 4 * 128 * 128, a.in[11] + l * 4 * 128, Y, (mx::lptr)lds, blk, G, tid);
            GRID_BAR();
        }
        if (IN(5)) REP(5) { PH_ENTER();
            float* rkv = (float*)(ws + WS_RKV); float* rsp = (float*)(ws + WS_RSP);
            if (NAIVE_MASK & 2) { for (int i = blk * NTHREADS + tid; i < 16 * 128 * 128; i += G * NTHREADS) { const int bhr = i >> 14, de = i & 16383;
                const float cd = exp2f(64.0f * ret_log2g(bhr & 3)); float st = 0.f;
                for (int n = 0; n < 64; ++n) { const size_t o = ((size_t)(bhr * 64 + n) << 14) + de; rsp[o] = st; st = st * cd + rkv[o]; } } }
            else mx::retscan_phase(rkv, (bf16_t*)rsp, blk, G, tid);
            GRID_BAR();
        }
        if (IN(6)) REP(6) {
            { PH_ENTER();
              bf16_t *RQ = (bf16_t*)(ws + WS_RQ), *RK = (bf16_t*)(ws + WS_RK), *RV = (bf16_t*)(ws + WS_RV), *RG = (bf16_t*)(ws + WS_RG), *Y = (bf16_t*)(ws + WS_Y);
              float* rsp = (float*)(ws + WS_RSP);
              if (NAIVE_MASK & 2) { for (int un = blk; un < 16 * 64; un += G) { const int bhr = un >> 6, n = un & 63, b = bhr >> 2, hr = bhr & 3; const size_t ro = ((size_t)bhr * SEQ + n * 64) * HD;
                  retout_unit(RQ + ro, RK + ro, RV + ro, RG + ro, rsp + (size_t)un * 128 * 128, Y + ((size_t)(b * SEQ + n * 64)) * DM + 1024 + hr * 128, ret_log2g(hr), (LAS float*)lds, tid); } }
              else mx::retout_phase(RQ, RK, RV, RG, (const bf16_t*)rsp, Y, (mx::lptr)lds, blk, G, tid); }
            { PH_ENTER();
              fa::attn_phase((const bf16_t*)(ws + WS_FQ), (const bf16_t*)(ws + WS_FK), (const bf16_t*)(ws + WS_FV), (const float*)(ws + WS_CUM), (bf16_t*)(ws + WS_Y), (fa::lptr)lds, blk, G, tid); }
            GRID_BAR();
        }
        if (IN(7)) REP(7) { PH_ENTER(); int l = l0; LS(l);
            pg8::Gemm g{(const bf16_t*)(ws + WS_Y), (const bf16_t*)(ws + WS_WOUT + (size_t)l * SZ_WOUT), MROWS, DM, DM}; pg8::StaticOrder S; S.init(MROWS, DM, G, blk);
            EpiResid E{(const float*)nullptr, (bf16_t*)(ws + WS_XB), (float*)(ws + WS_SSQ), rep_ == 0 ? 1.0f : 0.f, (PROBE_NULLEPI && rep_ > 0) ? 1 : 0};
            pg8::gemm_phase<EpiResid, pg8::StaticOrder, true, true>(lds, g, S, E, tid);
            GRID_BAR();
        }
        FFN_PAIR(1, 8, 9);
#undef FFN_PAIR
    }
    if (a.l_hi == DEPTH && IN(10)) { PH_ENTER();
        const float* fn = a.in[18]; const float* ssq = (const float*)(ws + WS_SSQ);
        for (int m = gw; m < MROWS; m += ngw) {
            float s = lane < 32 ? ssq[(size_t)m * 32 + lane] : 0.f; s = wave_sum(s);
            const float rs = rsqrtf(s * (1.0f / DM) + EPS);
            f32x4* xr = (f32x4*)(a.out + (size_t)m * DM); const u32x4* xbr = (const u32x4*)((const bf16_t*)(ws + WS_XB) + (size_t)m * DM);
#pragma unroll
            for (int j = 0; j < 4; ++j) { float f[8]; unpack8(xbr[j * 64 + lane], f); const f32x4 g0 = ((const f32x4*)fn)[(j * 64 + lane) * 2], g1 = ((const f32x4*)fn)[(j * 64 + lane) * 2 + 1];
                xr[(j * 64 + lane) * 2] = (f32x4){f[0], f[1], f[2], f[3]} * rs * g0; xr[(j * 64 + lane) * 2 + 1] = (f32x4){f[4], f[5], f[6], f[7]} * rs * g1; }
        }
    }
#undef PH_ENTER
#undef LV
#undef LS
#undef IN
#undef GRID_BAR
}

extern "C" void kernel_launch(void* const* d_in, const int* in_sizes, int n_in, void* d_out, int out_size, void* d_ws, size_t ws_size, hipStream_t stream) {
    static int grid = 0;
    if (grid == 0) {
        if (n_in != 19 || in_sizes[0] != MROWS * DM || out_size != MROWS * DM || ws_size < WS_END) { fprintf(stderr, "kernel_launch: unexpected shapes (n_in %d, in0 %d, out %d, ws %zu < %zu)\n", n_in, n_in > 0 ? in_sizes[0] : -1, out_size, ws_size, (size_t)WS_END); grid = -1; return; }
        int dev = 0, cus = 0;
        if (hipGetDevice(&dev) != hipSuccess || hipDeviceGetAttribute(&cus, hipDeviceAttributeMultiprocessorCount, dev) != hipSuccess) { grid = -1; return; }
#define SETATTR(K) do { if (hipFuncSetAttribute((const void*)(K), hipFuncAttributeMaxDynamicSharedMemorySize, LDS_BYTES) != hipSuccess) { fprintf(stderr, "kernel_launch: hipFuncSetAttribute failed\n"); grid = -1; return; } } while (0)
#if MK_SPLIT
        SETATTR(fwd<1u << 0>); SETATTR(fwd<1u << 1>); SETATTR(fwd<1u << 2>); SETATTR(fwd<1u << 3>); SETATTR(fwd<1u << 4>); SETATTR(fwd<1u << 5>);
        SETATTR(fwd<1u << 6>); SETATTR(fwd<1u << 7>); SETATTR(fwd<1u << 8>); SETATTR(fwd<1u << 9>); SETATTR(fwd<1u << 10>);
#else
        SETATTR(fwd<0x7ffu>);
        int per_cu = 0;
        if (hipOccupancyMaxActiveBlocksPerMultiprocessor(&per_cu, (const void*)fwd<0x7ffu>, NTHREADS, LDS_BYTES) != hipSuccess || per_cu < 1) fprintf(stderr, "kernel_launch: occupancy query reports %d\n", per_cu);
        (void)hipGetLastError();
#endif
        grid = cus;
    }
    if (grid < 0) return;
    (void)hipMemsetAsync((char*)d_ws + WS_CTL, 0, CTL_ZERO_BYTES, stream);
    Args a{};
    for (int i = 0; i < 19; ++i) a.in[i] = (const float*)d_in[i];
    a.out = (float*)d_out; a.ws = (unsigned char*)d_ws; a.pad = 0;
#if MK_SPLIT
    a.use_bar = 0;
#define LAUNCH1(PH, LL, LH) do { Args p = a; p.l_lo = (LL); p.l_hi = (LH); p.ph_lo = (PH); p.ph_hi = (PH) + 1; hipLaunchKernelGGL(fwd<(1u << (PH))>, dim3(grid), dim3(NTHREADS), LDS_BYTES, stream, p); } while (0)
    LAUNCH1(0, 0, 0);
    for (int l = 0; l < DEPTH; ++l) { LAUNCH1(1, l, l + 1); LAUNCH1(2, l, l + 1); LAUNCH1(3, l, l + 1); LAUNCH1(4, l, l + 1); LAUNCH1(5, l, l + 1); LAUNCH1(6, l, l + 1); LAUNCH1(7, l, l + 1); LAUNCH1(8, l, l + 1); LAUNCH1(9, l, l + 1); }
    LAUNCH1(10, DEPTH, DEPTH);
#else
    a.use_bar = 1; a.l_lo = 0; a.l_hi = DEPTH; a.ph_lo = 0; a.ph_hi = 11;
    hipLaunchKernelGGL(fwd<0x7ffu>, dim3(grid), dim3(NTHREADS), LDS_BYTES, stream, a);
#endif
}
```

```cpp
#include <hip/hip_runtime.h>
#include <cstdio>
#include <cstdint>

#ifndef MK_SPLIT
#define MK_SPLIT 0
#endif

#ifndef PROBE_MASK
#define PROBE_MASK 0u
#endif
#ifndef NAIVE_MASK
#define NAIVE_MASK 0
#endif
#ifndef PROBE_NULLEPI
#define PROBE_NULLEPI 0
#endif
#ifndef PROBE_REP
#define PROBE_REP 1
#endif
#define LAS __attribute__((address_space(3)))
#define GAS __attribute__((address_space(1)))
typedef unsigned short bf16_t;
typedef short bf16x8 __attribute__((ext_vector_type(8)));
typedef float f32x4 __attribute__((ext_vector_type(4)));
typedef float f32x2 __attribute__((ext_vector_type(2)));
typedef unsigned u32x4 __attribute__((ext_vector_type(4)));
typedef unsigned u32x2 __attribute__((ext_vector_type(2)));

constexpr int DM = 2048, NB = 4, SEQ = 4096, DEPTH = 4, MROWS = NB * SEQ, DFF = 5632, HD = 128;
constexpr int FOXH = 8, RETH = 4, GMG = 4;
constexpr int INCOLS = 6152, NWIN = 6144, NGU = 2 * DFF;
constexpr int FZ_COL = 3072;
constexpr float EPS = 1e-6f;
constexpr int NWAVES = 8, NTHREADS = 512;

constexpr size_t MiB = 1u << 20;
constexpr size_t WS_CTL = 0, CTL_ZERO_BYTES = 1 * MiB;
constexpr size_t WS_SSQ = 1 * MiB;
constexpr size_t WS_ROPE = 3 * MiB;
constexpr size_t WS_LOGF = 5 * MiB;
constexpr size_t WS_CUM = 5 * MiB + 512 * 1024;
constexpr size_t WS_WFZ = 6 * MiB;
constexpr size_t WS_WGU = 8 * MiB;
constexpr size_t SZ_WGU = (size_t)NGU * DM * 2;
constexpr size_t WS_WD = WS_WGU + 8 * SZ_WGU;
constexpr size_t SZ_WD = (size_t)DM * DFF * 2;
constexpr size_t WS_WIN = WS_WD + 8 * SZ_WD;
constexpr size_t SZ_WIN = (size_t)NWIN * DM * 2;
constexpr size_t WS_WOUT = WS_WIN + 4 * SZ_WIN;
constexpr size_t SZ_WOUT = (size_t)DM * DM * 2;
constexpr size_t WS_XB = WS_WOUT + 4 * SZ_WOUT;
constexpr size_t WS_ACT = WS_XB + (size_t)MROWS * DM * 2;
constexpr size_t WS_HID = WS_ACT;
constexpr size_t SZ_FOX = (size_t)NB * FOXH * SEQ * HD * 2;
constexpr size_t SZ_R = (size_t)NB * RETH * SEQ * HD * 2;
constexpr size_t WS_FQ = WS_ACT, WS_FK = WS_FQ + SZ_FOX, WS_FV = WS_FK + SZ_FOX;
constexpr size_t WS_RQ = WS_FV + SZ_FOX, WS_RK = WS_RQ + SZ_R, WS_RV = WS_RK + SZ_R, WS_RG = WS_RV + SZ_R;
constexpr size_t WS_GU = WS_RG + SZ_R, WS_GV = WS_GU + SZ_R;
constexpr size_t WS_Y = WS_GV + SZ_R;
constexpr size_t WS_RKV = WS_Y + (size_t)MROWS * DM * 2;
constexpr size_t SZ_RKV = (size_t)16 * 64 * 128 * 128 * 4;
constexpr size_t WS_RSP = WS_RKV + SZ_RKV;
constexpr size_t WS_END = WS_RSP + SZ_RKV;
static_assert(WS_WGU >= WS_WFZ + (size_t)DEPTH * 8 * DM * 4, "ws map");
static_assert(WS_Y + (size_t)MROWS * DM * 2 >= WS_HID + (size_t)MROWS * DFF * 2, "hid overlay fits");

constexpr int CW_BAR = 4096;

constexpr int RING_BYTES = 131072;
constexpr int LDSCTL_OFF = RING_BYTES, MISC_OFF = LDSCTL_OFF + 320;
constexpr int LDS_BYTES = 147456;
constexpr int RSL_OFF = LDSCTL_OFF + 1024;

__device__ __forceinline__ float bf2f(unsigned h) { return __uint_as_float(h << 16); }
__device__ __forceinline__ unsigned f2bf(float f) { unsigned u = __float_as_uint(f); return (u + 0x7fffu + ((u >> 16) & 1u)) >> 16; }
__device__ __forceinline__ unsigned pk2(float lo, float hi) { return f2bf(lo) | (f2bf(hi) << 16); }
__device__ __forceinline__ unsigned cvt_pk_bf16(float lo, float hi) { unsigned r; asm volatile("v_cvt_pk_bf16_f32 %0, %1, %2" : "=v"(r) : "v"(lo), "v"(hi)); return r; }
__device__ __forceinline__ float wave_sum(float v) {
#pragma unroll
    for (int o = 1; o < 64; o <<= 1) v += __shfl_xor(v, o);
    return v;
}
__device__ __forceinline__ float silu_f(float x) { return x * __builtin_amdgcn_rcpf(1.0f + __builtin_amdgcn_exp2f(-1.4426950408889634f * x)); }
__device__ __forceinline__ float gelu_tanh_f(float x) { const float u = (2.0f * 1.4426950408889634f * 0.7978845608028654f) * (x + 0.044715f * x * x * x); return x * __builtin_amdgcn_rcpf(1.0f + __builtin_amdgcn_exp2f(-u)); }
__device__ __forceinline__ float logsig_f(float z) { return fminf(z, 0.f) - log1pf(__expf(-fabsf(z))); }
__device__ __forceinline__ void unpack8(const u32x4 w, float* f) {
    f[0] = __uint_as_float(w.x << 16); f[1] = __uint_as_float(w.x & 0xffff0000u);
    f[2] = __uint_as_float(w.y << 16); f[3] = __uint_as_float(w.y & 0xffff0000u);
    f[4] = __uint_as_float(w.z << 16); f[5] = __uint_as_float(w.z & 0xffff0000u);
    f[6] = __uint_as_float(w.w << 16); f[7] = __uint_as_float(w.w & 0xffff0000u);
}
#define LDS_WAIT() asm volatile("s_waitcnt lgkmcnt(0)" ::: "memory")
#define VM_WAIT() asm volatile("s_waitcnt vmcnt(0)" ::: "memory")

#define XB_TMO      128
#define XB_XCNT(j)  (256  + 64 * (j))
#define XB_XSUB(j)  (1280 + 64 * (j))
#define XB_XGEN(j)  (2304 + 64 * (j))
#define XB_TOP      3328
#define XB_TOPGEN   3392
#define XCD_BAR_WORDS 3456
#define XB_SPIN_CAP (1u << 22)
__device__ __forceinline__ unsigned xb_ld(unsigned* p)              { return __hip_atomic_load(p, __ATOMIC_RELAXED, __HIP_MEMORY_SCOPE_AGENT); }
__device__ __forceinline__ unsigned xb_add(unsigned* p, unsigned v) { return __hip_atomic_fetch_add(p, v, __ATOMIC_RELAXED, __HIP_MEMORY_SCOPE_AGENT); }
__device__ __forceinline__ unsigned xb_xcc_id() { return (unsigned)__builtin_amdgcn_s_getreg((3 << 11) | 20) & 0xFu; }
#define XB_SPIN(cond, bar) do { unsigned _sp = 0; while (cond) { __builtin_amdgcn_s_sleep(1); \
    if ((++_sp & 255u) == 0u) { if (xb_ld(&(bar)[XB_TMO])) break; if (_sp > XB_SPIN_CAP) { atomicAdd(&(bar)[XB_TMO], 1u); break; } } } } while (0)
struct XcdBarrier { unsigned* bar; unsigned x; volatile LAS unsigned* st; };
__device__ __forceinline__ XcdBarrier xcd_barrier_post(unsigned* bar, volatile LAS unsigned* st) {
    XcdBarrier b; b.bar = bar; b.x = xb_xcc_id(); b.st = st;
    if (threadIdx.x == 0) (void)xb_add(&bar[XB_XCNT(b.x)], 1u);
    return b;
}
__device__ __forceinline__ void xcd_barrier_complete(unsigned* bar, unsigned x, unsigned& nloc, unsigned& nx) {
    const unsigned G = gridDim.x * gridDim.y * gridDim.z;
    unsigned sum, cnt, mine, sp = 0u;
    for (;;) {
        sum = 0u; cnt = 0u; mine = 0u;
#pragma unroll
        for (unsigned j = 0; j < 16; ++j) { const unsigned c = xb_ld(&bar[XB_XCNT(j)]); sum += c; cnt += (c > 0u) ? 1u : 0u; mine = (j == x) ? c : mine; }
        if (sum == G) break;
        __builtin_amdgcn_s_sleep(1);
        if ((++sp & 255u) == 0u) { if (xb_ld(&bar[XB_TMO])) break; if (sp > XB_SPIN_CAP) { atomicAdd(&bar[XB_TMO], 1u); break; } }
    }
    nloc = mine > 0u ? mine : 1u; nx = cnt > 0u ? cnt : 1u;
}
__device__ __forceinline__ void xcd_barrier(const XcdBarrier& b) {
    asm volatile("s_waitcnt vmcnt(0)" ::: "memory");
    __syncthreads();
    if (threadIdx.x == 0) {
        unsigned long long zb_ = 0ull; asm volatile("" : "+s"(zb_));
        unsigned* bar = b.bar + zb_; unsigned bx = b.x; asm volatile("" : "+s"(bx));
        __builtin_amdgcn_s_waitcnt(0);
        unsigned nloc = b.st[0], nx = b.st[1];
        if (nloc == 0u) { xcd_barrier_complete(bar, bx, nloc, nx); b.st[0] = nloc; b.st[1] = nx; }
        const unsigned old = xb_add(&bar[XB_XSUB(bx)], 1u);
        const unsigned gen = old / nloc;
        if (old + 1u == (gen + 1u) * nloc) {
            __builtin_amdgcn_fence(__ATOMIC_RELEASE, "agent");
            asm volatile("s_waitcnt vmcnt(0)" ::: "memory");
            const unsigned og = xb_add(&bar[XB_TOP], 1u);
            const unsigned tg = og / nx;
            if (og + 1u == (tg + 1u) * nx) xb_add(&bar[XB_TOPGEN], 1u);
            else XB_SPIN(xb_ld(&bar[XB_TOPGEN]) == tg, bar);
            __builtin_amdgcn_fence(__ATOMIC_ACQUIRE, "agent");
            xb_add(&bar[XB_XGEN(bx)], 1u);
            asm volatile("s_waitcnt vmcnt(0)" ::: "memory");
        } else {
            XB_SPIN(xb_ld(&bar[XB_XGEN(bx)]) == gen, bar);
            __builtin_amdgcn_fence(__ATOMIC_ACQUIRE, "agent");
            asm volatile("s_waitcnt vmcnt(0)" ::: "memory");
        }
    }
    __syncthreads();
}

namespace pg8 {
#define PG8_LAS __attribute__((address_space(3)))
constexpr int BM = 256, BK = 64, HALF = 128, HTB = HALF * BK * 2, STAGE_BYTES = 8 * HTB, NXCD = 8, WGM = 8;
__host__ __device__ __forceinline__ int lds_byte(int r, int c) { const int st = (r >> 4) * 2 + (c >> 5), rr = r & 15, cc = c & 31, ob = rr * 64 + cc * 2; return st * 1024 + (ob ^ (((ob >> 9) & 1) << 5)); }
__host__ __device__ __forceinline__ void stage_rc(int b, int& R, int& C) { const int st = b / 1024, sb = b % 1024, swz = sb ^ (((sb >> 9) & 1) << 5); R = (st >> 1) * 16 + swz / 64; C = (st & 1) * 32 + (swz % 64) / 2; }
__host__ __device__ __forceinline__ int perm32(int rho) { const int n = rho >> 4, i = rho & 15; return 8 * (i >> 2) + 4 * n + (i & 3); }
struct Unit { int pm, pn; };
struct Gemm { const bf16_t* A; const bf16_t* Bt; int M, N, K; };
struct StaticOrder {
    int nM, nN, nwg, G, c;
    __host__ __device__ void init(int M, int N, int G_, int c_) { nM = M / BM; nN = N / BM; nwg = nM * nN; G = G_; c = c_; }
    __host__ __device__ bool next(int i, Unit& u) const {
        const long L = (long)i * G + c; if (L >= nwg) return false;
        int wgid = (int)L; { const int q = nwg / NXCD, r = nwg % NXCD, xcd = wgid % NXCD, off = wgid / NXCD; wgid = (xcd < r ? xcd * (q + 1) : r * (q + 1) + (xcd - r) * q) + off; }
        const int nig = WGM * nN, gid = wgid / nig, fm = gid * WGM, gsz = (nM - fm) < WGM ? (nM - fm) : WGM;
        u.pm = fm + ((wgid % nig) % gsz); u.pn = (wgid % nig) / gsz; return true;
    }
    __device__ __forceinline__ void a_ready(const Unit&) const {}
    __device__ __forceinline__ void done(const Unit&) const {}
};
template <class Epi, class Sched, bool ALIGN_EPI = false, bool SP2 = false>
__device__ __forceinline__ void gemm_phase(PG8_LAS unsigned char* lds, const Gemm g, const Sched& S, Epi& E, const int tid) {
    const int wid = __builtin_amdgcn_readfirstlane(tid >> 6), lane = tid & 63, wr = wid >> 2, wc = wid & 3, fr = lane & 15, fq = lane >> 4;
    const int K = g.K, nt = K / BK;
    unsigned voffA[2], voffB[2];
#pragma unroll
    for (int i = 0; i < 2; ++i) { int R, C; stage_rc(tid * 16 + i * 8192, R, C); const int Rb = Epi::PERM ? ((R & ~31) + perm32(R & 31)) : R;
        voffA[i] = (unsigned)(R * K + C) * 2u; voffB[i] = (unsigned)(Rb * K + C) * 2u; }
    const size_t kstep = (size_t)(BK * 2);
    const size_t hstep = (size_t)HALF * K * 2;
    const size_t tstep = 2 * hstep;
    const unsigned ldsw = (unsigned)wid * 1024u;
    const int aoff = lds_byte(wr * 64 + fr, fq * 8), boff = lds_byte(wc * 32 + fr, fq * 8);
#define PG8_SA(b, h) (((b) * 2 + (h)) * HTB)
#define PG8_SB(b, h) ((4 + (b) * 2 + (h)) * HTB)
#define PG8_STAGE(bufoff, gbase, voff) do { _Pragma("unroll") for (int _i = 0; _i < 2; ++_i) \
        __builtin_amdgcn_global_load_lds((const unsigned*)((const char*)(gbase) + (voff)[_i]), (PG8_LAS unsigned*)(lds + (bufoff) + ldsw + _i * 8192), 16, 0, 0); } while (0)
#define PG8_LDA(dst, b, h) do { _Pragma("unroll") for (int m = 0; m < 4; ++m) _Pragma("unroll") for (int k = 0; k < 2; ++k) dst[m][k] = *(const PG8_LAS bf16x8*)(lds + PG8_SA(b, h) + aoff + m * 2048 + k * 1024); } while (0)
#define PG8_LDB(dst, b, h) do { _Pragma("unroll") for (int n = 0; n < 2; ++n) _Pragma("unroll") for (int k = 0; k < 2; ++k) dst[n][k] = *(const PG8_LAS bf16x8*)(lds + PG8_SB(b, h) + boff + n * 2048 + k * 1024); } while (0)
#define PG8_MMA(ai, bj, At, Bt) do { __builtin_amdgcn_s_setprio(1); _Pragma("unroll") for (int m = 0; m < 4; ++m) _Pragma("unroll") for (int n = 0; n < 2; ++n) _Pragma("unroll") for (int k = 0; k < 2; ++k) \
        acc[ai][bj][m][n] = __builtin_amdgcn_mfma_f32_16x16x32_bf16(Bt[n][k], At[m][k], acc[ai][bj][m][n], 0, 0, 0); __builtin_amdgcn_s_setprio(0); } while (0)
#define PG8_WAIT_V(n) asm volatile("s_waitcnt vmcnt(" #n ")" ::: "memory")
#define PG8_WAIT_L(n) asm volatile("s_waitcnt lgkmcnt(" #n ")" ::: "memory")
#define PG8_BAR __builtin_amdgcn_s_barrier()
#define PG8_SCHED __builtin_amdgcn_sched_barrier(0)
    Unit cur, nxt; int ui = 0;
    if (!S.next(0, cur)) return;
    f32x4 acc[2][2][4][2];
#pragma unroll
    for (int a = 0; a < 2; ++a)
#pragma unroll
        for (int b = 0; b < 2; ++b)
#pragma unroll
            for (int m = 0; m < 4; ++m)
#pragma unroll
                for (int n = 0; n < 2; ++n) acc[a][b][m][n] = (f32x4){0.f, 0.f, 0.f, 0.f};
    bf16x8 At[4][2], B0[2][2], B1[2][2];
    const char* cA = (const char*)g.A + (size_t)cur.pm * tstep; const char* cB = (const char*)g.Bt + (size_t)cur.pn * tstep;
    S.a_ready(cur);
    if constexpr (SP2) {
        PG8_STAGE(PG8_SB(0, 0), cB, voffB); PG8_STAGE(PG8_SB(0, 1), cB + hstep, voffB); PG8_STAGE(PG8_SA(0, 0), cA, voffA); PG8_STAGE(PG8_SA(0, 1), cA + hstep, voffA);
        if (wr == 1) PG8_BAR;
        PG8_WAIT_V(2); PG8_BAR;
        PG8_STAGE(PG8_SB(1, 0), cB + kstep, voffB); PG8_STAGE(PG8_SA(1, 0), cA + kstep, voffA); PG8_STAGE(PG8_SB(1, 1), cB + hstep + kstep, voffB);
        PG8_WAIT_V(6); PG8_BAR;
    } else {
        PG8_STAGE(PG8_SB(0, 0), cB, voffB); PG8_STAGE(PG8_SA(0, 0), cA, voffA); PG8_STAGE(PG8_SB(0, 1), cB + hstep, voffB); PG8_STAGE(PG8_SA(0, 1), cA + hstep, voffA);
        if (wr == 1) PG8_BAR;
        PG8_WAIT_V(4); PG8_BAR;
        PG8_STAGE(PG8_SB(1, 0), cB + kstep, voffB); PG8_STAGE(PG8_SA(1, 0), cA + kstep, voffA); PG8_STAGE(PG8_SB(1, 1), cB + hstep + kstep, voffB);
        PG8_WAIT_V(6); PG8_BAR;
    }
    for (;;) {
        const bool has_next = S.next(ui + 1, nxt);
        const char* nA = has_next ? (const char*)g.A + (size_t)nxt.pm * tstep : cA; const char* nB = has_next ? (const char*)g.Bt + (size_t)nxt.pn * tstep : cB;
        for (int t = 0; t < nt; t += 2) {
            const bool last = (t == nt - 2);
            const char* a1 = cA + (size_t)(t + 1) * kstep;
            const char* a2 = last ? nA : cA + (size_t)(t + 2) * kstep; const char* b2 = last ? nB : cB + (size_t)(t + 2) * kstep;
            const char* a3 = a2 + kstep; const char* b3 = b2 + kstep;
            if (last && has_next) S.a_ready(nxt);
            if constexpr (SP2) {
            PG8_LDB(B0, 0, 0); PG8_LDB(B1, 0, 1); PG8_SCHED; PG8_LDA(At, 0, 0); PG8_STAGE(PG8_SA(1, 1), a1 + hstep, voffA);
            PG8_WAIT_V(8); PG8_WAIT_L(0); PG8_BAR; PG8_MMA(0, 0, At, B0); PG8_MMA(0, 1, At, B1); PG8_BAR; PG8_SCHED;
            PG8_LDA(At, 0, 1); PG8_STAGE(PG8_SB(0, 0), b2, voffB); PG8_STAGE(PG8_SB(0, 1), b2 + hstep, voffB); PG8_STAGE(PG8_SA(0, 0), a2, voffA);
            PG8_WAIT_V(8); PG8_WAIT_L(0); PG8_BAR; PG8_MMA(1, 0, At, B0); PG8_MMA(1, 1, At, B1); PG8_BAR; PG8_SCHED;
            PG8_LDB(B0, 1, 0); PG8_LDB(B1, 1, 1); PG8_SCHED; PG8_LDA(At, 1, 0); PG8_STAGE(PG8_SA(0, 1), a2 + hstep, voffA);
            PG8_WAIT_V(8); PG8_WAIT_L(0); PG8_BAR; PG8_MMA(0, 0, At, B0); PG8_MMA(0, 1, At, B1); PG8_BAR; PG8_SCHED;
            PG8_LDA(At, 1, 1); PG8_STAGE(PG8_SB(1, 0), b3, voffB); PG8_STAGE(PG8_SB(1, 1), b3 + hstep, voffB); PG8_STAGE(PG8_SA(1, 0), a3, voffA);
            PG8_WAIT_V(8); PG8_WAIT_L(0); PG8_BAR; PG8_MMA(1, 0, At, B0); PG8_MMA(1, 1, At, B1); PG8_BAR; PG8_SCHED;
            } else {
            PG8_LDB(B0, 0, 0); PG8_SCHED; PG8_LDA(At, 0, 0); PG8_STAGE(PG8_SA(1, 1), a1 + hstep, voffA);
            PG8_WAIT_L(8); PG8_BAR; PG8_WAIT_L(0); PG8_MMA(0, 0, At, B0); PG8_BAR; PG8_SCHED;
            PG8_LDB(B1, 0, 1); PG8_STAGE(PG8_SB(0, 0), b2, voffB);
            PG8_BAR; PG8_WAIT_L(0); PG8_MMA(0, 1, At, B1); PG8_BAR;
            PG8_LDA(At, 0, 1); PG8_STAGE(PG8_SA(0, 0), a2, voffA);
            PG8_BAR; PG8_WAIT_L(0); PG8_MMA(1, 0, At, B0); PG8_BAR; PG8_SCHED;
            PG8_STAGE(PG8_SB(0, 1), b2 + hstep, voffB);
            PG8_WAIT_V(6); PG8_BAR; PG8_MMA(1, 1, At, B1); PG8_BAR;
            PG8_LDB(B0, 1, 0); PG8_SCHED; PG8_LDA(At, 1, 0); PG8_STAGE(PG8_SA(0, 1), a2 + hstep, voffA);
            PG8_WAIT_L(8); PG8_BAR; PG8_WAIT_L(0); PG8_MMA(0, 0, At, B0); PG8_BAR; PG8_SCHED;
            PG8_LDB(B1, 1, 1); PG8_STAGE(PG8_SB(1, 0), b3, voffB);
            PG8_BAR; PG8_WAIT_L(0); PG8_MMA(0, 1, At, B1); PG8_BAR;
            PG8_LDA(At, 1, 1); PG8_STAGE(PG8_SA(1, 0), a3, voffA);
            PG8_BAR; PG8_WAIT_L(0); PG8_MMA(1, 0, At, B0); PG8_BAR; PG8_SCHED;
            PG8_STAGE(PG8_SB(1, 1), b3 + hstep, voffB);
            PG8_WAIT_V(6); PG8_BAR; PG8_MMA(1, 1, At, B1); PG8_BAR;
            }
        }
        if constexpr (ALIGN_EPI) { if (wr == 0) PG8_BAR; }
        E(acc, cur, wr, wc, fr, fq, tid); S.done(cur);
        if (!has_next) break;
#pragma unroll
        for (int a = 0; a < 2; ++a)
#pragma unroll
            for (int b = 0; b < 2; ++b)
#pragma unroll
                for (int m = 0; m < 4; ++m)
#pragma unroll
                    for (int n = 0; n < 2; ++n) acc[a][b][m][n] = (f32x4){0.f, 0.f, 0.f, 0.f};
        cur = nxt; cA = nA; cB = nB; ++ui;
        if constexpr (ALIGN_EPI) { if (wr == 1) PG8_BAR; }
    }
    PG8_WAIT_V(0);
    if constexpr (!ALIGN_EPI) { if (wr == 0) PG8_BAR; }
    PG8_BAR;
#undef PG8_SA
#undef PG8_SB
#undef PG8_STAGE
#undef PG8_LDA
#undef PG8_LDB
#undef PG8_MMA
#undef PG8_WAIT_V
#undef PG8_WAIT_L
#undef PG8_BAR
#undef PG8_SCHED
}
}

__device__ __forceinline__ float row_rstd(const float* ssq, int row, int fq) {
    const f32x4* p = (const f32x4*)(ssq + (size_t)row * 32 + fq * 8);
    const f32x4 a = p[0], b = p[1];
    float s = ((a.x + a.y) + (a.z + a.w)) + ((b.x + b.y) + (b.z + b.w));
    s += __shfl_xor(s, 16); s += __shfl_xor(s, 32);
    return rsqrtf(s * (1.0f / DM) + EPS);
}
__device__ __forceinline__ void stage_rstd(const float* ssq, int pm, LAS float* rsl, int tid) {
    const int r = tid >> 1, hs = tid & 1;
    const f32x4* p = (const f32x4*)(ssq + (size_t)(pm * 256 + r) * 32 + hs * 16);
    const f32x4 a = p[0], b = p[1], c = p[2], d = p[3];
    float s = (((a.x + a.y) + (a.z + a.w)) + ((b.x + b.y) + (b.z + b.w))) + (((c.x + c.y) + (c.z + c.w)) + ((d.x + d.y) + (d.z + d.w)));
    s += __shfl_xor(s, 1);
    if (hs == 0) rsl[r] = rsqrtf(s * (1.0f / DM) + EPS);
    asm volatile("s_waitcnt lgkmcnt(0)" ::: "memory"); __builtin_amdgcn_s_barrier(); asm volatile("" ::: "memory");
}
__device__ __forceinline__ u32x4 pack8bf(const f32x4 a, const f32x4 b) {
    u32x4 w; w.x = cvt_pk_bf16(a[0], a[1]); w.y = cvt_pk_bf16(a[2], a[3]); w.z = cvt_pk_bf16(b[0], b[1]); w.w = cvt_pk_bf16(b[2], b[3]); return w;
}
struct EpiSwiGLU {
    static constexpr bool PERM = true, AFTER_DRAIN = false;
    bf16_t* H; const float* ssq; LAS float* rsl; int cur_pm; int skip;
    __device__ __forceinline__ void operator()(const f32x4 (&acc)[2][2][4][2], const pg8::Unit& u, int wr, int wc, int fr_, int fq_, int tid) {
        int fr = fr_, fq = fq_; asm volatile("" : "+v"(fr), "+v"(fq));
        if (skip) return;
        const int row0 = u.pm * 256 + wr * 64 + fr, col0 = u.pn * 128 + wc * 32 + 8 * fq;
        if (u.pm != cur_pm) { stage_rstd(ssq, u.pm, rsl, tid); cur_pm = u.pm; }
#pragma unroll
        for (int ai = 0; ai < 2; ++ai)
#pragma unroll
            for (int m = 0; m < 4; ++m) {
                const int row = row0 + ai * 128 + m * 16;
                const float rs = rsl[wr * 64 + fr + ai * 128 + m * 16];
                f32x4 h[2];
#pragma unroll
                for (int n = 0; n < 2; ++n) { const f32x4 g = acc[ai][0][m][n] * rs, up = acc[ai][1][m][n] * rs;
#pragma unroll
                    for (int i = 0; i < 4; ++i) h[n][i] = silu_f(g[i]) * up[i]; }
                *(u32x4*)(H + (size_t)row * DFF + col0) = pack8bf(h[0], h[1]);
            }
    }
};
struct EpiResid {
    static constexpr bool PERM = true, AFTER_DRAIN = false;
    const float* xin32; bf16_t* xb; float* ssq; float alpha; int skip;
    __device__ __forceinline__ void operator()(const f32x4 (&acc)[2][2][4][2], const pg8::Unit& u, int wr, int wc, int fr_, int fq_, int tid) {
        int fr = fr_, fq = fq_; asm volatile("" : "+v"(fr), "+v"(fq));
        if (skip) return;
        const int row0 = u.pm * 256 + wr * 64 + fr, col0 = u.pn * 256 + wc * 32 + 8 * fq;
        const size_t base = (size_t)row0 * DM + col0;
        f32x4 cur[4], nxt[4];
#define ER_LD(dst, g) do { const size_t o_ = base + (size_t)((((g) >> 2) * 128 + ((g) & 3) * 16)) * DM; \
            if (xin32) { const float* p_ = xin32 + o_; dst[0] = *(const f32x4*)(p_); dst[1] = *(const f32x4*)(p_ + 4); dst[2] = *(const f32x4*)(p_ + 128); dst[3] = *(const f32x4*)(p_ + 132); } \
            else { const u32x4 w0 = *(const u32x4*)(xb + o_), w1 = *(const u32x4*)(xb + o_ + 128); float f_[8]; unpack8(w0, f_); dst[0] = (f32x4){f_[0], f_[1], f_[2], f_[3]}; dst[1] = (f32x4){f_[4], f_[5], f_[6], f_[7]}; \
                   unpack8(w1, f_); dst[2] = (f32x4){f_[0], f_[1], f_[2], f_[3]}; dst[3] = (f32x4){f_[4], f_[5], f_[6], f_[7]}; } } while (0)
        ER_LD(cur, 0);
#pragma unroll
        for (int g = 0; g < 8; ++g) {
            const int ai = g >> 2, m = g & 3;
            if (g < 7) ER_LD(nxt, g + 1);
            const size_t off = base + (size_t)(ai * 128 + m * 16) * DM; float s = 0.f;
#pragma unroll
            for (int bj = 0; bj < 2; ++bj) {
                const f32x4 n0 = cur[2 * bj] + acc[ai][bj][m][0] * alpha, n1 = cur[2 * bj + 1] + acc[ai][bj][m][1] * alpha;
                const u32x4 w = pack8bf(n0, n1);
                *(u32x4*)(xb + off + bj * 128) = w;
                float q[8]; unpack8(w, q);
                s += ((q[0] * q[0] + q[1] * q[1]) + (q[2] * q[2] + q[3] * q[3])) + ((q[4] * q[4] + q[5] * q[5]) + (q[6] * q[6] + q[7] * q[7]));
            }
            s += __shfl_xor(s, 16); s += __shfl_xor(s, 32);
            if (fq == 0) ssq[(size_t)(row0 + ai * 128 + m * 16) * 32 + u.pn * 4 + wc] = s;
#pragma unroll
            for (int j = 0; j < 4; ++j) cur[j] = nxt[j];
        }
#undef ER_LD
    }
};
struct EpiWin {
    static constexpr bool PERM = true, AFTER_DRAIN = false;
    const float* ssq; LAS float* rsl; const float* __restrict__ ropec; const float* __restrict__ ropes;
    bf16_t *FQ, *RQ; int cur_pm;
    __device__ __forceinline__ void operator()(const f32x4 (&acc)[2][2][4][2], const pg8::Unit& u, int wr, int wc, int fr_, int fq_, int tid) {
        int fr = fr_, fq = fq_; asm volatile("" : "+v"(fr), "+v"(fq));
        const int pn = u.pn, b = u.pm >> 4, s0 = (u.pm & 15) * 256 + wr * 64 + fr, rl0 = wr * 64 + fr;
        if (u.pm != cur_pm) { stage_rstd(ssq, u.pm, rsl, tid); cur_pm = u.pm; }
        if (pn < 12) {
            const int t = pn >> 2; bf16_t* base = FQ + (size_t)t * (SZ_FOX / 2);
#pragma unroll
            for (int ai = 0; ai < 2; ++ai)
#pragma unroll
                for (int m = 0; m < 4; ++m) {
                    const int s = s0 + ai * 128 + m * 16; const float rs = rsl[rl0 + ai * 128 + m * 16];
#pragma unroll
                    for (int bj = 0; bj < 2; ++bj) { const int head = 2 * (pn & 3) + bj;
                        *(u32x4*)(base + ((size_t)(b * FOXH + head) * SEQ + s) * HD + wc * 32 + 8 * fq) = pack8bf(acc[ai][bj][m][0] * rs, acc[ai][bj][m][1] * rs); }
                }
        } else if (pn < 16) {
            const int seg = (pn - 12) >> 1, hh = 2 * ((pn - 12) & 1) + (wc >> 1), dp = 32 * (wc & 1) + 8 * fq;
            bf16_t* base = RQ + (size_t)seg * (SZ_R / 2); const float ksc = seg ? 0.08838834764831845f : 1.0f;
#pragma unroll
            for (int ai = 0; ai < 2; ++ai)
#pragma unroll
                for (int m = 0; m < 4; ++m) {
                    const int s = s0 + ai * 128 + m * 16; const float rs = rsl[rl0 + ai * 128 + m * 16] * ksc;
                    const f32x4 c0 = *(const f32x4*)(ropec + (size_t)s * 64 + dp), c1 = *(const f32x4*)(ropec + (size_t)s * 64 + dp + 4);
                    const f32x4 n0 = *(const f32x4*)(ropes + (size_t)s * 64 + dp), n1 = *(const f32x4*)(ropes + (size_t)s * 64 + dp + 4);
                    const f32x4 a0 = acc[ai][0][m][0] * rs, a1 = acc[ai][0][m][1] * rs, b0 = acc[ai][1][m][0] * rs, b1 = acc[ai][1][m][1] * rs;
                    bf16_t* dst = base + ((size_t)(b * RETH + hh) * SEQ + s) * HD + dp;
                    *(u32x4*)(dst) = pack8bf(a0 * c0 - b0 * n0, a1 * c1 - b1 * n1);
                    *(u32x4*)(dst + 64) = pack8bf(a0 * n0 + b0 * c0, a1 * n1 + b1 * c1);
                    if (m & 1) asm volatile("" ::: "memory");
                }
        } else {
            const int idx = pn - 16, kind = idx >> 1;
            bf16_t* base = RQ + (size_t)(2 + kind) * (SZ_R / 2);
#pragma unroll
            for (int ai = 0; ai < 2; ++ai)
#pragma unroll
                for (int m = 0; m < 4; ++m) {
                    const int s = s0 + ai * 128 + m * 16; const float rs = rsl[rl0 + ai * 128 + m * 16];
#pragma unroll
                    for (int bj = 0; bj < 2; ++bj) { const int head = 2 * (idx & 1) + bj;
                        f32x4 v0 = acc[ai][bj][m][0] * rs, v1 = acc[ai][bj][m][1] * rs;
                        if (kind == 1) {
#pragma unroll
                            for (int i = 0; i < 4; ++i) { v0[i] = silu_f(v0[i]); v1[i] = silu_f(v1[i]); } }
                        if (kind >= 2) {
#pragma unroll
                            for (int i = 0; i < 4; ++i) { v0[i] = gelu_tanh_f(v0[i]); v1[i] = gelu_tanh_f(v1[i]); } }
                        *(u32x4*)(base + ((size_t)(b * RETH + head) * SEQ + s) * HD + wc * 32 + 8 * fq) = pack8bf(v0, v1); }
                }
        }
    }
};

struct Args {
    const float* in[19]; float* out; unsigned char* ws;
    int l_lo, l_hi, ph_lo, ph_hi;
    int use_bar, pad;
};

__device__ __forceinline__ void tr_item(const float* W, int ldw, int src_col0, int k0, const float* gain, bf16_t* WT, int K, int dst_row0, LAS float* scr, int lane) {
    float v[32];
    const float* wp = W + (size_t)(k0 + (lane >> 5)) * ldw + src_col0 + (lane & 31);
#pragma unroll
    for (int i = 0; i < 32; ++i) v[i] = wp[(size_t)(2 * i) * ldw];
    if (gain) {
#pragma unroll
        for (int i = 0; i < 32; ++i) v[i] *= gain[k0 + 2 * i + (lane >> 5)]; }
#pragma unroll
    for (int i = 0; i < 32; ++i) scr[(2 * i + (lane >> 5)) * 33 + (lane & 31)] = v[i];
    LDS_WAIT(); asm volatile("" ::: "memory");
    const int c = lane & 7;
#pragma unroll
    for (int j = 0; j < 4; ++j) { const int n = (lane >> 3) + 8 * j; const LAS float* s = scr + (8 * c) * 33 + n;
        u32x4 o; o.x = pk2(s[0 * 33], s[1 * 33]); o.y = pk2(s[2 * 33], s[3 * 33]); o.z = pk2(s[4 * 33], s[5 * 33]); o.w = pk2(s[6 * 33], s[7 * 33]);
        *(u32x4*)(WT + (size_t)(dst_row0 + n) * K + k0 + 8 * c) = o; }
    LDS_WAIT(); asm volatile("" ::: "memory");
}
constexpr int IT_GU = (DM / 64) * (DFF / 32);
constexpr int IT_D = (DFF / 64) * (DM / 32);
constexpr int IT_WIN = (DM / 64) * (NWIN / 32);
constexpr int IT_WOUT = (DM / 64) * (DM / 32);
constexpr int IT_LAYER = 4 * IT_GU + 2 * IT_D + IT_WIN + IT_WOUT;
__device__ __forceinline__ int win_src_col(int db) {
    const int t = db >> 3, bb = db & 7, bj = bb >> 2, j0 = 32 * (bb & 3);
    if (t < 12) return 32 * db;
    if (t < 16) { const int seg = (t - 12) >> 1, ts = (t - 12) & 1, hh = 2 * ts + (j0 >> 6), d = 64 * bj + (j0 & 63); return 3080 + seg * 512 + hh * 128 + d; }
    return 8 + 32 * db;
}
__device__ __forceinline__ void prologue(const Args& a, unsigned char* ws, LAS unsigned char* lds, int gw, int ngw, int wave, int lane) {
    LAS float* scr = (LAS float*)(lds + wave * 16384);
    for (int it = gw; it < DEPTH * IT_LAYER; it += ngw) {
        const int l = it / IT_LAYER; int r = it - l * IT_LAYER;
        if (r < 4 * IT_GU) {
            const int which = r / IT_GU; r -= which * IT_GU; const int f = which >> 1, isup = which & 1;
            const float* W = a.in[f ? (isup ? 16 : 15) : (isup ? 3 : 2)] + (size_t)l * DM * DFF;
            const float* gain = a.in[f ? 14 : 1] + (size_t)l * DM;
            const int kb = r / (DFF / 32), nb = r % (DFF / 32), n0 = 32 * nb;
            bf16_t* WT = (bf16_t*)(ws + WS_WGU + (size_t)(l * 2 + f) * SZ_WGU);
            tr_item(W, DFF, n0, 64 * kb, gain, WT, DM, 256 * (n0 >> 7) + (n0 & 127) + 128 * isup, scr, lane);
        } else if (r < 4 * IT_GU + 2 * IT_D) {
            r -= 4 * IT_GU; const int f = r / IT_D; r -= f * IT_D;
            const float* W = a.in[f ? 17 : 4] + (size_t)l * DFF * DM;
            const int kb = r / (DM / 32), nb = r % (DM / 32);
            bf16_t* WT = (bf16_t*)(ws + WS_WD + (size_t)(l * 2 + f) * SZ_WD);
            tr_item(W, DM, 32 * nb, 64 * kb, nullptr, WT, DFF, 32 * nb, scr, lane);
        } else if (r < 4 * IT_GU + 2 * IT_D + IT_WIN) {
            r -= 4 * IT_GU + 2 * IT_D;
            const float* W = a.in[6] + (size_t)l * DM * INCOLS; const float* gain = a.in[5] + (size_t)l * DM;
            const int kb = r / (NWIN / 32), db = r % (NWIN / 32);
            bf16_t* WT = (bf16_t*)(ws + WS_WIN + (size_t)l * SZ_WIN);
            tr_item(W, INCOLS, win_src_col(db), 64 * kb, gain, WT, DM, 32 * db, scr, lane);
        } else {
            r -= 4 * IT_GU + 2 * IT_D + IT_WIN;
            const float* W = a.in[13] + (size_t)l * DM * DM; const float* gain = a.in[12] + (size_t)l * DM;
            const int kb = r / (DM / 32), nb = r % (DM / 32);
            bf16_t* WT = (bf16_t*)(ws + WS_WOUT + (size_t)l * SZ_WOUT);
            tr_item(W, DM, 32 * nb, 64 * kb, gain, WT, DM, 32 * nb, scr, lane);
        }
    }
    {
        const float* x = a.in[0]; bf16_t* xb = (bf16_t*)(ws + WS_XB); float* ssq = (float*)(ws + WS_SSQ);
        for (int m = gw; m < MROWS; m += ngw) {
            const f32x4* xr = (const f32x4*)(x + (size_t)m * DM); float s = 0.f;
#pragma unroll
            for (int j = 0; j < 4; ++j) { const f32x4 v0 = xr[(j * 64 + lane) * 2], v1 = xr[(j * 64 + lane) * 2 + 1];
                s += (v0[0] * v0[0] + v0[1] * v0[1]) + (v0[2] * v0[2] + v0[3] * v0[3]) + (v1[0] * v1[0] + v1[1] * v1[1]) + (v1[2] * v1[2] + v1[3] * v1[3]);
                u32x4 w; w.x = pk2(v0[0], v0[1]); w.y = pk2(v0[2], v0[3]); w.z = pk2(v1[0], v1[1]); w.w = pk2(v1[2], v1[3]);
                *(u32x4*)(xb + (size_t)m * DM + (j * 64 + lane) * 8) = w; }
            s = wave_sum(s);
            if (lane < 32) ssq[(size_t)m * 32 + lane] = lane == 0 ? s : 0.f;
        }
    }
    {
        float* rc = (float*)(ws + WS_ROPE); float* rs = rc + SEQ * 64;
        const int gt = gw * 64 + lane, ngt = ngw * 64;
        for (int i = gt; i < SEQ * 64; i += ngt) { const int s = i >> 6, j = i & 63;
            const float inv = exp2f(-(float)j * (13.287712379549449f / 64.0f));
            const float ang = (float)s * inv;
            const double rev = (double)ang * 0.15915494309189535; const float fr = (float)(rev - rint(rev));
            rc[i] = __builtin_amdgcn_cosf(fr); rs[i] = __builtin_amdgcn_sinf(fr); }
        for (int i = gt; i < DEPTH * 8 * DM; i += ngt) { const int l = i / (8 * DM), r = i - l * 8 * DM, h = r / DM, k = r - h * DM;
            const float v = a.in[6][((size_t)l * DM + k) * INCOLS + FZ_COL + h] * a.in[5][(size_t)l * DM + k];
            if (NAIVE_MASK & 1) ((float*)(ws + WS_WFZ))[i] = v; else ((bf16_t*)(ws + WS_WFZ))[i] = (bf16_t)f2bf(v); }
    }
}

__device__ __forceinline__ void fz_phase(const bf16_t* xb, const float* ssq, const float* wfz, const float* bf, float* logf, int blk, int nblk, int tid) {
    const int r = tid >> 3, ks = tid & 7, lane = tid & 63;
    for (int rb = blk; rb < MROWS / 64; rb += nblk) {
        const int row = rb * 64 + r;
        float acc[8];
#pragma unroll
        for (int h = 0; h < 8; ++h) acc[h] = 0.f;
        const u32x4* xp = (const u32x4*)(xb + (size_t)row * DM + ks * 256);
        for (int c = 0; c < 32; ++c) {
            float xv[8]; unpack8(xp[c], xv);
#pragma unroll
            for (int h = 0; h < 8; ++h) { const f32x4* wp = (const f32x4*)(wfz + h * DM + ks * 256 + c * 8); const f32x4 w0 = wp[0], w1 = wp[1];
                acc[h] += (xv[0] * w0[0] + xv[1] * w0[1]) + (xv[2] * w0[2] + xv[3] * w0[3]) + (xv[4] * w1[0] + xv[5] * w1[1]) + (xv[6] * w1[2] + xv[7] * w1[3]); }
        }
#pragma unroll
        for (int h = 0; h < 8; ++h) { acc[h] += __shfl_xor(acc[h], 1); acc[h] += __shfl_xor(acc[h], 2); acc[h] += __shfl_xor(acc[h], 4); }
        const f32x4 pp = *(const f32x4*)(ssq + (size_t)row * 32 + ks * 4);
        float s = (pp[0] + pp[1]) + (pp[2] + pp[3]); s += __shfl_xor(s, 1); s += __shfl_xor(s, 2); s += __shfl_xor(s, 4);
        const float rs = rsqrtf(s * (1.0f / DM) + EPS);
        float mine = acc[0];
#pragma unroll
        for (int h = 1; h < 8; ++h) mine = (ks == h) ? acc[h] : mine;
        const int b = row >> 12, sp = row & 4095;
        logf[((size_t)(b * FOXH + ks)) * SEQ + sp] = logsig_f(mine * rs + bf[ks]);
        (void)lane;
    }
}

__device__ __forceinline__ float ret_log2g(int hr) { return log2f(1.0f - exp2f(-(5.0f + (float)hr))); }

__device__ __forceinline__ void cumsum_unit(const float* lf, float* cum, LAS float* sm, int tid) {
    const int lane = tid & 63, w = tid >> 6;
    const f32x4 a = ((const f32x4*)lf)[2 * tid], b = ((const f32x4*)lf)[2 * tid + 1];
    float v0 = a[0], v1 = v0 + a[1], v2 = v1 + a[2], v3 = v2 + a[3], v4 = v3 + b[0], v5 = v4 + b[1], v6 = v5 + b[2], v7 = v6 + b[3];
    const float tot = v7; float sc = tot;
#pragma unroll
    for (int o = 1; o < 64; o <<= 1) { const float n = __shfl_up(sc, o); if (lane >= o) sc += n; }
    if (lane == 63) sm[w] = sc;
    __syncthreads();
    float base = 0.f;
    for (int i = 0; i < w; ++i) base += sm[i];
    const float ex = base + sc - tot;
    ((f32x4*)cum)[2 * tid] = (f32x4){v0 + ex, v1 + ex, v2 + ex, v3 + ex};
    ((f32x4*)cum)[2 * tid + 1] = (f32x4){v4 + ex, v5 + ex, v6 + ex, v7 + ex};
    __syncthreads();
}
__device__ __forceinline__ void retkv_unit(const bf16_t* K, const bf16_t* V, float* kv, float l2g, LAS float* lds, int tid) {
    LAS float* Kz = lds; LAS float* Vs = lds + 64 * 128;
    { const int s = tid >> 3, c0 = (tid & 7) * 16; const float z = exp2f((float)(63 - s) * l2g);
      const u32x4* kp = (const u32x4*)(K + s * 128 + c0); const u32x4* vp = (const u32x4*)(V + s * 128 + c0);
      float f[8];
#pragma unroll
      for (int j = 0; j < 2; ++j) { unpack8(kp[j], f);
#pragma unroll
          for (int i = 0; i < 8; ++i) Kz[s * 128 + c0 + j * 8 + i] = f[i] * z;
          unpack8(vp[j], f);
#pragma unroll
          for (int i = 0; i < 8; ++i) Vs[s * 128 + c0 + j * 8 + i] = f[i]; } }
    __syncthreads();
    const int e = tid & 127, dg = tid >> 7;
    float acc[32];
#pragma unroll
    for (int i = 0; i < 32; ++i) acc[i] = 0.f;
    for (int s = 0; s < 64; ++s) { const float v = Vs[s * 128 + e];
#pragma unroll
        for (int i = 0; i < 32; ++i) acc[i] += Kz[s * 128 + dg * 32 + i] * v; }
#pragma unroll
    for (int i = 0; i < 32; ++i) kv[(size_t)(dg * 32 + i) * 128 + e] = acc[i];
    __syncthreads();
}
__device__ __forceinline__ void gmlp_unit(const bf16_t* U, const bf16_t* V, const float* lng, const float* lnb, const float* wsp, const float* bsp, bf16_t* Y  , LAS float* lds, int tid) {
    LAS float* vln = lds; LAS float* Wt = lds + 128 * 128;
    const int lane = tid & 63, w = tid >> 6;
    for (int i = 0; i < 16; ++i) { const int s = 16 * w + i;
        const unsigned pr = *(const unsigned*)(V + s * 128 + 2 * lane); const float a = bf2f(pr & 0xffffu), b = bf2f(pr >> 16);
        const float mu = wave_sum(a + b) * (1.0f / 128.0f); const float da = a - mu, db = b - mu;
        const float var = wave_sum(da * da + db * db) * (1.0f / 128.0f); const float rs = rsqrtf(var + EPS);
        vln[s * 128 + 2 * lane] = da * rs * lng[2 * lane] + lnb[2 * lane]; vln[s * 128 + 2 * lane + 1] = db * rs * lng[2 * lane + 1] + lnb[2 * lane + 1]; }
    for (int i = tid; i < 128 * 128; i += NTHREADS) { const int t = i >> 7, s = i & 127; Wt[i] = (s <= t) ? wsp[i] : 0.f; }
    __syncthreads();
    const int c = tid & 127, tg = tid >> 7;
    float acc[32];
#pragma unroll
    for (int i = 0; i < 32; ++i) acc[i] = 0.f;
    for (int s4 = 0; s4 < 32; ++s4) {
        const float x0 = vln[(4 * s4) * 128 + c], x1 = vln[(4 * s4 + 1) * 128 + c], x2 = vln[(4 * s4 + 2) * 128 + c], x3 = vln[(4 * s4 + 3) * 128 + c];
#pragma unroll
        for (int i = 0; i < 32; ++i) { const f32x4 wv = *(const LAS f32x4*)(Wt + (tg * 32 + i) * 128 + 4 * s4); acc[i] += (wv[0] * x0 + wv[1] * x1) + (wv[2] * x2 + wv[3] * x3); }
    }
    __syncthreads();
#pragma unroll
    for (int i = 0; i < 32; ++i) { const int t = tg * 32 + i; const float uu = bf2f(U[t * 128 + c]); vln[t * 128 + c] = uu * (acc[i] + bsp[t]); }
    __syncthreads();
    for (int i = 0; i < 16; ++i) { const int t = 16 * w + i; const float a = vln[t * 128 + 2 * lane], b = vln[t * 128 + 2 * lane + 1];
        const float rs = rsqrtf(wave_sum(a * a + b * b) * (1.0f / 128.0f) + EPS);
        *(unsigned*)(Y + (size_t)t * DM + 2 * lane) = pk2(a * rs, b * rs); }
    __syncthreads();
}
__device__ __forceinline__ void retout_unit(const bf16_t* Q, const bf16_t* K, const bf16_t* V, const bf16_t* G, const float* sp, bf16_t* Y, float l2g, LAS float* lds, int tid) {
    LAS float* Qs = lds; LAS float* Ks = lds + 64 * 129; LAS float* Vs = lds + 2 * 64 * 129; LAS float* Sc = Vs + 64 * 128;
    const int lane = tid & 63, w = tid >> 6;
    { const int s = tid >> 3, c0 = (tid & 7) * 16; float f[8];
      const u32x4* qp = (const u32x4*)(Q + s * 128 + c0); const u32x4* kp = (const u32x4*)(K + s * 128 + c0); const u32x4* vp = (const u32x4*)(V + s * 128 + c0);
#pragma unroll
      for (int j = 0; j < 2; ++j) {
          unpack8(qp[j], f);
#pragma unroll
          for (int i = 0; i < 8; ++i) Qs[s * 129 + c0 + j * 8 + i] = f[i];
          unpack8(kp[j], f);
#pragma unroll
          for (int i = 0; i < 8; ++i) Ks[s * 129 + c0 + j * 8 + i] = f[i];
          unpack8(vp[j], f);
#pragma unroll
          for (int i = 0; i < 8; ++i) Vs[s * 128 + c0 + j * 8 + i] = f[i]; } }
    __syncthreads();
    {
        float acc[8];
#pragma unroll
        for (int j = 0; j < 8; ++j) acc[j] = 0.f;
        for (int d = 0; d < 128; ++d) { const float kk = Ks[lane * 129 + d];
#pragma unroll
            for (int j = 0; j < 8; ++j) acc[j] += Qs[(8 * w + j) * 129 + d] * kk; }
#pragma unroll
        for (int j = 0; j < 8; ++j) { const int t = 8 * w + j; Sc[t * 64 + lane] = (lane <= t) ? acc[j] * exp2f((float)(t - lane) * l2g) : 0.f; }
    }
    __syncthreads();
    const int e = tid & 127, tg = tid >> 7;
    float o[16];
#pragma unroll
    for (int j = 0; j < 16; ++j) o[j] = 0.f;
    for (int d = 0; d < 128; ++d) { const float sv = sp[(size_t)d * 128 + e];
#pragma unroll
        for (int j = 0; j < 16; ++j) o[j] += Qs[(tg * 16 + j) * 129 + d] * sv; }
#pragma unroll
    for (int j = 0; j < 16; ++j) o[j] *= exp2f((float)(tg * 16 + j + 1) * l2g);
    for (int s = 0; s < 64; ++s) { const float v = Vs[s * 128 + e];
#pragma unroll
        for (int j = 0; j < 16; ++j) o[j] += Sc[(tg * 16 + j) * 64 + s] * v; }
    __syncthreads();
#pragma unroll
    for (int j = 0; j < 16; ++j) Ks[(tg * 16 + j) * 128 + e] = o[j];
    __syncthreads();
    for (int i = 0; i < 8; ++i) { const int t = 8 * w + i; const float a = Ks[t * 128 + 2 * lane], b = Ks[t * 128 + 2 * lane + 1];
        const float rs = rsqrtf(wave_sum(a * a + b * b) * (1.0f / 128.0f) + EPS);
        const unsigned gp = *(const unsigned*)(G + t * 128 + 2 * lane);
        *(unsigned*)(Y + (size_t)t * DM + 2 * lane) = pk2(a * rs * bf2f(gp & 0xffffu), b * rs * bf2f(gp >> 16)); }
    __syncthreads();
}
__device__ __forceinline__ void attn_naive(const bf16_t* FQ, const bf16_t* FK, const bf16_t* FV, const float* cum, bf16_t* Y, int gw, int ngw, int lane) {
    const int sub = lane & 3, rl = lane >> 2;
    for (int it = gw; it < 4 * 2048; it += ngw) {
        const int vw = it & 2047, i = it >> 11;
        const int bh = (vw >> 7) + ((i >> 1) << 4), gg = vw & 127, g = (i & 1) ? 255 - gg : gg, t = g * 16 + rl;
        float q[32], o[32];
        { const u32x4* qp = (const u32x4*)(FQ + ((size_t)bh * SEQ + t) * HD + sub * 32);
#pragma unroll
          for (int j = 0; j < 4; ++j) { float f[8]; unpack8(qp[j], f);
#pragma unroll
              for (int k = 0; k < 8; ++k) q[j * 8 + k] = f[k] * 0.08838834764831845f; } }
#pragma unroll
        for (int j = 0; j < 32; ++j) o[j] = 0.f;
        float m = -1e30f, l = 0.f; const float ct = cum[(size_t)bh * SEQ + t];
        const int smax = g * 16 + 15;
        for (int s = 0; s <= smax; ++s) {
            const u32x4* kp = (const u32x4*)(FK + ((size_t)bh * SEQ + s) * HD + sub * 32);
            float d = 0.f;
#pragma unroll
            for (int j = 0; j < 4; ++j) { float f[8]; unpack8(kp[j], f);
#pragma unroll
                for (int k = 0; k < 8; ++k) d += q[j * 8 + k] * f[k]; }
            d += __shfl_xor(d, 1); d += __shfl_xor(d, 2);
            const float logit = d + ct - cum[(size_t)bh * SEQ + s];
            const bool valid = s <= t;
            const float mn = valid ? fmaxf(m, logit) : m;
            const float corr = __expf(m - mn), p = valid ? __expf(logit - mn) : 0.f;
            l = l * corr + p; m = mn;
            const u32x4* vp = (const u32x4*)(FV + ((size_t)bh * SEQ + s) * HD + sub * 32);
#pragma unroll
            for (int j = 0; j < 4; ++j) { float f[8]; unpack8(vp[j], f);
#pragma unroll
                for (int k = 0; k < 8; ++k) o[j * 8 + k] = o[j * 8 + k] * corr + p * f[k]; }
        }
        const float inv = 1.0f / l; float ss = 0.f;
#pragma unroll
        for (int j = 0; j < 32; ++j) { o[j] *= inv; ss += o[j] * o[j]; }
        ss += __shfl_xor(ss, 1); ss += __shfl_xor(ss, 2);
        const float rs = rsqrtf(ss * (1.0f / 128.0f) + EPS);
        const int b = bh >> 3, h = bh & 7;
        bf16_t* yp = Y + ((size_t)(b * SEQ + t)) * DM + h * HD + sub * 32;
#pragma unroll
        for (int j = 0; j < 4; ++j) { u32x4 wv; wv.x = pk2(o[j * 8] * rs, o[j * 8 + 1] * rs); wv.y = pk2(o[j * 8 + 2] * rs, o[j * 8 + 3] * rs); wv.z = pk2(o[j * 8 + 4] * rs, o[j * 8 + 5] * rs); wv.w = pk2(o[j * 8 + 6] * rs, o[j * 8 + 7] * rs);
            *(u32x4*)(yp + j * 8) = wv; }
    }
}


namespace fa {
constexpr int NW = 8, QBLK = 32, KVBLK = 64, QB = 256, D = 128;
constexpr int SHM_V = 16384, SHM_K = 16384;
constexpr int OFF_WS = 2 * SHM_V + 2 * SHM_K;
constexpr int OFF_CS = OFF_WS + NW * 64 * 4;
constexpr int LDS_NEED = OFF_CS + SEQ * 4;
constexpr float C2 = 1.4426950408889634f * 0.08838834764831845f;
constexpr float THR2 = 8.f * 1.4426950408889634f;
typedef float f32x16 __attribute__((ext_vector_type(16)));
typedef short s16x4 __attribute__((ext_vector_type(4)));
typedef LAS char* lptr;
#define KSWZ(row, colB) ((row) * 256 + ((colB) ^ (((row) & 7) << 4)))
#define SBAR() __builtin_amdgcn_sched_barrier(0)
__device__ __forceinline__ int v_st(int k, int c) { const int kk = (k & ~0xC) | ((k & 4) << 1) | ((k & 8) >> 1); return ((kk >> 3) * 4 + (c >> 5)) * 512 + ((kk & 7) * 32 + (c & 31)) * 2; }
__device__ __forceinline__ int v_rd_base(int lane) { return ((lane & 3) << 3) | (((lane >> 2) & 3) << 6) | (((lane >> 4) & 1) << 5) | (((lane >> 5) & 1) << 8); }
constexpr int v_rd_off(int d0, int ks, int half) { return d0 * 512 + ks * 4096 + half * 2048; }
__device__ __forceinline__ int crow(int r, int hi) { return (r & 3) + 8 * (r >> 2) + 4 * hi; }
__device__ __forceinline__ bf16x8 load8(const bf16_t* p) { return *reinterpret_cast<const bf16x8*>(p); }
__device__ __forceinline__ void bias_tile(f32x16& p0, f32x16& p1, const LAS float* cs) {
#pragma unroll
    for (int i = 0; i < 4; ++i) { const f32x4 a = *(const LAS f32x4*)(cs + 8 * i), b = *(const LAS f32x4*)(cs + 32 + 8 * i);
#pragma unroll
        for (int j = 0; j < 4; ++j) { p0[4 * i + j] = fmaf(p0[4 * i + j], C2, a[j]); p1[4 * i + j] = fmaf(p1[4 * i + j], C2, b[j]); } }
}
__device__ __forceinline__ void mask_tile(f32x16& p0, f32x16& p1, int dq) {
    const float NEG = -__builtin_inff();
#pragma unroll
    for (int r = 0; r < 16; ++r) { const int c = (r & 3) + 8 * (r >> 2);
        if (dq - c < 0) p0[r] = NEG;
        if (dq - c - 32 < 0) p1[r] = NEG; }
}
__device__ __forceinline__ void partialSM(f32x16& p0, f32x16& p1, float& m_reg, float& alpha) {
    float pmax = p0[0];
#pragma unroll
    for (int r = 1; r < 16; ++r) pmax = fmaxf(pmax, p0[r]);
#pragma unroll
    for (int r = 0; r < 16; ++r) pmax = fmaxf(pmax, p1[r]);
    { auto rr = __builtin_amdgcn_permlane32_swap(__float_as_uint(pmax), __float_as_uint(pmax), false, false);
      pmax = fmaxf(__uint_as_float(rr[0]), __uint_as_float(rr[1])); }
    float mn;
    if (__builtin_expect(__all(pmax - m_reg <= THR2), 1)) { mn = m_reg; alpha = 1.f; }
    else { mn = fmaxf(m_reg, pmax); alpha = __builtin_amdgcn_exp2f(m_reg - mn); m_reg = mn; }
#pragma unroll
    for (int r = 0; r < 16; ++r) p0[r] = p0[r] - mn;
#pragma unroll
    for (int r = 0; r < 16; ++r) p1[r] = p1[r] - mn;
#pragma unroll
    for (int r = 0; r < 16; ++r) p0[r] = __builtin_amdgcn_exp2f(p0[r]);
}
__device__ __forceinline__ void finishSM(f32x16& p0, f32x16& p1, float alpha, float& l_reg, bf16x8& pa0, bf16x8& pa1, bf16x8& pa2, bf16x8& pa3) {
#pragma unroll
    for (int r = 0; r < 16; ++r) p1[r] = __builtin_amdgcn_exp2f(p1[r]);
    float ps = 0;
#pragma unroll
    for (int r = 0; r < 16; ++r) ps += p0[r];
#pragma unroll
    for (int r = 0; r < 16; ++r) ps += p1[r];
    { auto rr = __builtin_amdgcn_permlane32_swap(__float_as_uint(ps), __float_as_uint(ps), false, false);
      ps = __uint_as_float(rr[0]) + __uint_as_float(rr[1]); }
    l_reg = l_reg * alpha + ps;
#define PK4(P, B_, OUT) do { unsigned a0 = cvt_pk_bf16(P[B_+0], P[B_+1]), a1 = cvt_pk_bf16(P[B_+2], P[B_+3]);                          \
        unsigned b0 = cvt_pk_bf16(P[B_+4], P[B_+5]), b1 = cvt_pk_bf16(P[B_+6], P[B_+7]);                                             \
        auto r0 = __builtin_amdgcn_permlane32_swap(a0, b0, false, false); auto r1 = __builtin_amdgcn_permlane32_swap(a1, b1, false, false); \
        u32x4 w = {r0[0], r1[0], r0[1], r1[1]}; OUT = *reinterpret_cast<bf16x8*>(&w); } while (0)
    PK4(p0, 0, pa0); PK4(p0, 8, pa1); PK4(p1, 0, pa2); PK4(p1, 8, pa3);
#undef PK4
}
template <int KB>
__device__ __forceinline__ void qkt(f32x16& p0, f32x16& p1, lptr K_lds, int r32, int hi, const bf16x8* qr) {
    p0 = f32x16{}; p1 = f32x16{};
    lptr kb[4];
#pragma unroll
    for (int dd = 0; dd < 4; ++dd) kb[dd] = K_lds + KB * SHM_K + KSWZ(r32, (dd * 16 + hi * 8) * 2);
#pragma unroll
    for (int d0 = 0; d0 < 8; ++d0) { lptr a = kb[d0 & 3] + (d0 >> 2) * 128;
        bf16x8 b0 = *reinterpret_cast<const LAS bf16x8*>(a);
        bf16x8 b1 = *reinterpret_cast<const LAS bf16x8*>(a + 32 * 256);
        p0 = __builtin_amdgcn_mfma_f32_32x32x16_bf16(b0, qr[d0], p0, 0, 0, 0);
        p1 = __builtin_amdgcn_mfma_f32_32x32x16_bf16(b1, qr[d0], p1, 0, 0, 0); }
}
template <int VB>
__device__ __forceinline__ void pv_tile(f32x16* o, int vb0, bf16x8 pa0, bf16x8 pa1, bf16x8 pa2, bf16x8 pa3) {
#define TRRD(dst, off) asm volatile("ds_read_b64_tr_b16 %0, %1 offset:%2" : "=&v"(dst) : "v"(vb0), "i"(off) : "memory")
#define PV_D0(d0) do { s16x4 l0, l1, l2, l3, h0, h1, h2, h3; constexpr int b_ = VB * SHM_V + v_rd_off(d0, 0, 0); \
        TRRD(l0, b_); TRRD(h0, b_ + 2048); TRRD(l1, b_ + 4096); TRRD(h1, b_ + 6144); TRRD(l2, b_ + 8192); TRRD(h2, b_ + 10240); TRRD(l3, b_ + 12288); TRRD(h3, b_ + 14336); \
        asm volatile("s_waitcnt lgkmcnt(0)" ::: "memory"); SBAR(); \
        o[d0] = __builtin_amdgcn_mfma_f32_32x32x16_bf16(pa0, (bf16x8){l0[0], l0[1], l0[2], l0[3], h0[0], h0[1], h0[2], h0[3]}, o[d0], 0, 0, 0);   \
        o[d0] = __builtin_amdgcn_mfma_f32_32x32x16_bf16(pa1, (bf16x8){l1[0], l1[1], l1[2], l1[3], h1[0], h1[1], h1[2], h1[3]}, o[d0], 0, 0, 0);   \
        o[d0] = __builtin_amdgcn_mfma_f32_32x32x16_bf16(pa2, (bf16x8){l2[0], l2[1], l2[2], l2[3], h2[0], h2[1], h2[2], h2[3]}, o[d0], 0, 0, 0);   \
        o[d0] = __builtin_amdgcn_mfma_f32_32x32x16_bf16(pa3, (bf16x8){l3[0], l3[1], l3[2], l3[3], h3[0], h3[1], h3[2], h3[3]}, o[d0], 0, 0, 0); } while (0)
    PV_D0(0); PV_D0(1); PV_D0(2); PV_D0(3);
#undef PV_D0
#undef TRRD
}
struct BlockRef { const bf16_t* Q; const bf16_t* K; const bf16_t* V; bf16_t* O; int P0; };
#define ROW(p, k0, rr) ((p) + (size_t)((k0) + (rr)) * D + sc)
#define VMW() asm volatile("s_waitcnt vmcnt(0)" ::: "memory")
#define SLOAD_H(Kp, Vp, k0) do { st_v0 = load8(ROW(Vp, k0, sr)); st_v1 = load8(ROW(Vp, k0, 32 + sr)); st_k0 = load8(ROW(Kp, k0, sr)); st_k1 = load8(ROW(Kp, k0, 32 + sr)); } while (0)
#define SWRITE_H(bf) do { *(LAS bf16x8*)(V_lds + (bf) * SHM_V + vst0) = st_v0; *(LAS bf16x8*)(V_lds + (bf) * SHM_V + vst1) = st_v1; \
                          *(LAS bf16x8*)(K_lds + (bf) * SHM_K + kws) = st_k0; *(LAS bf16x8*)(K_lds + (bf) * SHM_K + kws + 32 * 256) = st_k1; } while (0)
#define SWRITE_HK(bf) do { *(LAS bf16x8*)(K_lds + (bf) * SHM_K + kws) = st_k0; *(LAS bf16x8*)(K_lds + (bf) * SHM_K + kws + 32 * 256) = st_k1; } while (0)
#define SWRITE_HV(bf) do { *(LAS bf16x8*)(V_lds + (bf) * SHM_V + vst0) = st_v0; *(LAS bf16x8*)(V_lds + (bf) * SHM_V + vst1) = st_v1; } while (0)
__device__ __forceinline__ void block(const BlockRef& cur, lptr lds, int tid) {
    const int wid = __builtin_amdgcn_readfirstlane(tid >> 6), lane = tid & 63, r32 = lane & 31, hi = lane >> 5;
    const int NT = cur.P0 / KVBLK + 4;
    const int qlo = cur.P0 + wid * QBLK, qm = qlo + r32 - 4 * hi;
    lptr V_lds = lds; lptr K_lds = lds + 2 * SHM_V;
    LAS float* wsc = (LAS float*)(lds + OFF_WS) + wid * 64; LAS float* li_l = wsc; LAS float* al_l = wsc + 32;
    const LAS float* Cs = (const LAS float*)(lds + OFF_CS) + 4 * hi;
    float m_reg = -1e30f, l_reg = 0; f32x16 o[4] = {};
    const int sr = tid >> 4, sc = (tid & 15) * 8, vst0 = v_st(sr, sc), vst1 = v_st(32 + sr, sc), kws = KSWZ(sr, sc * 2);
    const int vb0 = (int)(unsigned)(uintptr_t)V_lds + v_rd_base(lane);
    const bf16_t* Kh = cur.K; const bf16_t* Vh = cur.V;
    bf16x8 qr[8], st_v0, st_v1, st_k0, st_k1;
#pragma unroll
    for (int d0 = 0; d0 < 8; ++d0) qr[d0] = load8(cur.Q + (size_t)(wid * QBLK + r32) * D + d0 * 16 + hi * 8);
    SLOAD_H(Kh, Vh, 0); VMW(); SWRITE_H(0);
    SLOAD_H(Kh, Vh, KVBLK);
    __syncthreads();
#define RESC(a) do { if (__any((a) < 1.f)) { if (hi == 0) al_l[r32] = (a); asm volatile("s_waitcnt lgkmcnt(0)" ::: "memory");              \
                     _Pragma("unroll") for (int d_ = 0; d_ < 4; ++d_) _Pragma("unroll") for (int r = 0; r < 16; ++r) o[d_][r] *= al_l[crow(r, hi)]; } } while (0)
#define KBASE(t) ((t) * KVBLK)
#define MASKT(P0_, P1_, t) do { const int kb_ = KBASE(t); bias_tile(P0_, P1_, Cs + kb_); if (kb_ + KVBLK - 1 > qlo) mask_tile(P0_, P1_, qm - kb_); } while (0)
    f32x16 pA0, pA1, pB0, pB1; float alA, alB; bf16x8 pa0, pa1, pa2, pa3;
    SBAR(); qkt<0>(pA0, pA1, K_lds, r32, hi, qr);
    MASKT(pA0, pA1, 0); partialSM(pA0, pA1, m_reg, alA);
    VMW(); SWRITE_H(1);
    __syncthreads();
#define HALF_STEP(PX0, PX1, alX, PY0, PY1, alY, t, KB, VB, SB) do {                                                      \
        SBAR(); qkt<KB>(PX0, PX1, K_lds, r32, hi, qr);                                             \
        finishSM(PY0, PY1, alY, l_reg, pa0, pa1, pa2, pa3); SBAR();                                                           \
        if ((t) + 1 < NT) { SLOAD_H(Kh, Vh, KBASE((t) + 1)); SBAR(); }                                               \
        pv_tile<VB>(o, vb0, pa0, pa1, pa2, pa3); MASKT(PX0, PX1, (t)); partialSM(PX0, PX1, m_reg, alX);                                        \
        __syncthreads();                                                                                                      \
        if ((t) + 1 < NT) { VMW(); SWRITE_H(SB); }                                                                          \
        RESC(alX); __syncthreads(); } while (0)
    for (int t = 1; t + 1 < NT; t += 2) {
        HALF_STEP(pB0, pB1, alB, pA0, pA1, alA, t, 1, 0, 0);
        HALF_STEP(pA0, pA1, alA, pB0, pB1, alB, t + 1, 0, 1, 1);
    }
    SBAR(); qkt<1>(pB0, pB1, K_lds, r32, hi, qr); SBAR();
    finishSM(pA0, pA1, alA, l_reg, pa0, pa1, pa2, pa3); SBAR();
    pv_tile<0>(o, vb0, pa0, pa1, pa2, pa3);
    MASKT(pB0, pB1, NT - 1); partialSM(pB0, pB1, m_reg, alB); RESC(alB);
    finishSM(pB0, pB1, alB, l_reg, pa0, pa1, pa2, pa3); SBAR(); pv_tile<1>(o, vb0, pa0, pa1, pa2, pa3);
    if (hi == 0) li_l[r32] = l_reg; asm volatile("s_waitcnt lgkmcnt(0)" ::: "memory");
    bf16_t* Ow = cur.O + (size_t)(wid * QBLK) * DM;
#pragma unroll
    for (int r = 0; r < 16; ++r) { const int orow = crow(r, hi); const float rli = __builtin_amdgcn_rcpf(li_l[orow]);
        float v0 = o[0][r] * rli, v1 = o[1][r] * rli, v2 = o[2][r] * rli, v3 = o[3][r] * rli;
        float ss = (v0 * v0 + v1 * v1) + (v2 * v2 + v3 * v3);
        ss += __shfl_xor(ss, 1); ss += __shfl_xor(ss, 2); ss += __shfl_xor(ss, 4); ss += __shfl_xor(ss, 8); ss += __shfl_xor(ss, 16);
        const float rs = rsqrtf(ss * (1.0f / 128.0f) + EPS);
        v0 *= rs; v1 *= rs; v2 *= rs; v3 *= rs;
        const float n0 = __shfl_xor(v0, 1), n1 = __shfl_xor(v1, 1), n2 = __shfl_xor(v2, 1), n3 = __shfl_xor(v3, 1);
        if ((r32 & 1) == 0) { bf16_t* op = Ow + (size_t)orow * DM + r32;
            *(unsigned*)(op) = cvt_pk_bf16(v0, n0); *(unsigned*)(op + 32) = cvt_pk_bf16(v1, n1); *(unsigned*)(op + 64) = cvt_pk_bf16(v2, n2); *(unsigned*)(op + 96) = cvt_pk_bf16(v3, n3); } }
    __syncthreads();
#undef RESC
#undef KBASE
#undef MASKT
#undef HALF_STEP
}
#undef SWRITE_HK
#undef SWRITE_HV
#undef ROW
#undef VMW
#undef SLOAD_H
#undef SWRITE_H
__device__ __forceinline__ void attn_phase(const bf16_t* FQ, const bf16_t* FK, const bf16_t* FV, const float* cum, bf16_t* Y, lptr lds, int blk, int G, int tid_) {
    for (int it2 = 2 * blk; it2 < 512; it2 += (it2 & 1) ? 2 * G - 1 : 1) {
        const int item = it2 >> 1, pass = it2 & 1; int tid = tid_; asm volatile("" : "+v"(tid));
        const int bh = item >> 3, x = item & 7, b = bh >> 3, h = bh & 7, qb = pass ? 15 - x : x;
        if (pass == 0) {
            __syncthreads();
            LAS float* Cs = (LAS float*)(lds + OFF_CS); const f32x4* cp = (const f32x4*)(cum + (size_t)bh * SEQ);
#pragma unroll
            for (int j = 0; j < 2; ++j) { const f32x4 v = cp[tid + j * NTHREADS]; *(LAS f32x4*)(Cs + 4 * (tid + j * NTHREADS)) = v * (-1.4426950408889634f); }
        }
        const bf16_t* Qh = FQ + (size_t)bh * SEQ * D; const bf16_t* Kh = FK + (size_t)bh * SEQ * D; const bf16_t* Vh = FV + (size_t)bh * SEQ * D;
        bf16_t* Yh = Y + (size_t)b * SEQ * DM + h * D;
        BlockRef br{Qh + (size_t)qb * QB * D, Kh, Vh, Yh + (size_t)qb * QB * DM, qb * QB};
        block(br, lds, tid);
    }
}
#undef KSWZ
#undef SBAR
}


namespace mx {
typedef float f32x16 __attribute__((ext_vector_type(16)));
typedef short s16x4 __attribute__((ext_vector_type(4)));
typedef LAS char* lptr;
using fa::v_st; using fa::v_rd_base; using fa::crow; using fa::load8;
template <int OFF> __device__ __forceinline__ s16x4 trrd(int vb) { s16x4 d; asm volatile("ds_read_b64_tr_b16 %0, %1 offset:%2" : "=&v"(d) : "v"(vb), "i"(OFF) : "memory"); return d; }
#define MX_LWAIT() do { asm volatile("s_waitcnt lgkmcnt(0)" ::: "memory"); __builtin_amdgcn_sched_barrier(0); } while (0)
#define MX_RD(l, h, vb, D0, KS) do { l = mx::trrd<(D0) * 512 + (KS) * 4096>(vb); h = mx::trrd<(D0) * 512 + (KS) * 4096 + 2048>(vb); } while (0)
#define MX_CAT(l, h) ((bf16x8){l[0], l[1], l[2], l[3], h[0], h[1], h[2], h[3]})
#define MX_MFMA(a, b, c) __builtin_amdgcn_mfma_f32_32x32x16_bf16((a), (b), (c), 0, 0, 0)
#define MX_PK4(P, B_, OUT) do { unsigned a0 = cvt_pk_bf16(P[B_+0], P[B_+1]), a1 = cvt_pk_bf16(P[B_+2], P[B_+3]); \
        unsigned b0 = cvt_pk_bf16(P[B_+4], P[B_+5]), b1 = cvt_pk_bf16(P[B_+6], P[B_+7]); \
        auto r0 = __builtin_amdgcn_permlane32_swap(a0, b0, false, false); auto r1 = __builtin_amdgcn_permlane32_swap(a1, b1, false, false); \
        u32x4 w = {r0[0], r1[0], r0[1], r1[1]}; OUT = *reinterpret_cast<bf16x8*>(&w); } while (0)
__device__ __forceinline__ bf16x8 scale8(const bf16x8 v, float z) {
    const u32x4 w = *reinterpret_cast<const u32x4*>(&v); float f[8]; unpack8(w, f);
    u32x4 o; o.x = cvt_pk_bf16(f[0] * z, f[1] * z); o.y = cvt_pk_bf16(f[2] * z, f[3] * z); o.z = cvt_pk_bf16(f[4] * z, f[5] * z); o.w = cvt_pk_bf16(f[6] * z, f[7] * z);
    return *reinterpret_cast<const bf16x8*>(&o);
}
__device__ __forceinline__ void retkv_phase(const bf16_t* RK, const bf16_t* RV, float* kvT, lptr lds, int blk, int G, int tid_) {
    for (int unit = blk; unit < 16 * 64; unit += G) {
        int tid = tid_; asm volatile("" : "+v"(tid));
        const int wid = __builtin_amdgcn_readfirstlane(tid >> 6), lane = tid & 63, r32 = lane & 31, hi = lane >> 5;
        const int bhr = unit >> 6, n = unit & 63; const float l2g = ret_log2g(bhr & 3);
        const size_t rowbase = (size_t)bhr * SEQ + n * 64;
        __syncthreads();
        { const int sr = tid >> 4, sc = (tid & 15) * 8;
#pragma unroll
          for (int j = 0; j < 2; ++j) { const int rr = sr + 32 * j;
              const bf16x8 k8 = load8(RK + (rowbase + rr) * HD + sc), v8 = load8(RV + (rowbase + rr) * HD + sc);
              *(LAS bf16x8*)(lds + v_st(rr, sc)) = scale8(k8, exp2f((float)(63 - rr) * l2g));
              *(LAS bf16x8*)(lds + 16384 + v_st(rr, sc)) = v8; } }
        __syncthreads();
        const int eb = wid & 3, db0 = 2 * (wid >> 2);
        const int vbK = (int)(unsigned)(uintptr_t)lds + v_rd_base(lane) + db0 * 512, vbV = (int)(unsigned)(uintptr_t)lds + 16384 + v_rd_base(lane) + eb * 512;
        f32x16 c0 = {}, c1 = {};
#define KV_STEP(KS) do { s16x4 al, ah, b0l, b0h, b1l, b1h; MX_RD(al, ah, vbV, 0, KS); MX_RD(b0l, b0h, vbK, 0, KS); MX_RD(b1l, b1h, vbK, 1, KS); MX_LWAIT(); \
            c0 = MX_MFMA(MX_CAT(al, ah), MX_CAT(b0l, b0h), c0); c1 = MX_MFMA(MX_CAT(al, ah), MX_CAT(b1l, b1h), c1); } while (0)
        KV_STEP(0); KV_STEP(1); KV_STEP(2); KV_STEP(3);
#undef KV_STEP
        float* op = kvT + ((size_t)unit << 14) + 32 * db0 + r32;
#pragma unroll
        for (int r = 0; r < 16; ++r) { const int e = 32 * eb + crow(r, hi); op[e * 128] = c0[r]; op[e * 128 + 32] = c1[r]; }
    }
}
__device__ __forceinline__ void retscan_phase(const float* kvT, bf16_t* ST, int blk, int G, int tid) {
    for (int i = blk * NTHREADS + tid; i < 16 * 128 * 64; i += G * NTHREADS) {
        const int bhr = i >> 13, rem2 = (i & 8191) * 2; const float cd = exp2f(64.0f * ret_log2g(bhr & 3));
        float s0 = 0.f, s1 = 0.f;
#pragma unroll 8
        for (int n = 0; n < 64; ++n) { const size_t o = ((size_t)(bhr * 64 + n) << 14) + rem2; const f32x2 kv = *(const f32x2*)(kvT + o);
            *(unsigned*)(ST + o) = cvt_pk_bf16(s0, s1); s0 = s0 * cd + kv.x; s1 = s1 * cd + kv.y; }
    }
}
__device__ __forceinline__ void retout_phase(const bf16_t* RQ, const bf16_t* RK, const bf16_t* RV, const bf16_t* RG, const bf16_t* ST, bf16_t* Y, lptr lds, int blk, int G, int tid_) {
    for (int unit = blk; unit < 256; unit += G) {
        int tid = tid_; asm volatile("" : "+v"(tid));
        const int wid = __builtin_amdgcn_readfirstlane(tid >> 6), lane = tid & 63, r32 = lane & 31, hi = lane >> 5;
        const int ci = wid >> 1, tb = wid & 1, bhr = unit >> 4, n = (unit & 15) * 4 + ci, hr = bhr & 3, b = bhr >> 2;
        const float l2g = ret_log2g(hr);
        const size_t rowbase = (size_t)bhr * SEQ + n * 64;
        __syncthreads();
        { const int l128 = tb * 64 + lane, row = l128 >> 1, half = l128 & 1; const bf16_t* vp = RV + (rowbase + row) * HD + half * 64;
          bf16x8 v[8];
#pragma unroll
          for (int j = 0; j < 8; ++j) v[j] = load8(vp + 8 * j);
#pragma unroll
          for (int j = 0; j < 8; ++j) *(LAS bf16x8*)(lds + ci * 16384 + v_st(row, half * 64 + 8 * j)) = v[j]; }
        bf16x8 qf[8];
#pragma unroll
        for (int ks = 0; ks < 8; ++ks) qf[ks] = load8(RQ + (rowbase + 32 * tb + r32) * HD + 16 * ks + 8 * hi);
        __syncthreads();
        f32x16 p0 = {}, p1 = {};
#pragma unroll
        for (int ks = 0; ks < 8; ++ks) { const bf16x8 k0 = load8(RK + (rowbase + r32) * HD + 16 * ks + 8 * hi); p0 = MX_MFMA(k0, qf[ks], p0); }
        if (tb) {
#pragma unroll
            for (int ks = 0; ks < 8; ++ks) { const bf16x8 k1 = load8(RK + (rowbase + 32 + r32) * HD + 16 * ks + 8 * hi); p1 = MX_MFMA(k1, qf[ks], p1); } }
        const int t = 32 * tb + r32;
#pragma unroll
        for (int r = 0; r < 16; ++r) { const int d0 = t - crow(r, hi), d1 = d0 - 32;
            p0[r] = d0 >= 0 ? p0[r] * exp2f((float)d0 * l2g) : 0.f; p1[r] = d1 >= 0 ? p1[r] * exp2f((float)d1 * l2g) : 0.f; }
        bf16x8 pa0, pa1, pa2, pa3;
        MX_PK4(p0, 0, pa0); MX_PK4(p0, 8, pa1); MX_PK4(p1, 0, pa2); MX_PK4(p1, 8, pa3);
        f32x16 o[4] = {};
        const bf16_t* stp = ST + ((size_t)(bhr * 64 + n) << 14) + (size_t)r32 * HD + 8 * hi;
#pragma unroll
        for (int eb = 0; eb < 4; ++eb)
#pragma unroll
            for (int ks = 0; ks < 8; ++ks) { const bf16x8 sf = load8(stp + eb * 32 * HD + 16 * ks); o[eb] = MX_MFMA(qf[ks], sf, o[eb]); }
#pragma unroll
        for (int r = 0; r < 16; ++r) { const float xi = exp2f((float)(32 * tb + crow(r, hi) + 1) * l2g);
#pragma unroll
            for (int eb = 0; eb < 4; ++eb) o[eb][r] *= xi; }
        const int vb = (int)(unsigned)(uintptr_t)lds + ci * 16384 + v_rd_base(lane);
#define RO_STEP(EB) do { s16x4 l0, h0, l1, h1; MX_RD(l0, h0, vb, EB, 0); MX_RD(l1, h1, vb, EB, 1); MX_LWAIT(); \
            o[EB] = MX_MFMA(pa0, MX_CAT(l0, h0), o[EB]); o[EB] = MX_MFMA(pa1, MX_CAT(l1, h1), o[EB]); \
            if (tb) { s16x4 l2, h2, l3, h3; MX_RD(l2, h2, vb, EB, 2); MX_RD(l3, h3, vb, EB, 3); MX_LWAIT(); \
                o[EB] = MX_MFMA(pa2, MX_CAT(l2, h2), o[EB]); o[EB] = MX_MFMA(pa3, MX_CAT(l3, h3), o[EB]); } } while (0)
        RO_STEP(0); RO_STEP(1); RO_STEP(2); RO_STEP(3);
#undef RO_STEP
        const bf16_t* gp = RG + (rowbase + 32 * tb) * HD + r32; bf16_t* yp = Y + ((size_t)(b * SEQ + n * 64 + 32 * tb)) * DM + 1024 + hr * HD + r32;
#pragma unroll
        for (int r = 0; r < 16; ++r) { const int tr = crow(r, hi);
            float v0 = o[0][r], v1 = o[1][r], v2 = o[2][r], v3 = o[3][r];
            float ss = (v0 * v0 + v1 * v1) + (v2 * v2 + v3 * v3);
            ss += __shfl_xor(ss, 1); ss += __shfl_xor(ss, 2); ss += __shfl_xor(ss, 4); ss += __shfl_xor(ss, 8); ss += __shfl_xor(ss, 16);
            const float rs = rsqrtf(ss * (1.0f / 128.0f) + EPS);
            v0 *= rs * bf2f(gp[tr * HD]); v1 *= rs * bf2f(gp[tr * HD + 32]); v2 *= rs * bf2f(gp[tr * HD + 64]); v3 *= rs * bf2f(gp[tr * HD + 96]);
            const float n0 = __shfl_xor(v0, 1), n1 = __shfl_xor(v1, 1), n2 = __shfl_xor(v2, 1), n3 = __shfl_xor(v3, 1);
            if ((r32 & 1) == 0) { bf16_t* op = yp + (size_t)tr * DM;
                *(unsigned*)(op) = cvt_pk_bf16(v0, n0); *(unsigned*)(op + 32) = cvt_pk_bf16(v1, n1); *(unsigned*)(op + 64) = cvt_pk_bf16(v2, n2); *(unsigned*)(op + 96) = cvt_pk_bf16(v3, n3); } }
    }
}
__device__ __forceinline__ void gmlp_phase(const bf16_t* GU, const bf16_t* GV, const float* lng, const float* lnb, const float* wsp, const float* bsp, bf16_t* Y, lptr lds, int blk, int G, int tid_) {
    for (int pu = blk; pu < 256; pu += G) {
        int tid = tid_; asm volatile("" : "+v"(tid));
        const int wid = __builtin_amdgcn_readfirstlane(tid >> 6), lane = tid & 63, r32 = lane & 31, hi = lane >> 5;
        const int ui = wid >> 2, tb = wid & 3, unit = 2 * pu + ui, g = unit & 3, n = (unit >> 2) & 31, b = unit >> 7;
        const size_t ro = ((size_t)(b * GMG + g) * SEQ + n * 128) * HD;
        __syncthreads();
        {
            const int l256 = tb * 64 + lane, ch = l256 & 15, rsub = l256 >> 4;
            float gg[8], bb[8];
#pragma unroll
            for (int j = 0; j < 8; ++j) { gg[j] = lng[g * 128 + 8 * ch + j]; bb[j] = lnb[g * 128 + 8 * ch + j]; }
#pragma unroll 2
            for (int ps = 0; ps < 8; ++ps) { const int row = ps * 16 + rsub;
                const bf16x8 v8 = load8(GV + ro + (size_t)row * HD + 8 * ch); float f[8]; unpack8(*reinterpret_cast<const u32x4*>(&v8), f);
                float s = ((f[0] + f[1]) + (f[2] + f[3])) + ((f[4] + f[5]) + (f[6] + f[7]));
                s += __shfl_xor(s, 1); s += __shfl_xor(s, 2); s += __shfl_xor(s, 4); s += __shfl_xor(s, 8);
                const float mu = s * (1.0f / 128.0f); float q = 0.f;
#pragma unroll
                for (int j = 0; j < 8; ++j) { f[j] -= mu; q += f[j] * f[j]; }
                q += __shfl_xor(q, 1); q += __shfl_xor(q, 2); q += __shfl_xor(q, 4); q += __shfl_xor(q, 8);
                const float rs = rsqrtf(q * (1.0f / 128.0f) + EPS);
                u32x4 o; o.x = cvt_pk_bf16(f[0] * rs * gg[0] + bb[0], f[1] * rs * gg[1] + bb[1]); o.y = cvt_pk_bf16(f[2] * rs * gg[2] + bb[2], f[3] * rs * gg[3] + bb[3]);
                o.z = cvt_pk_bf16(f[4] * rs * gg[4] + bb[4], f[5] * rs * gg[5] + bb[5]); o.w = cvt_pk_bf16(f[6] * rs * gg[6] + bb[6], f[7] * rs * gg[7] + bb[7]);
                *(LAS u32x4*)(lds + ui * 32768 + (row >> 6) * 16384 + v_st(row & 63, 8 * ch)) = o; }
        }
        __syncthreads();
        f32x16 acc[4] = {};
        const int vb = (int)(unsigned)(uintptr_t)lds + ui * 32768 + v_rd_base(lane);
        const int t = 32 * tb + r32; const float* wrow = wsp + (size_t)g * 128 * 128 + (size_t)t * 128 + 8 * hi;
#define GM_STEP(KS) do { if ((KS) <= 2 * tb + 1) { const f32x4 w0 = *(const f32x4*)(wrow + 16 * (KS)), w1 = *(const f32x4*)(wrow + 16 * (KS) + 4); const int sb = 16 * (KS) + 8 * hi; \
            u32x4 aw; aw.x = cvt_pk_bf16(sb + 0 <= t ? w0[0] : 0.f, sb + 1 <= t ? w0[1] : 0.f); aw.y = cvt_pk_bf16(sb + 2 <= t ? w0[2] : 0.f, sb + 3 <= t ? w0[3] : 0.f); \
            aw.z = cvt_pk_bf16(sb + 4 <= t ? w1[0] : 0.f, sb + 5 <= t ? w1[1] : 0.f); aw.w = cvt_pk_bf16(sb + 6 <= t ? w1[2] : 0.f, sb + 7 <= t ? w1[3] : 0.f); \
            const bf16x8 af = *reinterpret_cast<const bf16x8*>(&aw); \
            s16x4 l0, h0, l1, h1, l2, h2, l3, h3; constexpr int TO = ((KS) >> 2) * 16384; \
            l0 = mx::trrd<TO + 0 * 512 + ((KS) & 3) * 4096>(vb); h0 = mx::trrd<TO + 0 * 512 + ((KS) & 3) * 4096 + 2048>(vb); l1 = mx::trrd<TO + 1 * 512 + ((KS) & 3) * 4096>(vb); h1 = mx::trrd<TO + 1 * 512 + ((KS) & 3) * 4096 + 2048>(vb); \
            l2 = mx::trrd<TO + 2 * 512 + ((KS) & 3) * 4096>(vb); h2 = mx::trrd<TO + 2 * 512 + ((KS) & 3) * 4096 + 2048>(vb); l3 = mx::trrd<TO + 3 * 512 + ((KS) & 3) * 4096>(vb); h3 = mx::trrd<TO + 3 * 512 + ((KS) & 3) * 4096 + 2048>(vb); \
            MX_LWAIT(); \
            acc[0] = MX_MFMA(af, MX_CAT(l0, h0), acc[0]); acc[1] = MX_MFMA(af, MX_CAT(l1, h1), acc[1]); acc[2] = MX_MFMA(af, MX_CAT(l2, h2), acc[2]); acc[3] = MX_MFMA(af, MX_CAT(l3, h3), acc[3]); } } while (0)
        GM_STEP(0); GM_STEP(1); GM_STEP(2); GM_STEP(3); GM_STEP(4); GM_STEP(5); GM_STEP(6); GM_STEP(7);
#undef GM_STEP
        const bf16_t* up = GU + ro + (size_t)(32 * tb) * HD + r32; bf16_t* yp = Y + ((size_t)(b * SEQ + n * 128 + 32 * tb)) * DM + 1536 + g * HD + r32;
        const float* bp = bsp + g * 128 + 32 * tb;
#pragma unroll
        for (int r = 0; r < 16; ++r) { const int tr = crow(r, hi); const float bt = bp[tr];
            float v0 = bf2f(up[tr * HD]) * (acc[0][r] + bt), v1 = bf2f(up[tr * HD + 32]) * (acc[1][r] + bt), v2 = bf2f(up[tr * HD + 64]) * (acc[2][r] + bt), v3 = bf2f(up[tr * HD + 96]) * (acc[3][r] + bt);
            float ss = (v0 * v0 + v1 * v1) + (v2 * v2 + v3 * v3);
            ss += __shfl_xor(ss, 1); ss += __shfl_xor(ss, 2); ss += __shfl_xor(ss, 4); ss += __shfl_xor(ss, 8); ss += __shfl_xor(ss, 16);
            const float rs = rsqrtf(ss * (1.0f / 128.0f) + EPS);
            v0 *= rs; v1 *= rs; v2 *= rs; v3 *= rs;
            const float n0 = __shfl_xor(v0, 1), n1 = __shfl_xor(v1, 1), n2 = __shfl_xor(v2, 1), n3 = __shfl_xor(v3, 1);
            if ((r32 & 1) == 0) { bf16_t* op = yp + (size_t)tr * DM;
                *(unsigned*)(op) = cvt_pk_bf16(v0, n0); *(unsigned*)(op + 32) = cvt_pk_bf16(v1, n1); *(unsigned*)(op + 64) = cvt_pk_bf16(v2, n2); *(unsigned*)(op + 96) = cvt_pk_bf16(v3, n3); } }
    }
}
__device__ __forceinline__ void fz_phase(const bf16_t* xb, const float* ssq, const bf16_t* wfz, const float* bf, float* logf, LAS float* rsl, int blk, int G, int tid_) {
    int tid = tid_; asm volatile("" : "+v"(tid));
    const int wid = __builtin_amdgcn_readfirstlane(tid >> 6), lane = tid & 63, r32 = lane & 31, hi = lane >> 5;
    if (wid < 2) {
        for (int rb = blk * 2 + wid; rb < MROWS / 32; rb += 2 * G) {
            const bf16_t* ap = xb + (size_t)(32 * rb + r32) * DM + 8 * hi; const bf16_t* bp = wfz + (size_t)(r32 & 7) * DM + 8 * hi;
            f32x16 c = {};
#pragma unroll 8
            for (int ks = 0; ks < DM / 16; ++ks) { const bf16x8 a = load8(ap + 16 * ks); bf16x8 bv = load8(bp + 16 * ks); if (r32 >= 8) bv = (bf16x8){0, 0, 0, 0, 0, 0, 0, 0}; c = MX_MFMA(a, bv, c); }
            { const int row = lane >> 1, hs = lane & 1; const f32x4* p = (const f32x4*)(ssq + (size_t)(32 * rb + row) * 32 + hs * 16);
              const f32x4 a0 = p[0], a1 = p[1], a2 = p[2], a3 = p[3];
              float s = (((a0.x + a0.y) + (a0.z + a0.w)) + ((a1.x + a1.y) + (a1.z + a1.w))) + (((a2.x + a2.y) + (a2.z + a2.w)) + ((a3.x + a3.y) + (a3.z + a3.w)));
              s += __shfl_xor(s, 1); if (hs == 0) rsl[wid * 32 + row] = rsqrtf(s * (1.0f / DM) + EPS); }
            asm volatile("s_waitcnt lgkmcnt(0)" ::: "memory");
            if (r32 < 8) { const float bh = bf[r32];
#pragma unroll
                for (int r = 0; r < 16; ++r) { const int row = 32 * rb + crow(r, hi); const float rs = rsl[wid * 32 + crow(r, hi)];
                    logf[((size_t)((row >> 12) * FOXH + r32)) * SEQ + (row & 4095)] = logsig_f(c[r] * rs + bh); } }
            asm volatile("s_waitcnt lgkmcnt(0)" ::: "memory");
        }
    }
}
#undef MX_LWAIT
#undef MX_RD
#undef MX_CAT
#undef MX_MFMA
#undef MX_PK4
}

template <unsigned PHMASK> __global__ void __launch_bounds__(NTHREADS, 2) fwd(Args a) {
    extern __shared__ __attribute__((aligned(16))) unsigned char lds_raw[];
    LAS unsigned char* lds = (LAS unsigned char*)lds_raw;
    const int tid0 = threadIdx.x, G0 = gridDim.x, blk0 = blockIdx.x;
    unsigned char* ws0 = a.ws;
    for (int u = tid0; u < (LDS_BYTES - LDSCTL_OFF) / 4; u += NTHREADS) ((LAS unsigned*)(lds + LDSCTL_OFF))[u] = 0u;
    __syncthreads();
    XcdBarrier bar; bar.bar = (unsigned*)(ws0 + WS_CTL) + CW_BAR; bar.x = 0; bar.st = nullptr;
    if (a.use_bar) bar = xcd_barrier_post((unsigned*)(ws0 + WS_CTL) + CW_BAR, (volatile LAS unsigned*)(lds + MISC_OFF) + 8);
#define GRID_BAR() do { if (a.use_bar) xcd_barrier(bar); } while (0)
#define IN(k) (((PHMASK >> (k)) & 1u) != 0u && a.ph_lo <= (k) && (k) < a.ph_hi)
#define REP(k) for (int rep_ = 0; rep_ < (((PROBE_MASK >> (k)) & 1u) ? 1 + PROBE_REP : 1); ++rep_)

#define LV(x) asm volatile("" : "+v"(x))
#define LS(x) asm volatile("" : "+s"(x))
#define PH_ENTER() int tid = tid0, blk = blk0, G = G0; unsigned long long zoff_ = 0ull; LV(tid); LS(blk); LS(G); LS(zoff_); unsigned char* ws = ws0 + zoff_; \
        const int lane = tid & 63, wave = __builtin_amdgcn_readfirstlane(tid >> 6), gw = blk * NWAVES + wave, ngw = G * NWAVES; (void)lane; (void)gw; (void)ngw

    if (a.l_lo == 0 && IN(0)) REP(0) { PH_ENTER(); prologue(a, ws, lds, gw, ngw, wave, lane); GRID_BAR(); }

    for (int l0 = a.l_lo; l0 < a.l_hi; ++l0) {
#define FFN_PAIR(f, PU, PD) do { \
        if (IN(PU)) REP(PU) { PH_ENTER(); int l = l0; LS(l); \
            pg8::Gemm g{(const bf16_t*)(ws + WS_XB), (const bf16_t*)(ws + WS_WGU + (size_t)(l * 2 + (f)) * SZ_WGU), MROWS, NGU, DM}; pg8::StaticOrder S; S.init(MROWS, NGU, G, blk); \
            EpiSwiGLU E{(bf16_t*)(ws + WS_HID), (const float*)(ws + WS_SSQ), (LAS float*)(lds + RSL_OFF), -1, (PROBE_NULLEPI && rep_ > 0) ? 1 : 0}; \
            pg8::gemm_phase<EpiSwiGLU, pg8::StaticOrder, true, true>(lds, g, S, E, tid); \
            GRID_BAR(); \
        } \
        if (IN(PD)) REP(PD) { PH_ENTER(); int l = l0; LS(l); \
            pg8::Gemm g{(const bf16_t*)(ws + WS_HID), (const bf16_t*)(ws + WS_WD + (size_t)(l * 2 + (f)) * SZ_WD), MROWS, DM, DFF}; pg8::StaticOrder S; S.init(MROWS, DM, G, blk); \
            EpiResid E{(l == 0 && (f) == 0 && rep_ == 0) ? a.in[0] : (const float*)nullptr, (bf16_t*)(ws + WS_XB), (float*)(ws + WS_SSQ), rep_ == 0 ? 0.5f : 0.f, (PROBE_NULLEPI && rep_ > 0) ? 1 : 0}; \
            pg8::gemm_phase<EpiResid, pg8::StaticOrder, true, true>(lds, g, S, E, tid); \
            GRID_BAR(); \
        } } while (0)
        FFN_PAIR(0, 1, 2);
        if (IN(3)) REP(3) { PH_ENTER(); int l = l0; LS(l);
            pg8::Gemm g{(const bf16_t*)(ws + WS_XB), (const bf16_t*)(ws + WS_WIN + (size_t)l * SZ_WIN), MROWS, NWIN, DM}; pg8::StaticOrder S; S.init(MROWS, NWIN, G, blk);
            const float* ropec = (const float*)(ws + WS_ROPE);
            EpiWin E{(const float*)(ws + WS_SSQ), (LAS float*)(lds + RSL_OFF), ropec, ropec + SEQ * 64, (bf16_t*)(ws + WS_FQ), (bf16_t*)(ws + WS_RQ), -1};
            pg8::gemm_phase<EpiWin, pg8::StaticOrder, true, true>(lds, g, S, E, tid);
            if (NAIVE_MASK & 1) fz_phase((const bf16_t*)(ws + WS_XB), (const float*)(ws + WS_SSQ), (const float*)(ws + WS_WFZ) + (size_t)l * 8 * DM, a.in[7] + l * 8, (float*)(ws + WS_LOGF), blk, G, tid);
            else mx::fz_phase((const bf16_t*)(ws + WS_XB), (const float*)(ws + WS_SSQ), (const bf16_t*)(ws + WS_WFZ) + (size_t)l * 8 * DM, a.in[7] + l * 8, (float*)(ws + WS_LOGF), (LAS float*)(lds + RSL_OFF), blk, G, tid);
            GRID_BAR();
        }
        if (IN(4)) REP(4) { PH_ENTER(); int l = l0; LS(l);
            float* logf = (float*)(ws + WS_LOGF); float* cum = (float*)(ws + WS_CUM); float* rkv = (float*)(ws + WS_RKV);
            bf16_t *RK = (bf16_t*)(ws + WS_RK), *RV = (bf16_t*)(ws + WS_RV), *GU = (bf16_t*)(ws + WS_GU), *GV = (bf16_t*)(ws + WS_GV), *Y = (bf16_t*)(ws + WS_Y);
            for (int bh = blk; bh < NB * FOXH; bh += G) cumsum_unit(logf + (size_t)bh * SEQ, cum + (size_t)bh * SEQ, (LAS float*)lds, tid);
            if (NAIVE_MASK & 2) { for (int un = blk; un < 16 * 64; un += G) { const int bhr = un >> 6, n = un & 63; const size_t ro = ((size_t)bhr * SEQ + n * 64) * HD;
                retkv_unit(RK + ro, RV + ro, rkv + (size_t)un * 128 * 128, ret_log2g(bhr & 3), (LAS float*)lds, tid); } }
            else mx::retkv_phase(RK, RV, rkv, (mx::lptr)lds, blk, G, tid);
            if (NAIVE_MASK & 4) { for (int un = blk; un < NB * 32 * GMG; un += G) { const int g = un & 3, n = (un >> 2) & 31, b = un >> 7; const size_t ro = ((size_t)(b * GMG + g) * SEQ + n * 128) * HD;
                gmlp_unit(GU + ro, GV + ro, a.in[8] + l * 512 + g * 128, a.in[9] + l * 512 + g * 128, a.in[10] + ((size_t)l * 4 + g) * 128 * 128, a.in[11] + (l * 4 + g) * 128,
                          Y + ((size_t)(b * SEQ + n * 128)) * DM + 1536 + g * 128, (LAS float*)lds, tid); } }
            else mx::gmlp_phase(GU, GV, a.in[8] + l * 512, a.in[9] + l * 512, a.in[10] + (size_t)l * 4 * 128 * 128, a.in[11] + l * 4 * 128, Y, (mx::lptr)lds, blk, G, tid);
            GRID_BAR();
        }
        if (IN(5)) REP(5) { PH_ENTER();
            float* rkv = (float*)(ws + WS_RKV); float* rsp = (float*)(ws + WS_RSP);
            if (NAIVE_MASK & 2) { for (int i = blk * NTHREADS + tid; i < 16 * 128 * 128; i += G * NTHREADS) { const int bhr = i >> 14, de = i & 16383;
                const float cd = exp2f(64.0f * ret_log2g(bhr & 3)); float st = 0.f;
                for (int n = 0; n < 64; ++n) { const size_t o = ((size_t)(bhr * 64 + n) << 14) + de; rsp[o] = st; st = st * cd + rkv[o]; } } }
            else mx::retscan_phase(rkv, (bf16_t*)rsp, blk, G, tid);
            GRID_BAR();
        }
        if (IN(6)) REP(6) {
            { PH_ENTER();
              bf16_t *RQ = (bf16_t*)(ws + WS_RQ), *RK = (bf16_t*)(ws + WS_RK), *RV = (bf16_t*)(ws + WS_RV), *RG = (bf16_t*)(ws + WS_RG), *Y = (bf16_t*)(ws + WS_Y);
              float* rsp = (float*)(ws + WS_RSP);
              if (NAIVE_MASK & 2) { for (int un = blk; un < 16 * 64; un += G) { const int bhr = un >> 6, n = un & 63, b = bhr >> 2, hr = bhr & 3; const size_t ro = ((size_t)bhr * SEQ + n * 64) * HD;
                  retout_unit(RQ + ro, RK + ro, RV + ro, RG + ro, rsp + (size_t)un * 128 * 128, Y + ((size_t)(b * SEQ + n * 64)) * DM + 1024 + hr * 128, ret_log2g(hr), (LAS float*)lds, tid); } }
              else mx::retout_phase(RQ, RK, RV, RG, (const bf16_t*)rsp, Y, (mx::lptr)lds, blk, G, tid); }
            { PH_ENTER();
              fa::attn_phase((const bf16_t*)(ws + WS_FQ), (const bf16_t*)(ws + WS_FK), (const bf16_t*)(ws + WS_FV), (const float*)(ws + WS_CUM), (bf16_t*)(ws + WS_Y), (fa::lptr)lds, blk, G, tid); }
            GRID_BAR();
        }
        if (IN(7)) REP(7) { PH_ENTER(); int l = l0; LS(l);
            pg8::Gemm g{(const bf16_t*)(ws + WS_Y), (const bf16_t*)(ws + WS_WOUT + (size_t)l * SZ_WOUT), MROWS, DM, DM}; pg8::StaticOrder S; S.init(MROWS, DM, G, blk);
            EpiResid E{(const float*)nullptr, (bf16_t*)(ws + WS_XB), (float*)(ws + WS_SSQ), rep_ == 0 ? 1.0f : 0.f, (PROBE_NULLEPI && rep_ > 0) ? 1 : 0};
            pg8::gemm_phase<EpiResid, pg8::StaticOrder, true, true>(lds, g, S, E, tid);
            GRID_BAR();
        }
        FFN_PAIR(1, 8, 9);
#undef FFN_PAIR
    }
    if (a.l_hi == DEPTH && IN(10)) { PH_ENTER();
        const float* fn = a.in[18]; const float* ssq = (const float*)(ws + WS_SSQ);
        for (int m = gw; m < MROWS; m += ngw) {
            float s = lane < 32 ? ssq[(size_t)m * 32 + lane] : 0.f; s = wave_sum(s);
            const float rs = rsqrtf(s * (1.0f / DM) + EPS);
            f32x4* xr = (f32x4*)(a.out + (size_t)m * DM); const u32x4* xbr = (const u32x4*)((const bf16_t*)(ws + WS_XB) + (size_t)m * DM);
#pragma unroll
            for (int j = 0; j < 4; ++j) { float f[8]; unpack8(xbr[j * 64 + lane], f); const f32x4 g0 = ((const f32x4*)fn)[(j * 64 + lane) * 2], g1 = ((const f32x4*)fn)[(j * 64 + lane) * 2 + 1];
                xr[(j * 64 + lane) * 2] = (f32x4){f[0], f[1], f[2], f[3]} * rs * g0; xr[(j * 64 + lane) * 2 + 1] = (f32x4){f[4], f[5], f[6], f[7]} * rs * g1; }
        }
    }
#undef PH_ENTER
#undef LV
#undef LS
#undef IN
#undef GRID_BAR
}

extern "C" void kernel_launch(void* const* d_in, const int* in_sizes, int n_in, void* d_out, int out_size, void* d_ws, size_t ws_size, hipStream_t stream) {
    static int grid = 0;
    if (grid == 0) {
        if (n_in != 19 || in_sizes[0] != MROWS * DM || out_size != MROWS * DM || ws_size < WS_END) { fprintf(stderr, "kernel_launch: unexpected shapes (n_in %d, in0 %d, out %d, ws %zu < %zu)\n", n_in, n_in > 0 ? in_sizes[0] : -1, out_size, ws_size, (size_t)WS_END); grid = -1; return; }
        int dev = 0, cus = 0;
        if (hipGetDevice(&dev) != hipSuccess || hipDeviceGetAttribute(&cus, hipDeviceAttributeMultiprocessorCount, dev) != hipSuccess) { grid = -1; return; }
#define SETATTR(K) do { if (hipFuncSetAttribute((const void*)(K), hipFuncAttributeMaxDynamicSharedMemorySize, LDS_BYTES) != hipSuccess) { fprintf(stderr, "kernel_launch: hipFuncSetAttribute failed\n"); grid = -1; return; } } while (0)
#if MK_SPLIT
        SETATTR(fwd<1u << 0>); SETATTR(fwd<1u << 1>); SETATTR(fwd<1u << 2>); SETATTR(fwd<1u << 3>); SETATTR(fwd<1u << 4>); SETATTR(fwd<1u << 5>);
        SETATTR(fwd<1u << 6>); SETATTR(fwd<1u << 7>); SETATTR(fwd<1u << 8>); SETATTR(fwd<1u << 9>); SETATTR(fwd<1u << 10>);
#else
        SETATTR(fwd<0x7ffu>);
        int per_cu = 0;
        if (hipOccupancyMaxActiveBlocksPerMultiprocessor(&per_cu, (const void*)fwd<0x7ffu>, NTHREADS, LDS_BYTES) != hipSuccess || per_cu < 1) fprintf(stderr, "kernel_launch: occupancy query reports %d\n", per_cu);
        (void)hipGetLastError();
#endif
        grid = cus;
    }
    if (grid < 0) return;
    (void)hipMemsetAsync((char*)d_ws + WS_CTL, 0, CTL_ZERO_BYTES, stream);
    Args a{};
    for (int i = 0; i < 19; ++i) a.in[i] = (const float*)d_in[i];
    a.out = (float*)d_out; a.ws = (unsigned char*)d_ws; a.pad = 0;
#if MK_SPLIT
    a.use_bar = 0;
#define LAUNCH1(PH, LL, LH) do { Args p = a; p.l_lo = (LL); p.l_hi = (LH); p.ph_lo = (PH); p.ph_hi = (PH) + 1; hipLaunchKernelGGL(fwd<(1u << (PH))>, dim3(grid), dim3(NTHREADS), LDS_BYTES, stream, p); } while (0)
    LAUNCH1(0, 0, 0);
    for (int l = 0; l < DEPTH; ++l) { LAUNCH1(1, l, l + 1); LAUNCH1(2, l, l + 1); LAUNCH1(3, l, l + 1); LAUNCH1(4, l, l + 1); LAUNCH1(5, l, l + 1); LAUNCH1(6, l, l + 1); LAUNCH1(7, l, l + 1); LAUNCH1(8, l, l + 1); LAUNCH1(9, l, l + 1); }
    LAUNCH1(10, DEPTH, DEPTH);
#else
    a.use_bar = 1; a.l_lo = 0; a.l_hi = DEPTH; a.ph_lo = 0; a.ph_hi = 11;
    hipLaunchKernelGGL(fwd<0x7ffu>, dim3(grid), dim3(NTHREADS), LDS_BYTES, stream, a);
#endif
}
```

```cpp
#include <hip/hip_runtime.h>
#include <cstdio>
#include <cstdint>

#ifndef MK_SPLIT
#define MK_SPLIT 0
#endif

#ifndef PROBE_MASK
#define PROBE_MASK 0u
#endif
#ifndef NAIVE_MASK
#define NAIVE_MASK 0
#endif
#ifndef PROBE_NULLEPI
#define PROBE_NULLEPI 0
#endif
#ifndef PROBE_SPIN_MASK
#define PROBE_SPIN_MASK 0u
#endif
#ifndef PROBE_SPIN_AMP
#define PROBE_SPIN_AMP 4
#endif
#ifndef STAGGER_TICKS
#define STAGGER_TICKS 0
#endif
#ifndef PROBE_CLOCK
#define PROBE_CLOCK 0
#endif
#ifndef PROBE_TILES
#define PROBE_TILES 0
#endif
#ifndef PROBE_REP
#define PROBE_REP 1
#endif
#define LAS __attribute__((address_space(3)))
#define GAS __attribute__((address_space(1)))
typedef unsigned short bf16_t;
typedef short bf16x8 __attribute__((ext_vector_type(8)));
typedef float f32x4 __attribute__((ext_vector_type(4)));
typedef float f32x2 __attribute__((ext_vector_type(2)));
typedef unsigned u32x4 __attribute__((ext_vector_type(4)));
typedef unsigned u32x2 __attribute__((ext_vector_type(2)));
typedef int i32x4 __attribute__((ext_vector_type(4)));

constexpr int DM = 2048, NB = 4, SEQ = 4096, DEPTH = 4, MROWS = NB * SEQ, DFF = 5632, HD = 128;
constexpr int FOXH = 8, RETH = 4, GMG = 4;
constexpr int INCOLS = 6152, NWIN = 6144, NGU = 2 * DFF;
constexpr int FZ_COL = 3072;
constexpr float EPS = 1e-6f;
constexpr int NWAVES = 8, NTHREADS = 512;

constexpr size_t MiB = 1u << 20;
constexpr size_t WS_CTL = 0, CTL_ZERO_BYTES = 1 * MiB;
constexpr size_t WS_SSQ = 1 * MiB;
constexpr size_t WS_ROPE = 3 * MiB;
constexpr size_t WS_LOGF = 5 * MiB;
constexpr size_t WS_CUM = 5 * MiB + 512 * 1024;
constexpr size_t WS_WFZ = 6 * MiB;
constexpr size_t WS_NORM = 7 * MiB;
constexpr size_t WS_WGU = 8 * MiB;
constexpr size_t SZ_WGU = (size_t)NGU * DM * 2;
constexpr size_t WS_WD = WS_WGU + 8 * SZ_WGU;
constexpr size_t SZ_WD = (size_t)DM * DFF * 2;
constexpr size_t WS_WIN = WS_WD + 8 * SZ_WD;
constexpr size_t SZ_WIN = (size_t)NWIN * DM * 2;
constexpr size_t WS_WOUT = WS_WIN + 4 * SZ_WIN;
constexpr size_t SZ_WOUT = (size_t)DM * DM * 2;
constexpr size_t WS_XB = WS_WOUT + 4 * SZ_WOUT;
constexpr size_t WS_ACT = WS_XB + (size_t)MROWS * DM * 2;
constexpr size_t WS_HID = WS_ACT;
constexpr size_t SZ_FOX = (size_t)NB * FOXH * SEQ * HD * 2;
constexpr size_t SZ_R = (size_t)NB * RETH * SEQ * HD * 2;
constexpr size_t WS_FQ = WS_ACT, WS_FK = WS_FQ + SZ_FOX, WS_FV = WS_FK + SZ_FOX;
constexpr size_t WS_RQ = WS_FV + SZ_FOX, WS_RK = WS_RQ + SZ_R, WS_RV = WS_RK + SZ_R, WS_RG = WS_RV + SZ_R;
constexpr size_t WS_GU = WS_RG + SZ_R, WS_GV = WS_GU + SZ_R;
constexpr size_t WS_Y = WS_GV + SZ_R;
constexpr size_t WS_RKV = WS_Y + (size_t)MROWS * DM * 2;
constexpr size_t SZ_RKV = (size_t)16 * 64 * 128 * 128 * 4;
constexpr size_t WS_RSP = WS_RKV + SZ_RKV;
constexpr size_t WS_PART = WS_RSP + SZ_RKV;
constexpr size_t SZ_PART = (size_t)512 * 8 * 66 * 64 * 4;
constexpr size_t WS_XQ = WS_PART + SZ_PART;
constexpr size_t WS_QS = WS_XQ + (size_t)MROWS * DM;
constexpr size_t WS_END = WS_QS + (size_t)MROWS * 4;
static_assert(WS_WGU >= WS_WFZ + (size_t)DEPTH * 8 * DM * 4, "ws map");
static_assert(WS_Y + (size_t)MROWS * DM * 2 >= WS_HID + (size_t)MROWS * DFF * 2, "hid overlay fits");

constexpr int CW_BAR = 4096;
constexpr int CW_FLAGS = 32768;
constexpr int CW_QCNT = 40960;
constexpr int CW_CMAX = 131072;
constexpr int CW_QUEUE = 16384;

constexpr int RING_BYTES = 131072;
constexpr int LDSCTL_OFF = RING_BYTES, MISC_OFF = LDSCTL_OFF + 320;
constexpr int LDS_BYTES = 147456;
constexpr int CSL_OFF = LDSCTL_OFF + 4096;
constexpr int RSL_OFF = LDSCTL_OFF + 1024;

__device__ __forceinline__ float bf2f(unsigned h) { return __uint_as_float(h << 16); }
__device__ __forceinline__ unsigned f2bf(float f) { unsigned u = __float_as_uint(f); return (u + 0x7fffu + ((u >> 16) & 1u)) >> 16; }
__device__ __forceinline__ unsigned pk2(float lo, float hi) { return f2bf(lo) | (f2bf(hi) << 16); }
__device__ __forceinline__ unsigned cvt_pk_bf16(float lo, float hi) { unsigned r; asm volatile("v_cvt_pk_bf16_f32 %0, %1, %2" : "=v"(r) : "v"(lo), "v"(hi)); return r; }
__device__ __forceinline__ float wave_sum(float v) {
#pragma unroll
    for (int o = 1; o < 64; o <<= 1) v += __shfl_xor(v, o);
    return v;
}
__device__ __forceinline__ float silu_f(float x) { return x * __builtin_amdgcn_rcpf(1.0f + __builtin_amdgcn_exp2f(-1.4426950408889634f * x)); }
__device__ __forceinline__ float gelu_tanh_f(float x) { const float u = (2.0f * 1.4426950408889634f * 0.7978845608028654f) * (x + 0.044715f * x * x * x); return x * __builtin_amdgcn_rcpf(1.0f + __builtin_amdgcn_exp2f(-u)); }
__device__ __forceinline__ float logsig_f(float z) { return fminf(z, 0.f) - log1pf(__expf(-fabsf(z))); }
__device__ __forceinline__ void unpack8(const u32x4 w, float* f) {
    f[0] = __uint_as_float(w.x << 16); f[1] = __uint_as_float(w.x & 0xffff0000u);
    f[2] = __uint_as_float(w.y << 16); f[3] = __uint_as_float(w.y & 0xffff0000u);
    f[4] = __uint_as_float(w.z << 16); f[5] = __uint_as_float(w.z & 0xffff0000u);
    f[6] = __uint_as_float(w.w << 16); f[7] = __uint_as_float(w.w & 0xffff0000u);
}
#define LDS_WAIT() asm volatile("s_waitcnt lgkmcnt(0)" ::: "memory")
#define VM_WAIT() asm volatile("s_waitcnt vmcnt(0)" ::: "memory")

#define XB_TMO      128
#define XB_XCNT(j)  (256  + 64 * (j))
#define XB_XSUB(j)  (1280 + 64 * (j))
#define XB_XGEN(j)  (2304 + 64 * (j))
#define XB_TOP      3328
#define XB_TOPGEN   3392
#define XCD_BAR_WORDS 3456
#define XB_SPIN_CAP (1u << 22)
__device__ __forceinline__ unsigned xb_ld(unsigned* p)              { return __hip_atomic_load(p, __ATOMIC_RELAXED, __HIP_MEMORY_SCOPE_AGENT); }
__device__ __forceinline__ unsigned xb_add(unsigned* p, unsigned v) { return __hip_atomic_fetch_add(p, v, __ATOMIC_RELAXED, __HIP_MEMORY_SCOPE_AGENT); }
__device__ __forceinline__ unsigned xb_xcc_id() { return (unsigned)__builtin_amdgcn_s_getreg((3 << 11) | 20) & 0xFu; }
#define XB_SPIN(cond, bar) do { unsigned _sp = 0; while (cond) { __builtin_amdgcn_s_sleep(1); \
    if ((++_sp & 255u) == 0u) { if (xb_ld(&(bar)[XB_TMO])) break; if (_sp > XB_SPIN_CAP) { atomicAdd(&(bar)[XB_TMO], 1u); break; } } } } while (0)
struct XcdBarrier { unsigned* bar; unsigned x; volatile LAS unsigned* st; };
__device__ __forceinline__ XcdBarrier xcd_barrier_post(unsigned* bar, volatile LAS unsigned* st) {
    XcdBarrier b; b.bar = bar; b.x = xb_xcc_id(); b.st = st;
    if (threadIdx.x == 0) (void)xb_add(&bar[XB_XCNT(b.x)], 1u);
    return b;
}
__device__ __forceinline__ void xcd_barrier_complete(unsigned* bar, unsigned x, unsigned& nloc, unsigned& nx) {
    const unsigned G = gridDim.x * gridDim.y * gridDim.z;
    unsigned sum, cnt, mine, sp = 0u;
    for (;;) {
        sum = 0u; cnt = 0u; mine = 0u;
#pragma unroll
        for (unsigned j = 0; j < 16; ++j) { const unsigned c = xb_ld(&bar[XB_XCNT(j)]); sum += c; cnt += (c > 0u) ? 1u : 0u; mine = (j == x) ? c : mine; }
        if (sum == G) break;
        __builtin_amdgcn_s_sleep(1);
        if ((++sp & 255u) == 0u) { if (xb_ld(&bar[XB_TMO])) break; if (sp > XB_SPIN_CAP) { atomicAdd(&bar[XB_TMO], 1u); break; } }
    }
    nloc = mine > 0u ? mine : 1u; nx = cnt > 0u ? cnt : 1u;
}
__device__ __forceinline__ void xcd_barrier(const XcdBarrier& b) {
    asm volatile("s_waitcnt vmcnt(0)" ::: "memory");
    __syncthreads();
    if (threadIdx.x == 0) {
        unsigned long long zb_ = 0ull; asm volatile("" : "+s"(zb_));
        unsigned* bar = b.bar + zb_; unsigned bx = b.x; asm volatile("" : "+s"(bx));
        __builtin_amdgcn_s_waitcnt(0);
        unsigned nloc = b.st[0], nx = b.st[1];
        if (nloc == 0u) { xcd_barrier_complete(bar, bx, nloc, nx); b.st[0] = nloc; b.st[1] = nx; }
        const unsigned old = xb_add(&bar[XB_XSUB(bx)], 1u);
        const unsigned gen = old / nloc;
        if (old + 1u == (gen + 1u) * nloc) {
            __builtin_amdgcn_fence(__ATOMIC_RELEASE, "agent");
            asm volatile("s_waitcnt vmcnt(0)" ::: "memory");
            const unsigned og = xb_add(&bar[XB_TOP], 1u);
            const unsigned tg = og / nx;
            if (og + 1u == (tg + 1u) * nx) xb_add(&bar[XB_TOPGEN], 1u);
            else XB_SPIN(xb_ld(&bar[XB_TOPGEN]) == tg, bar);
            __builtin_amdgcn_fence(__ATOMIC_ACQUIRE, "agent");
            xb_add(&bar[XB_XGEN(bx)], 1u);
            asm volatile("s_waitcnt vmcnt(0)" ::: "memory");
        } else {
            XB_SPIN(xb_ld(&bar[XB_XGEN(bx)]) == gen, bar);
            __builtin_amdgcn_fence(__ATOMIC_ACQUIRE, "agent");
            asm volatile("s_waitcnt vmcnt(0)" ::: "memory");
        }
    }
    __syncthreads();
}

namespace pg8 {
#define PG8_LAS __attribute__((address_space(3)))
constexpr int BM = 256, BK = 64, HALF = 128, HTB = HALF * BK * 2, STAGE_BYTES = 8 * HTB, NXCD = 8, WGM = 8;
__host__ __device__ __forceinline__ int lds_byte(int r, int c) { const int st = (r >> 4) * 2 + (c >> 5), rr = r & 15, cc = c & 31, ob = rr * 64 + cc * 2; return st * 1024 + (ob ^ (((ob >> 9) & 1) << 5)); }
__host__ __device__ __forceinline__ void stage_rc(int b, int& R, int& C) { const int st = b / 1024, sb = b % 1024, swz = sb ^ (((sb >> 9) & 1) << 5); R = (st >> 1) * 16 + swz / 64; C = (st & 1) * 32 + (swz % 64) / 2; }
__host__ __device__ __forceinline__ int perm32(int rho) { const int n = rho >> 4, i = rho & 15; return 8 * (i >> 2) + 4 * n + (i & 3); }
struct Unit { int pm, pn; };
struct Gemm { const bf16_t* A; const bf16_t* Bt; int M, N, K; };
struct StaticOrder {
    int nM, nN, nwg, G, c;
    __host__ __device__ void init(int M, int N, int G_, int c_) { nM = M / BM; nN = N / BM; nwg = nM * nN; G = G_; c = c_; }
    __host__ __device__ __forceinline__ bool next(int i, Unit& u) const {
        const long L = (long)i * G + c; if (L >= nwg) return false;
        int wgid = (int)L; { const int q = nwg / NXCD, r = nwg % NXCD, xcd = wgid % NXCD, off = wgid / NXCD; wgid = (xcd < r ? xcd * (q + 1) : r * (q + 1) + (xcd - r) * q) + off; }
        const int nig = WGM * nN, gid = wgid / nig, fm = gid * WGM, gsz = (nM - fm) < WGM ? (nM - fm) : WGM;
        u.pm = fm + ((wgid % nig) % gsz); u.pn = (wgid % nig) / gsz; return true;
    }
    __device__ __forceinline__ void a_ready(const Unit&) const {}
    __device__ __forceinline__ void done(const Unit&) const {}
};
__device__ __forceinline__ f32x4 mma1(const bf16x8 a, const bf16x8 b, const f32x4 c) { return __builtin_amdgcn_mfma_f32_16x16x32_bf16(a, b, c, 0, 0, 0); }
__device__ __forceinline__ i32x4 mma1(const i32x4 a, const i32x4 b, const i32x4 c) { return __builtin_amdgcn_mfma_i32_16x16x64_i8(a, b, c, 0, 0, 0); }
template <bool I8> struct AccT { typedef f32x4 acc; typedef bf16x8 frag; };
template <> struct AccT<true> { typedef i32x4 acc; typedef i32x4 frag; };
template <class Epi, class Sched, bool ALIGN_EPI = false, bool SP2 = false, bool A_TILED = false, bool I8 = false>
__device__ __forceinline__ void gemm_phase(PG8_LAS unsigned char* lds, const Gemm g, const Sched& S, Epi& E, const int tid) {
    typedef typename AccT<I8>::acc acc_t; typedef typename AccT<I8>::frag frag_t;
    const int wid = __builtin_amdgcn_readfirstlane(tid >> 6), lane = tid & 63, wr = wid >> 2, wc = wid & 3, fr = lane & 15, fq = lane >> 4;
    const int K = g.K, nt = K / BK;
    unsigned voffA[2], voffB[2];
#pragma unroll
    for (int i = 0; i < 2; ++i) { int R, C; stage_rc(tid * 16 + i * 8192, R, C); const int Rb = Epi::PERM ? ((R & ~31) + perm32(R & 31)) : R;
        voffA[i] = A_TILED ? (unsigned)(R * BK + C) * 2u : (unsigned)(R * K + C) * 2u; voffB[i] = (unsigned)(Rb * BK + C) * 2u; }
    const size_t kstep = A_TILED ? (size_t)BM * BK * 2 : (size_t)(BK * 2);
    const size_t hstep = A_TILED ? (size_t)HALF * BK * 2 : (size_t)HALF * K * 2;
    const size_t tstep = (size_t)BM * K * 2;
    const size_t kstepB = (size_t)BM * BK * 2, hstepB = (size_t)HALF * BK * 2;
    const unsigned ldsw = (unsigned)wid * 1024u;
    const int aoff = lds_byte(wr * 64 + fr, fq * 8), boff = lds_byte(wc * 32 + fr, fq * 8);
#define PG8_SA(b, h) (((b) * 2 + (h)) * HTB)
#define PG8_SB(b, h) ((4 + (b) * 2 + (h)) * HTB)
#define PG8_STAGE(bufoff, gbase, voff) do { _Pragma("unroll") for (int _i = 0; _i < 2; ++_i) \
        __builtin_amdgcn_global_load_lds((const unsigned*)((const char*)(gbase) + (voff)[_i]), (PG8_LAS unsigned*)(lds + (bufoff) + ldsw + _i * 8192), 16, 0, 0); } while (0)
#define PG8_LDA(dst, b, h) do { _Pragma("unroll") for (int m = 0; m < 4; ++m) _Pragma("unroll") for (int k = 0; k < 2; ++k) dst[m][k] = *(const PG8_LAS frag_t*)(lds + PG8_SA(b, h) + aoff + m * 2048 + k * 1024); } while (0)
#define PG8_LDB(dst, b, h) do { _Pragma("unroll") for (int n = 0; n < 2; ++n) _Pragma("unroll") for (int k = 0; k < 2; ++k) dst[n][k] = *(const PG8_LAS frag_t*)(lds + PG8_SB(b, h) + boff + n * 2048 + k * 1024); } while (0)
#define PG8_MMA(ai, bj, At, Bt) do { __builtin_amdgcn_s_setprio(1); _Pragma("unroll") for (int m = 0; m < 4; ++m) _Pragma("unroll") for (int n = 0; n < 2; ++n) _Pragma("unroll") for (int k = 0; k < 2; ++k) \
        acc[ai][bj][m][n] = mma1(Bt[n][k], At[m][k], acc[ai][bj][m][n]); __builtin_amdgcn_s_setprio(0); } while (0)
#define PG8_WAIT_V(n) asm volatile("s_waitcnt vmcnt(" #n ")" ::: "memory")
#define PG8_WAIT_L(n) asm volatile("s_waitcnt lgkmcnt(" #n ")" ::: "memory")
#define PG8_BAR __builtin_amdgcn_s_barrier()
#define PG8_SCHED __builtin_amdgcn_sched_barrier(0)
    Unit cur, nxt; int ui = 0;
    if (!S.next(0, cur)) return;
    acc_t acc[2][2][4][2];
#pragma unroll
    for (int a = 0; a < 2; ++a)
#pragma unroll
        for (int b = 0; b < 2; ++b)
#pragma unroll
            for (int m = 0; m < 4; ++m)
#pragma unroll
                for (int n = 0; n < 2; ++n) acc[a][b][m][n] = acc_t{};
    frag_t At[4][2], B0[2][2], B1[2][2];
    const char* cA = (const char*)g.A + (size_t)cur.pm * tstep; const char* cB = (const char*)g.Bt + (size_t)cur.pn * tstep;
    S.a_ready(cur);
    if constexpr (SP2) {
        PG8_STAGE(PG8_SB(0, 0), cB, voffB); PG8_STAGE(PG8_SB(0, 1), cB + hstepB, voffB); PG8_STAGE(PG8_SA(0, 0), cA, voffA); PG8_STAGE(PG8_SA(0, 1), cA + hstep, voffA);
        if (wr == 1) PG8_BAR;
        PG8_WAIT_V(2); PG8_BAR;
        PG8_STAGE(PG8_SB(1, 0), cB + kstepB, voffB); PG8_STAGE(PG8_SA(1, 0), cA + kstep, voffA); PG8_STAGE(PG8_SB(1, 1), cB + hstepB + kstepB, voffB);
        PG8_WAIT_V(6); PG8_BAR;
    } else {
        PG8_STAGE(PG8_SB(0, 0), cB, voffB); PG8_STAGE(PG8_SA(0, 0), cA, voffA); PG8_STAGE(PG8_SB(0, 1), cB + hstepB, voffB); PG8_STAGE(PG8_SA(0, 1), cA + hstep, voffA);
        if (wr == 1) PG8_BAR;
        PG8_WAIT_V(4); PG8_BAR;
        PG8_STAGE(PG8_SB(1, 0), cB + kstepB, voffB); PG8_STAGE(PG8_SA(1, 0), cA + kstep, voffA); PG8_STAGE(PG8_SB(1, 1), cB + hstepB + kstepB, voffB);
        PG8_WAIT_V(6); PG8_BAR;
    }
    for (;;) {
        if constexpr (I8) { if (wid == 0) E.stage(lds, cur, lane); }
        const bool has_next = S.next(ui + 1, nxt);
        const char* nA = has_next ? (const char*)g.A + (size_t)nxt.pm * tstep : cA; const char* nB = has_next ? (const char*)g.Bt + (size_t)nxt.pn * tstep : cB;
        for (int t = 0; t < nt; t += 2) {
            const bool last = (t == nt - 2);
            const char* a1 = cA + (size_t)(t + 1) * kstep;
            const char* a2 = last ? nA : cA + (size_t)(t + 2) * kstep; const char* b2 = last ? nB : cB + (size_t)(t + 2) * kstepB;
            const char* a3 = a2 + kstep; const char* b3 = b2 + kstepB;
            if (last && has_next) S.a_ready(nxt);
            if constexpr (SP2) {
            PG8_LDB(B0, 0, 0); PG8_LDB(B1, 0, 1); PG8_SCHED; PG8_LDA(At, 0, 0); PG8_STAGE(PG8_SA(1, 1), a1 + hstep, voffA);
            PG8_WAIT_V(8); PG8_WAIT_L(0); PG8_BAR; PG8_MMA(0, 0, At, B0); PG8_MMA(0, 1, At, B1); PG8_BAR; PG8_SCHED;
            PG8_LDA(At, 0, 1); PG8_STAGE(PG8_SB(0, 0), b2, voffB); PG8_STAGE(PG8_SB(0, 1), b2 + hstepB, voffB); PG8_STAGE(PG8_SA(0, 0), a2, voffA);
            PG8_WAIT_V(8); PG8_WAIT_L(0); PG8_BAR; PG8_MMA(1, 0, At, B0); PG8_MMA(1, 1, At, B1); PG8_BAR; PG8_SCHED;
            PG8_LDB(B0, 1, 0); PG8_LDB(B1, 1, 1); PG8_SCHED; PG8_LDA(At, 1, 0); PG8_STAGE(PG8_SA(0, 1), a2 + hstep, voffA);
            PG8_WAIT_V(8); PG8_WAIT_L(0); PG8_BAR; PG8_MMA(0, 0, At, B0); PG8_MMA(0, 1, At, B1); PG8_BAR; PG8_SCHED;
            PG8_LDA(At, 1, 1); PG8_STAGE(PG8_SB(1, 0), b3, voffB); PG8_STAGE(PG8_SB(1, 1), b3 + hstepB, voffB); PG8_STAGE(PG8_SA(1, 0), a3, voffA);
            PG8_WAIT_V(8); PG8_WAIT_L(0); PG8_BAR; PG8_MMA(1, 0, At, B0); PG8_MMA(1, 1, At, B1); PG8_BAR; PG8_SCHED;
            } else {
            PG8_LDB(B0, 0, 0); PG8_SCHED; PG8_LDA(At, 0, 0); PG8_STAGE(PG8_SA(1, 1), a1 + hstep, voffA);
            PG8_WAIT_L(8); PG8_BAR; PG8_WAIT_L(0); PG8_MMA(0, 0, At, B0); PG8_BAR; PG8_SCHED;
            PG8_LDB(B1, 0, 1); PG8_STAGE(PG8_SB(0, 0), b2, voffB);
            PG8_BAR; PG8_WAIT_L(0); PG8_MMA(0, 1, At, B1); PG8_BAR;
            PG8_LDA(At, 0, 1); PG8_STAGE(PG8_SA(0, 0), a2, voffA);
            PG8_BAR; PG8_WAIT_L(0); PG8_MMA(1, 0, At, B0); PG8_BAR; PG8_SCHED;
            PG8_STAGE(PG8_SB(0, 1), b2 + hstepB, voffB);
            PG8_WAIT_V(6); PG8_BAR; PG8_MMA(1, 1, At, B1); PG8_BAR;
            PG8_LDB(B0, 1, 0); PG8_SCHED; PG8_LDA(At, 1, 0); PG8_STAGE(PG8_SA(0, 1), a2 + hstep, voffA);
            PG8_WAIT_L(8); PG8_BAR; PG8_WAIT_L(0); PG8_MMA(0, 0, At, B0); PG8_BAR; PG8_SCHED;
            PG8_LDB(B1, 1, 1); PG8_STAGE(PG8_SB(1, 0), b3, voffB);
            PG8_BAR; PG8_WAIT_L(0); PG8_MMA(0, 1, At, B1); PG8_BAR;
            PG8_LDA(At, 1, 1); PG8_STAGE(PG8_SA(1, 0), a3, voffA);
            PG8_BAR; PG8_WAIT_L(0); PG8_MMA(1, 0, At, B0); PG8_BAR; PG8_SCHED;
            PG8_STAGE(PG8_SB(1, 1), b3 + hstepB, voffB);
            PG8_WAIT_V(6); PG8_BAR; PG8_MMA(1, 1, At, B1); PG8_BAR;
            }
        }
        if constexpr (ALIGN_EPI) { if (wr == 0) PG8_BAR; }
        E(acc, cur, wr, wc, fr, fq, tid); S.done(cur);
        if (!has_next) break;
#pragma unroll
        for (int a = 0; a < 2; ++a)
#pragma unroll
            for (int b = 0; b < 2; ++b)
#pragma unroll
                for (int m = 0; m < 4; ++m)
#pragma unroll
                    for (int n = 0; n < 2; ++n) acc[a][b][m][n] = acc_t{};
        cur = nxt; cA = nA; cB = nB; ++ui;
        if constexpr (ALIGN_EPI) { if (wr == 1) PG8_BAR; }
    }
    PG8_WAIT_V(0);
    if constexpr (!ALIGN_EPI) { if (wr == 0) PG8_BAR; }
    PG8_BAR;
#undef PG8_SA
#undef PG8_SB
#undef PG8_STAGE
#undef PG8_LDA
#undef PG8_LDB
#undef PG8_MMA
#undef PG8_WAIT_V
#undef PG8_WAIT_L
#undef PG8_BAR
#undef PG8_SCHED
}
}

__device__ __forceinline__ float row_rstd(const float* ssq, int row, int fq) {
    const f32x4* p = (const f32x4*)(ssq + (size_t)row * 32 + fq * 8);
    const f32x4 a = p[0], b = p[1];
    float s = ((a.x + a.y) + (a.z + a.w)) + ((b.x + b.y) + (b.z + b.w));
    s += __shfl_xor(s, 16); s += __shfl_xor(s, 32);
    return rsqrtf(s * (1.0f / DM) + EPS);
}
__device__ __forceinline__ void stage_rstd(const float* ssq, int pm, LAS float* rsl, int tid) {
    const int r = tid >> 1, hs = tid & 1;
    const f32x4* p = (const f32x4*)(ssq + (size_t)(pm * 256 + r) * 32 + hs * 16);
    const f32x4 a = p[0], b = p[1], c = p[2], d = p[3];
    float s = (((a.x + a.y) + (a.z + a.w)) + ((b.x + b.y) + (b.z + b.w))) + (((c.x + c.y) + (c.z + c.w)) + ((d.x + d.y) + (d.z + d.w)));
    s += __shfl_xor(s, 1);
    if (hs == 0) rsl[r] = rsqrtf(s * (1.0f / DM) + EPS);
    asm volatile("s_waitcnt lgkmcnt(0)" ::: "memory"); __builtin_amdgcn_s_barrier(); asm volatile("" ::: "memory");
}
__device__ __forceinline__ u32x4 pack8bf(const f32x4 a, const f32x4 b) {
    u32x4 w; w.x = cvt_pk_bf16(a[0], a[1]); w.y = cvt_pk_bf16(a[2], a[3]); w.z = cvt_pk_bf16(b[0], b[1]); w.w = cvt_pk_bf16(b[2], b[3]); return w;
}
struct EpiSwiGLU {
    static constexpr bool PERM = true, AFTER_DRAIN = false;
    bf16_t* H; const float* ssq; LAS float* rsl; int cur_pm; int skip;
    __device__ __forceinline__ void operator()(const f32x4 (&acc)[2][2][4][2], const pg8::Unit& u, int wr, int wc, int fr_, int fq_, int tid) {
        int fr = fr_, fq = fq_; asm volatile("" : "+v"(fr), "+v"(fq));
        if (skip) return;
        const int row0 = u.pm * 256 + wr * 64 + fr, col0 = u.pn * 128 + wc * 32 + 8 * fq;
        if (u.pm != cur_pm) { stage_rstd(ssq, u.pm, rsl, tid); cur_pm = u.pm; }
#pragma unroll
        for (int ai = 0; ai < 2; ++ai)
#pragma unroll
            for (int m = 0; m < 4; ++m) {
                const int row = row0 + ai * 128 + m * 16;
                const float rs = rsl[wr * 64 + fr + ai * 128 + m * 16];
                f32x4 h[2];
#pragma unroll
                for (int n = 0; n < 2; ++n) { const f32x4 g = acc[ai][0][m][n] * rs, up = acc[ai][1][m][n] * rs;
#pragma unroll
                    for (int i = 0; i < 4; ++i) h[n][i] = silu_f(g[i]) * up[i]; }
                *(u32x4*)(H + ((size_t)(u.pm * (DFF / 64) + (col0 >> 6)) * 256 + (size_t)(row & 255)) * 64 + (col0 & 63)) = pack8bf(h[0], h[1]);
            }
    }
};
__device__ __forceinline__ unsigned pack4q(unsigned b0, unsigned b1, unsigned b2, unsigned b3) {
    return __builtin_amdgcn_perm(b1, b0, 0x0c0c0400u) | __builtin_amdgcn_perm(b3, b2, 0x04000c0cu);
}
constexpr float QMAGIC = 12582912.0f;
struct EpiSwiGLUq {
    static constexpr bool PERM = true, AFTER_DRAIN = false;
    bf16_t* H; const float* cmax; LAS float* rsl; int skip; int sp, ep;
    __device__ __forceinline__ void stage(LAS unsigned char* lds, const pg8::Unit& u, int lane) {
        __builtin_amdgcn_global_load_lds((const unsigned*)(cmax + u.pn * 256 + 4 * lane), (LAS unsigned*)(lds + CSL_OFF + sp * 1024), 16, 0, 0); sp ^= 1;
    }
    __device__ __forceinline__ void operator()(const i32x4 (&acc)[2][2][4][2], const pg8::Unit& u, int wr, int wc, int fr_, int fq_, int tid) {
        int fr = fr_, fq = fq_; asm volatile("" : "+v"(fr), "+v"(fq));
        const LAS float* cp = (const LAS float*)((const LAS unsigned char*)rsl - RSL_OFF + CSL_OFF + ep * 1024) + wc * 32 + 8 * fq; ep ^= 1;
        if (skip) return;
        const int row0 = u.pm * 256 + wr * 64 + fr, col0 = u.pn * 128 + wc * 32 + 8 * fq;
        f32x4 cs[2][2];
        cs[0][0] = *(const LAS f32x4*)(cp) * (1.0f / 127.0f); cs[0][1] = *(const LAS f32x4*)(cp + 4) * (1.0f / 127.0f);
        cs[1][0] = *(const LAS f32x4*)(cp + 128) * (1.0f / 127.0f); cs[1][1] = *(const LAS f32x4*)(cp + 132) * (1.0f / 127.0f);
#pragma unroll
        for (int ai = 0; ai < 2; ++ai)
#pragma unroll
            for (int m = 0; m < 4; ++m) {
                const int row = row0 + ai * 128 + m * 16;
                const float rs = rsl[wr * 64 + fr + ai * 128 + m * 16];
                f32x4 h[2];
#pragma unroll
                for (int n = 0; n < 2; ++n) {
#pragma unroll
                    for (int i = 0; i < 4; ++i) { const float g = (float)acc[ai][0][m][n][i] * (rs * cs[0][n][i]), up = (float)acc[ai][1][m][n][i] * (rs * cs[1][n][i]); h[n][i] = silu_f(g) * up; } }
                *(u32x4*)(H + ((size_t)(u.pm * (DFF / 64) + (col0 >> 6)) * 256 + (size_t)(row & 255)) * 64 + (col0 & 63)) = pack8bf(h[0], h[1]);
            }
    }
};
__device__ __forceinline__ void quant_rows(const bf16_t* xb, unsigned char* xq, float* qs, const float* ssq, unsigned* cnt, int pm, int quarter, LAS float* rsl, int tid_) {
    int tid = tid_; asm volatile("" : "+v"(tid));
    const int wave = __builtin_amdgcn_readfirstlane(tid >> 6), lane = tid & 63;
#pragma unroll 1
    for (int trip = 0; trip < 2; ++trip) {
        const int rbase = pm * 256 + quarter * 64 + wave * 8 + trip * 4;
        u32x4 v[4][4];
#pragma unroll
        for (int q = 0; q < 4; ++q)
#pragma unroll
            for (int j = 0; j < 4; ++j) v[q][j] = *(const u32x4*)(xb + (size_t)(rbase + q) * DM + (j * 64 + lane) * 8);
#pragma unroll
        for (int q = 0; q < 4; ++q) {
            unsigned mx = 0u;
#pragma unroll
            for (int j = 0; j < 4; ++j)
#pragma unroll
                for (int e = 0; e < 4; ++e) { const unsigned w = v[q][j][e]; mx = max(mx, max(w & 0x7fffu, (w >> 16) & 0x7fffu)); }
#pragma unroll
            for (int o = 1; o < 64; o <<= 1) mx = max(mx, (unsigned)__shfl_xor((int)mx, o));
            const float amax = __uint_as_float(mx << 16);
            const float inv = mx ? 127.0f / amax : 0.f;
#pragma unroll
            for (int j = 0; j < 4; ++j) { float f[8]; unpack8(v[q][j], f); unsigned b[8];
#pragma unroll
                for (int e = 0; e < 8; ++e) b[e] = __float_as_uint(__builtin_fmaf(f[e], inv, QMAGIC));
                u32x2 o; o.x = pack4q(b[0], b[1], b[2], b[3]); o.y = pack4q(b[4], b[5], b[6], b[7]);
                *(u32x2*)(xq + (size_t)(rbase + q) * DM + (j * 64 + lane) * 8) = o; }
            if (lane == 0) qs[rbase + q] = amax * (1.0f / 127.0f);
        }
    }
    __builtin_amdgcn_fence(__ATOMIC_RELEASE, "agent");
    asm volatile("s_waitcnt vmcnt(0)" ::: "memory");
    __syncthreads();
    if (tid == 0) {
        __hip_atomic_fetch_add(cnt, 1u, __ATOMIC_RELEASE, __HIP_MEMORY_SCOPE_AGENT);
        unsigned spins = 0;
        while (__hip_atomic_load(cnt, __ATOMIC_RELAXED, __HIP_MEMORY_SCOPE_AGENT) < 4u) { __builtin_amdgcn_s_sleep(2); if (++spins > (1u << 22)) break; }
        __builtin_amdgcn_fence(__ATOMIC_ACQUIRE, "agent");
        asm volatile("s_waitcnt vmcnt(0)" ::: "memory");
    }
    __syncthreads();
    {
        const int r = tid >> 1, hs = tid & 1;
        const f32x4* p = (const f32x4*)(ssq + (size_t)(pm * 256 + r) * 32 + hs * 16);
        const f32x4 a = p[0], b = p[1], c = p[2], d = p[3];
        const float sc = qs[pm * 256 + r];
        float s = (((a.x + a.y) + (a.z + a.w)) + ((b.x + b.y) + (b.z + b.w))) + (((c.x + c.y) + (c.z + c.w)) + ((d.x + d.y) + (d.z + d.w)));
        s += __shfl_xor(s, 1);
        if (hs == 0) rsl[r] = rsqrtf(s * (1.0f / DM) + EPS) * sc;
        asm volatile("s_waitcnt lgkmcnt(0)" ::: "memory"); __builtin_amdgcn_s_barrier(); asm volatile("" ::: "memory");
    }
}
struct EpiResid {
    static constexpr bool PERM = true, AFTER_DRAIN = false;
    const float* xin32; bf16_t* xb; float* ssq; float alpha; int skip;
    __device__ __forceinline__ void operator()(const f32x4 (&acc)[2][2][4][2], const pg8::Unit& u, int wr, int wc, int fr_, int fq_, int tid) {
        int fr = fr_, fq = fq_; asm volatile("" : "+v"(fr), "+v"(fq));
        if (skip) return;
        const int row0 = u.pm * 256 + wr * 64 + fr, col0 = u.pn * 256 + wc * 32 + 8 * fq;
        const size_t base = (size_t)row0 * DM + col0;
        f32x4 cur[4], nxt[4];
#define ER_LD(dst, g) do { const size_t o_ = base + (size_t)((((g) >> 2) * 128 + ((g) & 3) * 16)) * DM; \
            if (xin32) { const float* p_ = xin32 + o_; dst[0] = *(const f32x4*)(p_); dst[1] = *(const f32x4*)(p_ + 4); dst[2] = *(const f32x4*)(p_ + 128); dst[3] = *(const f32x4*)(p_ + 132); } \
            else { const u32x4 w0 = *(const u32x4*)(xb + o_), w1 = *(const u32x4*)(xb + o_ + 128); float f_[8]; unpack8(w0, f_); dst[0] = (f32x4){f_[0], f_[1], f_[2], f_[3]}; dst[1] = (f32x4){f_[4], f_[5], f_[6], f_[7]}; \
                   unpack8(w1, f_); dst[2] = (f32x4){f_[0], f_[1], f_[2], f_[3]}; dst[3] = (f32x4){f_[4], f_[5], f_[6], f_[7]}; } } while (0)
        ER_LD(cur, 0);
#pragma unroll
        for (int g = 0; g < 8; ++g) {
            const int ai = g >> 2, m = g & 3;
            if (g < 7) ER_LD(nxt, g + 1);
            const size_t off = base + (size_t)(ai * 128 + m * 16) * DM; float s = 0.f;
#pragma unroll
            for (int bj = 0; bj < 2; ++bj) {
                const f32x4 n0 = cur[2 * bj] + acc[ai][bj][m][0] * alpha, n1 = cur[2 * bj + 1] + acc[ai][bj][m][1] * alpha;
                const u32x4 w = pack8bf(n0, n1);
                *(u32x4*)(xb + off + bj * 128) = w;
                float q[8]; unpack8(w, q);
                s += ((q[0] * q[0] + q[1] * q[1]) + (q[2] * q[2] + q[3] * q[3])) + ((q[4] * q[4] + q[5] * q[5]) + (q[6] * q[6] + q[7] * q[7]));
            }
            s += __shfl_xor(s, 16); s += __shfl_xor(s, 32);
            if (fq == 0) ssq[(size_t)(row0 + ai * 128 + m * 16) * 32 + u.pn * 4 + wc] = s;
#pragma unroll
            for (int j = 0; j < 4; ++j) cur[j] = nxt[j];
        }
#undef ER_LD
    }
};
struct EpiWin {
    static constexpr bool PERM = true, AFTER_DRAIN = false;
    const float* ssq; LAS float* rsl; const float* __restrict__ ropec; const float* __restrict__ ropes;
    bf16_t *FQ, *RQ; int cur_pm;
    float* norms4;
    __device__ __forceinline__ void operator()(const f32x4 (&acc)[2][2][4][2], const pg8::Unit& u, int wr, int wc, int fr_, int fq_, int tid) {
        int fr = fr_, fq = fq_; asm volatile("" : "+v"(fr), "+v"(fq));
        const int pn = u.pn, b = u.pm >> 4, s0 = (u.pm & 15) * 256 + wr * 64 + fr, rl0 = wr * 64 + fr;
        if (u.pm != cur_pm) { stage_rstd(ssq, u.pm, rsl, tid); cur_pm = u.pm; }
        if (pn < 12) {
            const int t = pn >> 2; bf16_t* base = FQ + (size_t)t * (SZ_FOX / 2);
            float mx[2][2] = {{0.f, 0.f}, {0.f, 0.f}};
#pragma unroll
            for (int ai = 0; ai < 2; ++ai)
#pragma unroll
                for (int m = 0; m < 4; ++m) {
                    const int s = s0 + ai * 128 + m * 16; const float rs = rsl[rl0 + ai * 128 + m * 16];
#pragma unroll
                    for (int bj = 0; bj < 2; ++bj) { const int head = 2 * (pn & 3) + bj;
                        const u32x4 w = pack8bf(acc[ai][bj][m][0] * rs, acc[ai][bj][m][1] * rs);
                        *(u32x4*)(base + ((size_t)(b * FOXH + head) * SEQ + s) * HD + wc * 32 + 8 * fq) = w;
                        if (t < 2) { float f[8]; unpack8(w, f);
                            float ss = ((f[0] * f[0] + f[1] * f[1]) + (f[2] * f[2] + f[3] * f[3])) + ((f[4] * f[4] + f[5] * f[5]) + (f[6] * f[6] + f[7] * f[7]));
                            ss += __shfl_xor(ss, 16); ss += __shfl_xor(ss, 32); mx[ai][bj] = fmaxf(mx[ai][bj], ss); } }
                }
            if (t < 2) {
#pragma unroll
                for (int ai = 0; ai < 2; ++ai)
#pragma unroll
                    for (int bj = 0; bj < 2; ++bj) { float v = mx[ai][bj];
                        v = fmaxf(v, __shfl_xor(v, 1)); v = fmaxf(v, __shfl_xor(v, 2)); v = fmaxf(v, __shfl_xor(v, 4)); v = fmaxf(v, __shfl_xor(v, 8));
                        if (fr == 0 && fq == 0) norms4[((((1 - t) * 32 + b * FOXH + 2 * (pn & 3) + bj) * 64 + (((u.pm & 15) * 4 + 2 * ai + wr))) << 2) + wc] = v; }
            }
        } else if (pn < 16) {
            const int seg = (pn - 12) >> 1, hh = 2 * ((pn - 12) & 1) + (wc >> 1), dp = 32 * (wc & 1) + 8 * fq;
            bf16_t* base = RQ + (size_t)seg * (SZ_R / 2); const float ksc = seg ? 0.08838834764831845f : 1.0f;
#pragma unroll
            for (int ai = 0; ai < 2; ++ai)
#pragma unroll
                for (int m = 0; m < 4; ++m) {
                    const int s = s0 + ai * 128 + m * 16; const float rs = rsl[rl0 + ai * 128 + m * 16] * ksc;
                    const f32x4 c0 = *(const f32x4*)(ropec + (size_t)s * 64 + dp), c1 = *(const f32x4*)(ropec + (size_t)s * 64 + dp + 4);
                    const f32x4 n0 = *(const f32x4*)(ropes + (size_t)s * 64 + dp), n1 = *(const f32x4*)(ropes + (size_t)s * 64 + dp + 4);
                    const f32x4 a0 = acc[ai][0][m][0] * rs, a1 = acc[ai][0][m][1] * rs, b0 = acc[ai][1][m][0] * rs, b1 = acc[ai][1][m][1] * rs;
                    bf16_t* dst = base + ((size_t)(b * RETH + hh) * SEQ + s) * HD + dp;
                    *(u32x4*)(dst) = pack8bf(a0 * c0 - b0 * n0, a1 * c1 - b1 * n1);
                    *(u32x4*)(dst + 64) = pack8bf(a0 * n0 + b0 * c0, a1 * n1 + b1 * c1);
                    if (m & 1) asm volatile("" ::: "memory");
                }
        } else {
            const int idx = pn - 16, kind = idx >> 1;
            bf16_t* base = RQ + (size_t)(2 + kind) * (SZ_R / 2);
#pragma unroll
            for (int ai = 0; ai < 2; ++ai)
#pragma unroll
                for (int m = 0; m < 4; ++m) {
                    const int s = s0 + ai * 128 + m * 16; const float rs = rsl[rl0 + ai * 128 + m * 16];
#pragma unroll
                    for (int bj = 0; bj < 2; ++bj) { const int head = 2 * (idx & 1) + bj;
                        f32x4 v0 = acc[ai][bj][m][0] * rs, v1 = acc[ai][bj][m][1] * rs;
                        if (kind == 1) {
#pragma unroll
                            for (int i = 0; i < 4; ++i) { v0[i] = silu_f(v0[i]); v1[i] = silu_f(v1[i]); } }
                        if (kind >= 2) {
#pragma unroll
                            for (int i = 0; i < 4; ++i) { v0[i] = gelu_tanh_f(v0[i]); v1[i] = gelu_tanh_f(v1[i]); } }
                        *(u32x4*)(base + ((size_t)(b * RETH + head) * SEQ + s) * HD + wc * 32 + 8 * fq) = pack8bf(v0, v1); }
                }
        }
    }
};

struct Args {
    const float* in[19]; float* out; unsigned char* ws;
    int l_lo, l_hi, ph_lo, ph_hi;
    int use_bar, pad;
};

__device__ __forceinline__ void tr_item(const float* W, int ldw, int src_col0, int k0, const float* gain, bf16_t* WT, int K, int dst_row0, LAS float* scr, int lane) {
    float v[32];
    const float* wp = W + (size_t)(k0 + (lane >> 5)) * ldw + src_col0 + (lane & 31);
#pragma unroll
    for (int i = 0; i < 32; ++i) v[i] = wp[(size_t)(2 * i) * ldw];
    if (gain) {
#pragma unroll
        for (int i = 0; i < 32; ++i) v[i] *= gain[k0 + 2 * i + (lane >> 5)]; }
#pragma unroll
    for (int i = 0; i < 32; ++i) scr[(2 * i + (lane >> 5)) * 33 + (lane & 31)] = v[i];
    LDS_WAIT(); asm volatile("" ::: "memory");
    const int c = lane & 7;
#pragma unroll
    for (int j = 0; j < 4; ++j) { const int n = (lane >> 3) + 8 * j; const LAS float* s = scr + (8 * c) * 33 + n;
        u32x4 o; o.x = pk2(s[0 * 33], s[1 * 33]); o.y = pk2(s[2 * 33], s[3 * 33]); o.z = pk2(s[4 * 33], s[5 * 33]); o.w = pk2(s[6 * 33], s[7 * 33]);
        const int nn = dst_row0 + n;
        *(u32x4*)(WT + ((size_t)(nn >> 8) * (K >> 6) + (k0 >> 6)) * (256 * 64) + (size_t)(nn & 255) * 64 + 8 * c) = o; }
    LDS_WAIT(); asm volatile("" ::: "memory");
}
__device__ __forceinline__ void tr_item_q(const float* W, int ldw, int src_col0, int k0, const float* gain, unsigned char* WT, int K, int dst_row0, const unsigned* cmax, LAS float* scr, int lane) {
    float v[32];
    const float* wp = W + (size_t)(k0 + (lane >> 5)) * ldw + src_col0 + (lane & 31);
#pragma unroll
    for (int i = 0; i < 32; ++i) v[i] = wp[(size_t)(2 * i) * ldw];
    const float cm = __uint_as_float(cmax[dst_row0 + (lane & 31)]);
    const float inv = cm > 0.f ? 127.0f / cm : 0.f;
#pragma unroll
    for (int i = 0; i < 32; ++i) v[i] = __builtin_fmaf(v[i] * gain[k0 + 2 * i + (lane >> 5)], inv, QMAGIC);
#pragma unroll
    for (int i = 0; i < 32; ++i) scr[(2 * i + (lane >> 5)) * 33 + (lane & 31)] = v[i];
    LDS_WAIT(); asm volatile("" ::: "memory");
    const int c = lane & 7;
#pragma unroll
    for (int j = 0; j < 4; ++j) { const int n = (lane >> 3) + 8 * j; const LAS unsigned* sq = (const LAS unsigned*)scr + (8 * c) * 33 + n;
        u32x2 o; o.x = pack4q(sq[0 * 33], sq[1 * 33], sq[2 * 33], sq[3 * 33]); o.y = pack4q(sq[4 * 33], sq[5 * 33], sq[6 * 33], sq[7 * 33]);
        const int nn = dst_row0 + n;
        *(u32x2*)(WT + ((size_t)(nn >> 8) * (K >> 7) + (k0 >> 7)) * (256 * 128) + (size_t)(nn & 255) * 128 + (k0 & 127) + 8 * c) = o; }
    LDS_WAIT(); asm volatile("" ::: "memory");
}
__device__ __forceinline__ void prologue_cmax(const Args& a, unsigned char* ws, int gw, int ngw, int lane) {
    unsigned* cmax = (unsigned*)(ws + WS_CTL) + CW_CMAX;
    for (int it = gw; it < DEPTH * 4 * (DFF / 256) * (DM / 128); it += ngw) {
        const int kc = it & 15, r = it >> 4, cs = r % (DFF / 256), mi = r / (DFF / 256), l = mi >> 2, which = mi & 3, f = which >> 1, isup = which & 1;
        const float* W = a.in[f ? (isup ? 16 : 15) : (isup ? 3 : 2)] + (size_t)l * DM * DFF + (size_t)(128 * kc) * DFF + 256 * cs + 4 * lane;
        const float* gain = a.in[f ? 14 : 1] + (size_t)l * DM + 128 * kc;
        f32x4 mx = (f32x4){0.f, 0.f, 0.f, 0.f};
#pragma unroll 1
        for (int k0 = 0; k0 < 128; k0 += 16) {
            f32x4 v[16];
#pragma unroll
            for (int i = 0; i < 16; ++i) v[i] = *(const f32x4*)(W + (size_t)(k0 + i) * DFF);
#pragma unroll
            for (int i = 0; i < 16; ++i) { const float g = fabsf(gain[k0 + i]);
#pragma unroll
                for (int e = 0; e < 4; ++e) mx[e] = fmaxf(mx[e], fabsf(v[i][e] * g)); }
        }
        const int n = 256 * cs + 4 * lane;
        unsigned* dst = cmax + (size_t)(l * 2 + f) * NGU + 256 * (n >> 7) + (n & 127) + 128 * isup;
#pragma unroll
        for (int e = 0; e < 4; ++e) __hip_atomic_fetch_max(dst + e, __float_as_uint(mx[e]), __ATOMIC_RELAXED, __HIP_MEMORY_SCOPE_AGENT);
    }
}
constexpr int IT_GU = (DM / 64) * (DFF / 32);
constexpr int IT_D = (DFF / 64) * (DM / 32);
constexpr int IT_WIN = (DM / 64) * (NWIN / 32);
constexpr int IT_WOUT = (DM / 64) * (DM / 32);
constexpr int IT_LAYER = 4 * IT_GU + 2 * IT_D + IT_WIN + IT_WOUT;
__device__ __forceinline__ int win_src_col(int db) {
    const int t = db >> 3, bb = db & 7, bj = bb >> 2, j0 = 32 * (bb & 3);
    if (t < 12) return 32 * db;
    if (t < 16) { const int seg = (t - 12) >> 1, ts = (t - 12) & 1, hh = 2 * ts + (j0 >> 6), d = 64 * bj + (j0 & 63); return 3080 + seg * 512 + hh * 128 + d; }
    return 8 + 32 * db;
}
__device__ __forceinline__ void prologue(const Args& a, unsigned char* ws, LAS unsigned char* lds, int gw, int ngw, int wave, int lane) {
    LAS float* scr = (LAS float*)(lds + wave * 16384);
    for (int it = gw; it < DEPTH * IT_LAYER; it += ngw) {
        const int l = it / IT_LAYER; int r = it - l * IT_LAYER;
        if (r < 4 * IT_GU) {
            const int which = r / IT_GU; r -= which * IT_GU; const int f = which >> 1, isup = which & 1;
            const float* W = a.in[f ? (isup ? 16 : 15) : (isup ? 3 : 2)] + (size_t)l * DM * DFF;
            const float* gain = a.in[f ? 14 : 1] + (size_t)l * DM;
            const int kb = r / (DFF / 32), nb = r % (DFF / 32), n0 = 32 * nb;
            unsigned char* WT = ws + WS_WGU + (size_t)(l * 2 + f) * SZ_WGU;
            tr_item_q(W, DFF, n0, 64 * kb, gain, WT, DM, 256 * (n0 >> 7) + (n0 & 127) + 128 * isup, (const unsigned*)(ws + WS_CTL) + CW_CMAX + (size_t)(l * 2 + f) * NGU, scr, lane);
        } else if (r < 4 * IT_GU + 2 * IT_D) {
            r -= 4 * IT_GU; const int f = r / IT_D; r -= f * IT_D;
            const float* W = a.in[f ? 17 : 4] + (size_t)l * DFF * DM;
            const int kb = r / (DM / 32), nb = r % (DM / 32);
            bf16_t* WT = (bf16_t*)(ws + WS_WD + (size_t)(l * 2 + f) * SZ_WD);
            tr_item(W, DM, 32 * nb, 64 * kb, nullptr, WT, DFF, 32 * nb, scr, lane);
        } else if (r < 4 * IT_GU + 2 * IT_D + IT_WIN) {
            r -= 4 * IT_GU + 2 * IT_D;
            const float* W = a.in[6] + (size_t)l * DM * INCOLS; const float* gain = a.in[5] + (size_t)l * DM;
            const int kb = r / (NWIN / 32), db = r % (NWIN / 32);
            bf16_t* WT = (bf16_t*)(ws + WS_WIN + (size_t)l * SZ_WIN);
            tr_item(W, INCOLS, win_src_col(db), 64 * kb, gain, WT, DM, 32 * db, scr, lane);
        } else {
            r -= 4 * IT_GU + 2 * IT_D + IT_WIN;
            const float* W = a.in[13] + (size_t)l * DM * DM; const float* gain = a.in[12] + (size_t)l * DM;
            const int kb = r / (DM / 32), nb = r % (DM / 32);
            bf16_t* WT = (bf16_t*)(ws + WS_WOUT + (size_t)l * SZ_WOUT);
            tr_item(W, DM, 32 * nb, 64 * kb, gain, WT, DM, 32 * nb, scr, lane);
        }
    }
    {
        const float* x = a.in[0]; bf16_t* xb = (bf16_t*)(ws + WS_XB); float* ssq = (float*)(ws + WS_SSQ);
        for (int m = gw; m < MROWS; m += 2 * ngw) {
            const int m2 = m + ngw; const bool has2 = m2 < MROWS;
            const f32x4* xr0 = (const f32x4*)(x + (size_t)m * DM); const f32x4* xr1 = (const f32x4*)(x + (size_t)(has2 ? m2 : m) * DM);
            f32x4 v[2][8];
#pragma unroll
            for (int j = 0; j < 4; ++j) { v[0][2 * j] = xr0[(j * 64 + lane) * 2]; v[0][2 * j + 1] = xr0[(j * 64 + lane) * 2 + 1]; v[1][2 * j] = xr1[(j * 64 + lane) * 2]; v[1][2 * j + 1] = xr1[(j * 64 + lane) * 2 + 1]; }
#pragma unroll
            for (int q = 0; q < 2; ++q) { if (q == 1 && !has2) break; const int mm = q ? m2 : m; float s = 0.f;
#pragma unroll
                for (int j = 0; j < 4; ++j) { const f32x4 v0 = v[q][2 * j], v1 = v[q][2 * j + 1];
                    s += (v0[0] * v0[0] + v0[1] * v0[1]) + (v0[2] * v0[2] + v0[3] * v0[3]) + (v1[0] * v1[0] + v1[1] * v1[1]) + (v1[2] * v1[2] + v1[3] * v1[3]);
                    u32x4 w; w.x = pk2(v0[0], v0[1]); w.y = pk2(v0[2], v0[3]); w.z = pk2(v1[0], v1[1]); w.w = pk2(v1[2], v1[3]);
                    *(u32x4*)(xb + (size_t)mm * DM + (j * 64 + lane) * 8) = w; }
                s = wave_sum(s);
                if (lane < 32) ssq[(size_t)mm * 32 + lane] = lane == 0 ? s : 0.f; }
        }
    }
    {
        float* rc = (float*)(ws + WS_ROPE); float* rs = rc + SEQ * 64;
        const int gt = gw * 64 + lane, ngt = ngw * 64;
        for (int i = gt; i < SEQ * 64; i += ngt) { const int s = i >> 6, j = i & 63;
            const float inv = exp2f(-(float)j * (13.287712379549449f / 64.0f));
            const float ang = (float)s * inv;
            const double rev = (double)ang * 0.15915494309189535; const float fr = (float)(rev - rint(rev));
            rc[i] = __builtin_amdgcn_cosf(fr); rs[i] = __builtin_amdgcn_sinf(fr); }
        for (int i = gt; i < DEPTH * 8 * DM; i += ngt) { const int l = i / (8 * DM), r = i - l * 8 * DM, h = r / DM, k = r - h * DM;
            const float v = a.in[6][((size_t)l * DM + k) * INCOLS + FZ_COL + h] * a.in[5][(size_t)l * DM + k];
            if (NAIVE_MASK & 1) ((float*)(ws + WS_WFZ))[i] = v; else ((bf16_t*)(ws + WS_WFZ))[i] = (bf16_t)f2bf(v); }
    }
}

__device__ __forceinline__ void fz_phase(const bf16_t* xb, const float* ssq, const float* wfz, const float* bf, float* logf, int blk, int nblk, int tid) {
    const int r = tid >> 3, ks = tid & 7, lane = tid & 63;
    for (int rb = blk; rb < MROWS / 64; rb += nblk) {
        const int row = rb * 64 + r;
        float acc[8];
#pragma unroll
        for (int h = 0; h < 8; ++h) acc[h] = 0.f;
        const u32x4* xp = (const u32x4*)(xb + (size_t)row * DM + ks * 256);
        for (int c = 0; c < 32; ++c) {
            float xv[8]; unpack8(xp[c], xv);
#pragma unroll
            for (int h = 0; h < 8; ++h) { const f32x4* wp = (const f32x4*)(wfz + h * DM + ks * 256 + c * 8); const f32x4 w0 = wp[0], w1 = wp[1];
                acc[h] += (xv[0] * w0[0] + xv[1] * w0[1]) + (xv[2] * w0[2] + xv[3] * w0[3]) + (xv[4] * w1[0] + xv[5] * w1[1]) + (xv[6] * w1[2] + xv[7] * w1[3]); }
        }
#pragma unroll
        for (int h = 0; h < 8; ++h) { acc[h] += __shfl_xor(acc[h], 1); acc[h] += __shfl_xor(acc[h], 2); acc[h] += __shfl_xor(acc[h], 4); }
        const f32x4 pp = *(const f32x4*)(ssq + (size_t)row * 32 + ks * 4);
        float s = (pp[0] + pp[1]) + (pp[2] + pp[3]); s += __shfl_xor(s, 1); s += __shfl_xor(s, 2); s += __shfl_xor(s, 4);
        const float rs = rsqrtf(s * (1.0f / DM) + EPS);
        float mine = acc[0];
#pragma unroll
        for (int h = 1; h < 8; ++h) mine = (ks == h) ? acc[h] : mine;
        const int b = row >> 12, sp = row & 4095;
        logf[((size_t)(b * FOXH + ks)) * SEQ + sp] = logsig_f(mine * rs + bf[ks]);
        (void)lane;
    }
}

__device__ __forceinline__ float ret_log2g(int hr) { return log2f(1.0f - exp2f(-(5.0f + (float)hr))); }

__device__ __forceinline__ void cumsum_unit(const float* lf, float* cum, LAS float* sm, int tid) {
    const int lane = tid & 63, w = tid >> 6;
    const f32x4 a = ((const f32x4*)lf)[2 * tid], b = ((const f32x4*)lf)[2 * tid + 1];
    float v0 = a[0], v1 = v0 + a[1], v2 = v1 + a[2], v3 = v2 + a[3], v4 = v3 + b[0], v5 = v4 + b[1], v6 = v5 + b[2], v7 = v6 + b[3];
    const float tot = v7; float sc = tot;
#pragma unroll
    for (int o = 1; o < 64; o <<= 1) { const float n = __shfl_up(sc, o); if (lane >= o) sc += n; }
    if (lane == 63) sm[w] = sc;
    __syncthreads();
    float base = 0.f;
    for (int i = 0; i < w; ++i) base += sm[i];
    const float ex = base + sc - tot;
    ((f32x4*)cum)[2 * tid] = (f32x4){v0 + ex, v1 + ex, v2 + ex, v3 + ex};
    ((f32x4*)cum)[2 * tid + 1] = (f32x4){v4 + ex, v5 + ex, v6 + ex, v7 + ex};
    __syncthreads();
}
__device__ __forceinline__ void retkv_unit(const bf16_t* K, const bf16_t* V, float* kv, float l2g, LAS float* lds, int tid) {
    LAS float* Kz = lds; LAS float* Vs = lds + 64 * 128;
    { const int s = tid >> 3, c0 = (tid & 7) * 16; const float z = exp2f((float)(63 - s) * l2g);
      const u32x4* kp = (const u32x4*)(K + s * 128 + c0); const u32x4* vp = (const u32x4*)(V + s * 128 + c0);
      float f[8];
#pragma unroll
      for (int j = 0; j < 2; ++j) { unpack8(kp[j], f);
#pragma unroll
          for (int i = 0; i < 8; ++i) Kz[s * 128 + c0 + j * 8 + i] = f[i] * z;
          unpack8(vp[j], f);
#pragma unroll
          for (int i = 0; i < 8; ++i) Vs[s * 128 + c0 + j * 8 + i] = f[i]; } }
    __syncthreads();
    const int e = tid & 127, dg = tid >> 7;
    float acc[32];
#pragma unroll
    for (int i = 0; i < 32; ++i) acc[i] = 0.f;
    for (int s = 0; s < 64; ++s) { const float v = Vs[s * 128 + e];
#pragma unroll
        for (int i = 0; i < 32; ++i) acc[i] += Kz[s * 128 + dg * 32 + i] * v; }
#pragma unroll
    for (int i = 0; i < 32; ++i) kv[(size_t)(dg * 32 + i) * 128 + e] = acc[i];
    __syncthreads();
}
__device__ __forceinline__ void gmlp_unit(const bf16_t* U, const bf16_t* V, const float* lng, const float* lnb, const float* wsp, const float* bsp, bf16_t* Y  , LAS float* lds, int tid) {
    LAS float* vln = lds; LAS float* Wt = lds + 128 * 128;
    const int lane = tid & 63, w = tid >> 6;
    for (int i = 0; i < 16; ++i) { const int s = 16 * w + i;
        const unsigned pr = *(const unsigned*)(V + s * 128 + 2 * lane); const float a = bf2f(pr & 0xffffu), b = bf2f(pr >> 16);
        const float mu = wave_sum(a + b) * (1.0f / 128.0f); const float da = a - mu, db = b - mu;
        const float var = wave_sum(da * da + db * db) * (1.0f / 128.0f); const float rs = rsqrtf(var + EPS);
        vln[s * 128 + 2 * lane] = da * rs * lng[2 * lane] + lnb[2 * lane]; vln[s * 128 + 2 * lane + 1] = db * rs * lng[2 * lane + 1] + lnb[2 * lane + 1]; }
    for (int i = tid; i < 128 * 128; i += NTHREADS) { const int t = i >> 7, s = i & 127; Wt[i] = (s <= t) ? wsp[i] : 0.f; }
    __syncthreads();
    const int c = tid & 127, tg = tid >> 7;
    float acc[32];
#pragma unroll
    for (int i = 0; i < 32; ++i) acc[i] = 0.f;
    for (int s4 = 0; s4 < 32; ++s4) {
        const float x0 = vln[(4 * s4) * 128 + c], x1 = vln[(4 * s4 + 1) * 128 + c], x2 = vln[(4 * s4 + 2) * 128 + c], x3 = vln[(4 * s4 + 3) * 128 + c];
#pragma unroll
        for (int i = 0; i < 32; ++i) { const f32x4 wv = *(const LAS f32x4*)(Wt + (tg * 32 + i) * 128 + 4 * s4); acc[i] += (wv[0] * x0 + wv[1] * x1) + (wv[2] * x2 + wv[3] * x3); }
    }
    __syncthreads();
#pragma unroll
    for (int i = 0; i < 32; ++i) { const int t = tg * 32 + i; const float uu = bf2f(U[t * 128 + c]); vln[t * 128 + c] = uu * (acc[i] + bsp[t]); }
    __syncthreads();
    for (int i = 0; i < 16; ++i) { const int t = 16 * w + i; const float a = vln[t * 128 + 2 * lane], b = vln[t * 128 + 2 * lane + 1];
        const float rs = rsqrtf(wave_sum(a * a + b * b) * (1.0f / 128.0f) + EPS);
        *(unsigned*)(Y + (size_t)t * DM + 2 * lane) = pk2(a * rs, b * rs); }
    __syncthreads();
}
__device__ __forceinline__ void retout_unit(const bf16_t* Q, const bf16_t* K, const bf16_t* V, const bf16_t* G, const float* sp, bf16_t* Y, float l2g, LAS float* lds, int tid) {
    LAS float* Qs = lds; LAS float* Ks = lds + 64 * 129; LAS float* Vs = lds + 2 * 64 * 129; LAS float* Sc = Vs + 64 * 128;
    const int lane = tid & 63, w = tid >> 6;
    { const int s = tid >> 3, c0 = (tid & 7) * 16; float f[8];
      const u32x4* qp = (const u32x4*)(Q + s * 128 + c0); const u32x4* kp = (const u32x4*)(K + s * 128 + c0); const u32x4* vp = (const u32x4*)(V + s * 128 + c0);
#pragma unroll
      for (int j = 0; j < 2; ++j) {
          unpack8(qp[j], f);
#pragma unroll
          for (int i = 0; i < 8; ++i) Qs[s * 129 + c0 + j * 8 + i] = f[i];
          unpack8(kp[j], f);
#pragma unroll
          for (int i = 0; i < 8; ++i) Ks[s * 129 + c0 + j * 8 + i] = f[i];
          unpack8(vp[j], f);
#pragma unroll
          for (int i = 0; i < 8; ++i) Vs[s * 128 + c0 + j * 8 + i] = f[i]; } }
    __syncthreads();
    {
        float acc[8];
#pragma unroll
        for (int j = 0; j < 8; ++j) acc[j] = 0.f;
        for (int d = 0; d < 128; ++d) { const float kk = Ks[lane * 129 + d];
#pragma unroll
            for (int j = 0; j < 8; ++j) acc[j] += Qs[(8 * w + j) * 129 + d] * kk; }
#pragma unroll
        for (int j = 0; j < 8; ++j) { const int t = 8 * w + j; Sc[t * 64 + lane] = (lane <= t) ? acc[j] * exp2f((float)(t - lane) * l2g) : 0.f; }
    }
    __syncthreads();
    const int e = tid & 127, tg = tid >> 7;
    float o[16];
#pragma unroll
    for (int j = 0; j < 16; ++j) o[j] = 0.f;
    for (int d = 0; d < 128; ++d) { const float sv = sp[(size_t)d * 128 + e];
#pragma unroll
        for (int j = 0; j < 16; ++j) o[j] += Qs[(tg * 16 + j) * 129 + d] * sv; }
#pragma unroll
    for (int j = 0; j < 16; ++j) o[j] *= exp2f((float)(tg * 16 + j + 1) * l2g);
    for (int s = 0; s < 64; ++s) { const float v = Vs[s * 128 + e];
#pragma unroll
        for (int j = 0; j < 16; ++j) o[j] += Sc[(tg * 16 + j) * 64 + s] * v; }
    __syncthreads();
#pragma unroll
    for (int j = 0; j < 16; ++j) Ks[(tg * 16 + j) * 128 + e] = o[j];
    __syncthreads();
    for (int i = 0; i < 8; ++i) { const int t = 8 * w + i; const float a = Ks[t * 128 + 2 * lane], b = Ks[t * 128 + 2 * lane + 1];
        const float rs = rsqrtf(wave_sum(a * a + b * b) * (1.0f / 128.0f) + EPS);
        const unsigned gp = *(const unsigned*)(G + t * 128 + 2 * lane);
        *(unsigned*)(Y + (size_t)t * DM + 2 * lane) = pk2(a * rs * bf2f(gp & 0xffffu), b * rs * bf2f(gp >> 16)); }
    __syncthreads();
}
__device__ __forceinline__ void attn_naive(const bf16_t* FQ, const bf16_t* FK, const bf16_t* FV, const float* cum, bf16_t* Y, int gw, int ngw, int lane) {
    const int sub = lane & 3, rl = lane >> 2;
    for (int it = gw; it < 4 * 2048; it += ngw) {
        const int vw = it & 2047, i = it >> 11;
        const int bh = (vw >> 7) + ((i >> 1) << 4), gg = vw & 127, g = (i & 1) ? 255 - gg : gg, t = g * 16 + rl;
        float q[32], o[32];
        { const u32x4* qp = (const u32x4*)(FQ + ((size_t)bh * SEQ + t) * HD + sub * 32);
#pragma unroll
          for (int j = 0; j < 4; ++j) { float f[8]; unpack8(qp[j], f);
#pragma unroll
              for (int k = 0; k < 8; ++k) q[j * 8 + k] = f[k] * 0.08838834764831845f; } }
#pragma unroll
        for (int j = 0; j < 32; ++j) o[j] = 0.f;
        float m = -1e30f, l = 0.f; const float ct = cum[(size_t)bh * SEQ + t];
        const int smax = g * 16 + 15;
        for (int s = 0; s <= smax; ++s) {
            const u32x4* kp = (const u32x4*)(FK + ((size_t)bh * SEQ + s) * HD + sub * 32);
            float d = 0.f;
#pragma unroll
            for (int j = 0; j < 4; ++j) { float f[8]; unpack8(kp[j], f);
#pragma unroll
                for (int k = 0; k < 8; ++k) d += q[j * 8 + k] * f[k]; }
            d += __shfl_xor(d, 1); d += __shfl_xor(d, 2);
            const float logit = d + ct - cum[(size_t)bh * SEQ + s];
            const bool valid = s <= t;
            const float mn = valid ? fmaxf(m, logit) : m;
            const float corr = __expf(m - mn), p = valid ? __expf(logit - mn) : 0.f;
            l = l * corr + p; m = mn;
            const u32x4* vp = (const u32x4*)(FV + ((size_t)bh * SEQ + s) * HD + sub * 32);
#pragma unroll
            for (int j = 0; j < 4; ++j) { float f[8]; unpack8(vp[j], f);
#pragma unroll
                for (int k = 0; k < 8; ++k) o[j * 8 + k] = o[j * 8 + k] * corr + p * f[k]; }
        }
        const float inv = 1.0f / l; float ss = 0.f;
#pragma unroll
        for (int j = 0; j < 32; ++j) { o[j] *= inv; ss += o[j] * o[j]; }
        ss += __shfl_xor(ss, 1); ss += __shfl_xor(ss, 2);
        const float rs = rsqrtf(ss * (1.0f / 128.0f) + EPS);
        const int b = bh >> 3, h = bh & 7;
        bf16_t* yp = Y + ((size_t)(b * SEQ + t)) * DM + h * HD + sub * 32;
#pragma unroll
        for (int j = 0; j < 4; ++j) { u32x4 wv; wv.x = pk2(o[j * 8] * rs, o[j * 8 + 1] * rs); wv.y = pk2(o[j * 8 + 2] * rs, o[j * 8 + 3] * rs); wv.z = pk2(o[j * 8 + 4] * rs, o[j * 8 + 5] * rs); wv.w = pk2(o[j * 8 + 6] * rs, o[j * 8 + 7] * rs);
            *(u32x4*)(yp + j * 8) = wv; }
    }
}


namespace fa {
constexpr int NW = 8, QBLK = 32, KVBLK = 64, QB = 256, D = 128;
constexpr int SHM_V = 16384, SHM_K = 16384;
constexpr int OFF_WS = 2 * SHM_V + 2 * SHM_K;
constexpr int OFF_CS = OFF_WS + NW * 64 * 4;
constexpr int OFF_SH = OFF_CS + SEQ * 4;
constexpr int LDS_NEED = OFF_SH + 64;
constexpr float C2 = 1.4426950408889634f * 0.08838834764831845f;
constexpr float THR2 = 8.f * 1.4426950408889634f;
typedef float f32x16 __attribute__((ext_vector_type(16)));
typedef short s16x4 __attribute__((ext_vector_type(4)));
typedef LAS char* lptr;
#define KSWZ(row, colB) ((row) * 256 + ((colB) ^ (((row) & 7) << 4)))
#define SBAR() __builtin_amdgcn_sched_barrier(0)
__device__ __forceinline__ int v_st(int k, int c) { const int kk = (k & ~0xC) | ((k & 4) << 1) | ((k & 8) >> 1); return ((kk >> 3) * 4 + (c >> 5)) * 512 + ((kk & 7) * 32 + (c & 31)) * 2; }
__device__ __forceinline__ int v_rd_base(int lane) { return ((lane & 3) << 3) | (((lane >> 2) & 3) << 6) | (((lane >> 4) & 1) << 5) | (((lane >> 5) & 1) << 8); }
constexpr int v_rd_off(int d0, int ks, int half) { return d0 * 512 + ks * 4096 + half * 2048; }
__device__ __forceinline__ int crow(int r, int hi) { return (r & 3) + 8 * (r >> 2) + 4 * hi; }
__device__ __forceinline__ bf16x8 load8(const bf16_t* p) { return *reinterpret_cast<const bf16x8*>(p); }
__device__ __forceinline__ void bias_tile(f32x16& p0, f32x16& p1, const LAS float* cs) {
#pragma unroll
    for (int i = 0; i < 4; ++i) { const f32x4 a = *(const LAS f32x4*)(cs + 8 * i), b = *(const LAS f32x4*)(cs + 32 + 8 * i);
#pragma unroll
        for (int j = 0; j < 4; ++j) { p0[4 * i + j] = fmaf(p0[4 * i + j], C2, a[j]); p1[4 * i + j] = fmaf(p1[4 * i + j], C2, b[j]); } }
}
__device__ __forceinline__ void mask_tile(f32x16& p0, f32x16& p1, int dq) {
    const float NEG = -__builtin_inff();
#pragma unroll
    for (int r = 0; r < 16; ++r) { const int c = (r & 3) + 8 * (r >> 2);
        if (dq - c < 0) p0[r] = NEG;
        if (dq - c - 32 < 0) p1[r] = NEG; }
}
__device__ __forceinline__ void partialSM(f32x16& p0, f32x16& p1, float& m_reg, float& alpha) {
    float pmax = p0[0];
#pragma unroll
    for (int r = 1; r < 16; ++r) pmax = fmaxf(pmax, p0[r]);
#pragma unroll
    for (int r = 0; r < 16; ++r) pmax = fmaxf(pmax, p1[r]);
    { auto rr = __builtin_amdgcn_permlane32_swap(__float_as_uint(pmax), __float_as_uint(pmax), false, false);
      pmax = fmaxf(__uint_as_float(rr[0]), __uint_as_float(rr[1])); }
    float mn;
    if (__builtin_expect(__all(pmax - m_reg <= THR2), 1)) { mn = m_reg; alpha = 1.f; }
    else { mn = fmaxf(m_reg, pmax); alpha = __builtin_amdgcn_exp2f(m_reg - mn); m_reg = mn; }
#pragma unroll
    for (int r = 0; r < 16; ++r) p0[r] = p0[r] - mn;
#pragma unroll
    for (int r = 0; r < 16; ++r) p1[r] = p1[r] - mn;
#pragma unroll
    for (int r = 0; r < 16; ++r) p0[r] = __builtin_amdgcn_exp2f(p0[r]);
}
__device__ __forceinline__ void finishSM(f32x16& p0, f32x16& p1, float alpha, float& l_reg, bf16x8& pa0, bf16x8& pa1, bf16x8& pa2, bf16x8& pa3) {
#pragma unroll
    for (int r = 0; r < 16; ++r) p1[r] = __builtin_amdgcn_exp2f(p1[r]);
    float ps = 0;
#pragma unroll
    for (int r = 0; r < 16; ++r) ps += p0[r];
#pragma unroll
    for (int r = 0; r < 16; ++r) ps += p1[r];
    { auto rr = __builtin_amdgcn_permlane32_swap(__float_as_uint(ps), __float_as_uint(ps), false, false);
      ps = __uint_as_float(rr[0]) + __uint_as_float(rr[1]); }
    l_reg = l_reg * alpha + ps;
#define PK4(P, B_, OUT) do { unsigned a0 = cvt_pk_bf16(P[B_+0], P[B_+1]), a1 = cvt_pk_bf16(P[B_+2], P[B_+3]);                          \
        unsigned b0 = cvt_pk_bf16(P[B_+4], P[B_+5]), b1 = cvt_pk_bf16(P[B_+6], P[B_+7]);                                             \
        auto r0 = __builtin_amdgcn_permlane32_swap(a0, b0, false, false); auto r1 = __builtin_amdgcn_permlane32_swap(a1, b1, false, false); \
        u32x4 w = {r0[0], r1[0], r0[1], r1[1]}; OUT = *reinterpret_cast<bf16x8*>(&w); } while (0)
    PK4(p0, 0, pa0); PK4(p0, 8, pa1); PK4(p1, 0, pa2); PK4(p1, 8, pa3);
#undef PK4
}
template <int KB>
__device__ __forceinline__ void qkt(f32x16& p0, f32x16& p1, lptr K_lds, int r32, int hi, const bf16x8* qr) {
    p0 = f32x16{}; p1 = f32x16{};
    lptr kb[4];
#pragma unroll
    for (int dd = 0; dd < 4; ++dd) kb[dd] = K_lds + KB * SHM_K + KSWZ(r32, (dd * 16 + hi * 8) * 2);
#pragma unroll
    for (int d0 = 0; d0 < 8; ++d0) { lptr a = kb[d0 & 3] + (d0 >> 2) * 128;
        bf16x8 b0 = *reinterpret_cast<const LAS bf16x8*>(a);
        bf16x8 b1 = *reinterpret_cast<const LAS bf16x8*>(a + 32 * 256);
        p0 = __builtin_amdgcn_mfma_f32_32x32x16_bf16(b0, qr[d0], p0, 0, 0, 0);
        p1 = __builtin_amdgcn_mfma_f32_32x32x16_bf16(b1, qr[d0], p1, 0, 0, 0); }
}
template <int VB>
__device__ __forceinline__ void pv_tile(f32x16* o, int vb0, bf16x8 pa0, bf16x8 pa1, bf16x8 pa2, bf16x8 pa3) {
#define TRRD(dst, off) asm volatile("ds_read_b64_tr_b16 %0, %1 offset:%2" : "=&v"(dst) : "v"(vb0), "i"(off) : "memory")
#define PV_D0(d0) do { s16x4 l0, l1, l2, l3, h0, h1, h2, h3; constexpr int b_ = VB * SHM_V + v_rd_off(d0, 0, 0); \
        TRRD(l0, b_); TRRD(h0, b_ + 2048); TRRD(l1, b_ + 4096); TRRD(h1, b_ + 6144); TRRD(l2, b_ + 8192); TRRD(h2, b_ + 10240); TRRD(l3, b_ + 12288); TRRD(h3, b_ + 14336); \
        asm volatile("s_waitcnt lgkmcnt(0)" ::: "memory"); SBAR(); \
        o[d0] = __builtin_amdgcn_mfma_f32_32x32x16_bf16(pa0, (bf16x8){l0[0], l0[1], l0[2], l0[3], h0[0], h0[1], h0[2], h0[3]}, o[d0], 0, 0, 0);   \
        o[d0] = __builtin_amdgcn_mfma_f32_32x32x16_bf16(pa1, (bf16x8){l1[0], l1[1], l1[2], l1[3], h1[0], h1[1], h1[2], h1[3]}, o[d0], 0, 0, 0);   \
        o[d0] = __builtin_amdgcn_mfma_f32_32x32x16_bf16(pa2, (bf16x8){l2[0], l2[1], l2[2], l2[3], h2[0], h2[1], h2[2], h2[3]}, o[d0], 0, 0, 0);   \
        o[d0] = __builtin_amdgcn_mfma_f32_32x32x16_bf16(pa3, (bf16x8){l3[0], l3[1], l3[2], l3[3], h3[0], h3[1], h3[2], h3[3]}, o[d0], 0, 0, 0); } while (0)
    PV_D0(0); PV_D0(1); PV_D0(2); PV_D0(3);
#undef PV_D0
#undef TRRD
}
struct BlockRef { const bf16_t* Q; const bf16_t* K; const bf16_t* V; bf16_t* O; int P0; };
#define ROW(p, k0, rr) ((p) + (size_t)((k0) + (rr)) * D + sc)
#define VMW() asm volatile("s_waitcnt vmcnt(0)" ::: "memory")
#define SLOAD_H(Kp, Vp, k0) do { st_v0 = load8(ROW(Vp, k0, sr)); st_v1 = load8(ROW(Vp, k0, 32 + sr)); st_k0 = load8(ROW(Kp, k0, sr)); st_k1 = load8(ROW(Kp, k0, 32 + sr)); } while (0)
#define SWRITE_H(bf) do { *(LAS bf16x8*)(V_lds + (bf) * SHM_V + vst0) = st_v0; *(LAS bf16x8*)(V_lds + (bf) * SHM_V + vst1) = st_v1; \
                          *(LAS bf16x8*)(K_lds + (bf) * SHM_K + kws) = st_k0; *(LAS bf16x8*)(K_lds + (bf) * SHM_K + kws + 32 * 256) = st_k1; } while (0)
#define SWRITE_HK(bf) do { *(LAS bf16x8*)(K_lds + (bf) * SHM_K + kws) = st_k0; *(LAS bf16x8*)(K_lds + (bf) * SHM_K + kws + 32 * 256) = st_k1; } while (0)
#define SWRITE_HV(bf) do { *(LAS bf16x8*)(V_lds + (bf) * SHM_V + vst0) = st_v0; *(LAS bf16x8*)(V_lds + (bf) * SHM_V + vst1) = st_v1; } while (0)
struct SplitRef { unsigned* arrive; unsigned* ready; float* part; };
__device__ __forceinline__ void block(const BlockRef& cur, const int j0, const int NT, const int split, const SplitRef sp, lptr lds, int tid) {
    const int wid = __builtin_amdgcn_readfirstlane(tid >> 6), lane = tid & 63, r32 = lane & 31, hi = lane >> 5;
    const int qlo = cur.P0 + wid * QBLK, qm = qlo + r32 - 4 * hi;
    lptr V_lds = lds; lptr K_lds = lds + 2 * SHM_V;
    LAS float* wsc = (LAS float*)(lds + OFF_WS) + wid * 64; LAS float* li_l = wsc; LAS float* al_l = wsc + 32;
    const LAS float* Cs = (const LAS float*)(lds + OFF_CS) + 4 * hi;
    float m_reg = -1e30f, l_reg = 0; f32x16 o[4] = {};
    const int sr = tid >> 4, sc = (tid & 15) * 8, vst0 = v_st(sr, sc), vst1 = v_st(32 + sr, sc), kws = KSWZ(sr, sc * 2);
    const int vb0 = (int)(unsigned)(uintptr_t)V_lds + v_rd_base(lane);
    const bf16_t* Kh = cur.K; const bf16_t* Vh = cur.V;
    bf16x8 qr[8], st_v0, st_v1, st_k0, st_k1;
#pragma unroll
    for (int d0 = 0; d0 < 8; ++d0) qr[d0] = load8(cur.Q + (size_t)(wid * QBLK + r32) * D + d0 * 16 + hi * 8);
    SLOAD_H(Kh, Vh, j0 * KVBLK); VMW(); SWRITE_H(0);
    SLOAD_H(Kh, Vh, (j0 + 1) * KVBLK);
    __syncthreads();
#define RESC(a) do { if (__any((a) < 1.f)) { if (hi == 0) al_l[r32] = (a); asm volatile("s_waitcnt lgkmcnt(0)" ::: "memory");              \
                     _Pragma("unroll") for (int d_ = 0; d_ < 4; ++d_) _Pragma("unroll") for (int r = 0; r < 16; ++r) o[d_][r] *= al_l[crow(r, hi)]; } } while (0)
#define KBASE(t) ((j0 + (t)) * KVBLK)
#define MASKT(P0_, P1_, t) do { const int kb_ = KBASE(t); bias_tile(P0_, P1_, Cs + kb_); if (kb_ + KVBLK - 1 > qlo) mask_tile(P0_, P1_, qm - kb_); } while (0)
    f32x16 pA0, pA1, pB0, pB1; float alA, alB; bf16x8 pa0, pa1, pa2, pa3;
    SBAR(); qkt<0>(pA0, pA1, K_lds, r32, hi, qr);
    MASKT(pA0, pA1, 0); partialSM(pA0, pA1, m_reg, alA);
    VMW(); SWRITE_H(1);
    __syncthreads();
#define HALF_STEP(PX0, PX1, alX, PY0, PY1, alY, t, KB, VB, SB) do {                                                      \
        SBAR(); qkt<KB>(PX0, PX1, K_lds, r32, hi, qr);                                             \
        finishSM(PY0, PY1, alY, l_reg, pa0, pa1, pa2, pa3); SBAR();                                                           \
        if ((t) + 1 < NT) { SLOAD_H(Kh, Vh, KBASE((t) + 1)); SBAR(); }                                               \
        pv_tile<VB>(o, vb0, pa0, pa1, pa2, pa3); MASKT(PX0, PX1, (t)); partialSM(PX0, PX1, m_reg, alX);                                        \
        __syncthreads();                                                                                                      \
        if ((t) + 1 < NT) { VMW(); SWRITE_H(SB); }                                                                          \
        RESC(alX); __syncthreads(); } while (0)
    for (int t = 1; t + 1 < NT; t += 2) {
        HALF_STEP(pB0, pB1, alB, pA0, pA1, alA, t, 1, 0, 0);
        HALF_STEP(pA0, pA1, alA, pB0, pB1, alB, t + 1, 0, 1, 1);
    }
    SBAR(); qkt<1>(pB0, pB1, K_lds, r32, hi, qr); SBAR();
    finishSM(pA0, pA1, alA, l_reg, pa0, pa1, pa2, pa3); SBAR();
    pv_tile<0>(o, vb0, pa0, pa1, pa2, pa3);
    MASKT(pB0, pB1, NT - 1); partialSM(pB0, pB1, m_reg, alB); RESC(alB);
    finishSM(pB0, pB1, alB, l_reg, pa0, pa1, pa2, pa3); SBAR(); pv_tile<1>(o, vb0, pa0, pa1, pa2, pa3);
    if (split) {
        LAS int* sh = (LAS int*)(lds + OFF_SH);
        __syncthreads();
        if (tid == 0) sh[2] = (int)__hip_atomic_fetch_add(sp.arrive, 1u, __ATOMIC_RELAXED, __HIP_MEMORY_SCOPE_AGENT);
        __syncthreads();
        const bool first = sh[2] == 0;
        float* pp = sp.part + (size_t)wid * 66 * 64 + lane;
        if (first) {
#pragma unroll
            for (int d_ = 0; d_ < 4; ++d_)
#pragma unroll
                for (int r = 0; r < 16; ++r) __hip_atomic_store(pp + (d_ * 16 + r) * 64, o[d_][r], __ATOMIC_RELAXED, __HIP_MEMORY_SCOPE_AGENT);
            __hip_atomic_store(pp + 64 * 64, m_reg, __ATOMIC_RELAXED, __HIP_MEMORY_SCOPE_AGENT); __hip_atomic_store(pp + 65 * 64, l_reg, __ATOMIC_RELAXED, __HIP_MEMORY_SCOPE_AGENT);
            asm volatile("s_waitcnt vmcnt(0)" ::: "memory");
            __syncthreads();
            if (tid == 0) __hip_atomic_store(sp.ready, 1u, __ATOMIC_RELAXED, __HIP_MEMORY_SCOPE_AGENT);
            return;
        }
        if (wid == 0) {
            unsigned spins = 0;
            while ((unsigned)__builtin_amdgcn_readfirstlane(__hip_atomic_load(sp.ready, __ATOMIC_RELAXED, __HIP_MEMORY_SCOPE_AGENT)) == 0u) { __builtin_amdgcn_s_sleep(2); if (++spins > (1u << 22)) break; }
            __builtin_amdgcn_fence(__ATOMIC_ACQUIRE, "agent");
            asm volatile("s_waitcnt vmcnt(0)" ::: "memory");
        }
        __syncthreads();
        const float om = __hip_atomic_load(pp + 64 * 64, __ATOMIC_RELAXED, __HIP_MEMORY_SCOPE_AGENT), ol = __hip_atomic_load(pp + 65 * 64, __ATOMIC_RELAXED, __HIP_MEMORY_SCOPE_AGENT);
        const float mm = fmaxf(m_reg, om), as = __builtin_amdgcn_exp2f(m_reg - mm), ao = __builtin_amdgcn_exp2f(om - mm);
        { const float t1 = (split == 1) ? ol * ao : l_reg * as; l_reg = (split == 1) ? __builtin_fmaf(l_reg, as, t1) : __builtin_fmaf(ol, ao, t1); } m_reg = mm;
        if (hi == 0) { al_l[r32] = as; li_l[r32] = ao; }
        asm volatile("s_waitcnt lgkmcnt(0)" ::: "memory");
#pragma unroll
        for (int d_ = 0; d_ < 4; ++d_)
#pragma unroll
            for (int r = 0; r < 16; ++r) { const float po = __hip_atomic_load(pp + (d_ * 16 + r) * 64, __ATOMIC_RELAXED, __HIP_MEMORY_SCOPE_AGENT); const float ws_ = al_l[crow(r, hi)], wo_ = li_l[crow(r, hi)];
                const float t1 = (split == 1) ? po * wo_ : o[d_][r] * ws_; o[d_][r] = (split == 1) ? __builtin_fmaf(o[d_][r], ws_, t1) : __builtin_fmaf(po, wo_, t1); }
        asm volatile("s_waitcnt lgkmcnt(0)" ::: "memory");
    }
    if (hi == 0) li_l[r32] = l_reg; asm volatile("s_waitcnt lgkmcnt(0)" ::: "memory");
    bf16_t* Ow = cur.O + (size_t)(wid * QBLK) * DM;
#pragma unroll
    for (int r = 0; r < 16; ++r) { const int orow = crow(r, hi); const float rli = __builtin_amdgcn_rcpf(li_l[orow]);
        float v0 = o[0][r] * rli, v1 = o[1][r] * rli, v2 = o[2][r] * rli, v3 = o[3][r] * rli;
        float ss = (v0 * v0 + v1 * v1) + (v2 * v2 + v3 * v3);
        ss += __shfl_xor(ss, 1); ss += __shfl_xor(ss, 2); ss += __shfl_xor(ss, 4); ss += __shfl_xor(ss, 8); ss += __shfl_xor(ss, 16);
        const float rs = rsqrtf(ss * (1.0f / 128.0f) + EPS);
        v0 *= rs; v1 *= rs; v2 *= rs; v3 *= rs;
        const float n0 = __shfl_xor(v0, 1), n1 = __shfl_xor(v1, 1), n2 = __shfl_xor(v2, 1), n3 = __shfl_xor(v3, 1);
        if ((r32 & 1) == 0) { bf16_t* op = Ow + (size_t)orow * DM + r32;
            *(unsigned*)(op) = cvt_pk_bf16(v0, n0); *(unsigned*)(op + 32) = cvt_pk_bf16(v1, n1); *(unsigned*)(op + 64) = cvt_pk_bf16(v2, n2); *(unsigned*)(op + 96) = cvt_pk_bf16(v3, n3); } }
    __syncthreads();
#undef RESC
#undef KBASE
#undef MASKT
#undef HALF_STEP
}
#undef SWRITE_HK
#undef SWRITE_HV
#undef ROW
#undef VMW
#undef SLOAD_H
#undef SWRITE_H
__device__ __forceinline__ void norm_phase(const bf16_t* FQ, const bf16_t* FK, float* norms, int gw, int ngw, int lane) {
    for (int tt = gw; tt < NB * FOXH * (SEQ / 64); tt += ngw) {
        const size_t ro = ((size_t)tt * 64 + lane) * D;
        float k2 = 0.f, q2 = 0.f;
        bf16x8 kv[16], qv[16];
#pragma unroll
        for (int j = 0; j < 16; ++j) { kv[j] = load8(FK + ro + 8 * j); qv[j] = load8(FQ + ro + 8 * j); }
#pragma unroll
        for (int j = 0; j < 16; ++j) { float f[8];
            unpack8(*reinterpret_cast<const u32x4*>(&kv[j]), f); k2 += ((f[0] * f[0] + f[1] * f[1]) + (f[2] * f[2] + f[3] * f[3])) + ((f[4] * f[4] + f[5] * f[5]) + (f[6] * f[6] + f[7] * f[7]));
            unpack8(*reinterpret_cast<const u32x4*>(&qv[j]), f); q2 += ((f[0] * f[0] + f[1] * f[1]) + (f[2] * f[2] + f[3] * f[3])) + ((f[4] * f[4] + f[5] * f[5]) + (f[6] * f[6] + f[7] * f[7])); }
#pragma unroll
        for (int o = 1; o < 64; o <<= 1) { k2 = fmaxf(k2, __shfl_xor(k2, o)); q2 = fmaxf(q2, __shfl_xor(q2, o)); }
        if (lane == 0) { norms[2 * tt] = k2; norms[2 * tt + 1] = q2; }
    }
}
__device__ __forceinline__ void item_decode(int item, int& qb, int& bh, int& nh, int& half) {
    constexpr int GQ[16] = {13, 12, 11, 10, 9, 8, 15, 7, 14, 6, 5, 4, 3, 2, 1, 0};
    int base = 0; qb = 0; nh = 1; half = 0; bh = 0;
#pragma unroll
    for (int g = 0; g < 16; ++g) { const int q = GQ[g], n = q >= 14 ? 2 : 1, cnt = 32 * n; if (item >= base && item < base + cnt) { const int r = item - base; qb = q; nh = n; bh = r % 32; half = n == 2 ? 1 - r / 32 : 0; } base += cnt; }
}
constexpr int N_ITEMS = 2 * 32 * 2 + 14 * 32;
__device__ __forceinline__ void attn_phase(const bf16_t* FQ, const bf16_t* FK, const bf16_t* FV, const float* cum, const float* norms, bf16_t* Y, unsigned* qctr, unsigned* flags, float* parts, lptr lds, int tid_) {
    LAS int* sh = (LAS int*)(lds + OFF_SH);
    for (;;) {
        int tid = tid_; asm volatile("" : "+v"(tid));
        const int wid = __builtin_amdgcn_readfirstlane(tid >> 6), lane = tid & 63;
        __syncthreads();
        if (tid == 0) sh[0] = (int)__hip_atomic_fetch_add(qctr, 1u, __ATOMIC_RELAXED, __HIP_MEMORY_SCOPE_AGENT);
        __syncthreads();
        const int item = sh[0];
        if (item >= N_ITEMS) break;
        int qb, bh, nh, half; item_decode(item, qb, bh, nh, half);
        const int b = bh >> 3, h = bh & 7, NTall = qb * 4 + 4;
        f32x4 kq_ = {}, qq_ = {};
        if (wid == 0) { kq_ = *(const f32x4*)(norms + (size_t)((bh * 64 + lane) << 2)); qq_ = *(const f32x4*)(norms + (size_t)(((32 + bh) * 64 + lane) << 2)); }
        { LAS float* Cs = (LAS float*)(lds + OFF_CS); const f32x4* cp = (const f32x4*)(cum + (size_t)bh * SEQ);
#pragma unroll
          for (int j = 0; j < 2; ++j) { const int i4 = tid + j * NTHREADS; if (i4 < NTall * 16) { const f32x4 v = cp[i4]; *(LAS f32x4*)(Cs + 4 * i4) = v * (-1.4426950408889634f); } } }
        __syncthreads();
        if (wid == 0) {
            const LAS float* Cs = (const LAS float*)(lds + OFF_CS);
            const bool valid = lane < NTall, diag = valid && lane >= NTall - 4;
            const float k2 = (kq_[0] + kq_[1]) + (kq_[2] + kq_[3]), q2 = (qq_[0] + qq_[1]) + (qq_[2] + qq_[3]);
            float kd2 = diag ? k2 : 0.f, qm2 = diag ? q2 : 0.f;
#pragma unroll
            for (int o = 1; o < 64; o <<= 1) { kd2 = fmaxf(kd2, __shfl_xor(kd2, o)); qm2 = fmaxf(qm2, __shfl_xor(qm2, o)); }
            const float bound = 1.01f * C2 * sqrtf(qm2) * (sqrtf(k2) + sqrtf(kd2)) + (valid ? Cs[64 * lane + 63] : 0.f) - Cs[qb * QB];
            const unsigned long long keep = __ballot(valid && !(bound < -44.0f));
            if (lane == 0) sh[1] = keep ? (int)__builtin_ctzll(keep) : 0;
        }
        __syncthreads();
        const int j0 = sh[1] & ~1, NTe = NTall - j0;
        int jb = j0, nt = NTe;
        if (nh == 2) { const int nA = (NTe >> 1) & ~1; if (half == 0) nt = nA; else { jb = j0 + nA; nt = NTe - nA; } }
        const bf16_t* Qh = FQ + (size_t)bh * SEQ * D; const bf16_t* Kh = FK + (size_t)bh * SEQ * D; const bf16_t* Vh = FV + (size_t)bh * SEQ * D;
        bf16_t* Yh = Y + (size_t)b * SEQ * DM + h * D;
        BlockRef br{Qh + (size_t)qb * QB * D, Kh, Vh, Yh + (size_t)qb * QB * DM, qb * QB};
        const int sb = bh * 16 + qb;
        SplitRef sp{flags + 2 * sb, flags + 2 * sb + 1, parts + (size_t)sb * (NW * 66 * 64)};
        if (PROBE_TILES && tid == 0) __hip_atomic_fetch_add(qctr + 32, (unsigned)nt, __ATOMIC_RELAXED, __HIP_MEMORY_SCOPE_AGENT);
        block(br, jb, nt, nh == 2 ? 1 + half : 0, sp, lds, tid);
    }
}
#undef KSWZ
#undef SBAR
}


namespace mx {
typedef float f32x16 __attribute__((ext_vector_type(16)));
typedef short s16x4 __attribute__((ext_vector_type(4)));
typedef LAS char* lptr;
using fa::v_st; using fa::v_rd_base; using fa::crow; using fa::load8;
template <int OFF> __device__ __forceinline__ s16x4 trrd(int vb) { s16x4 d; asm volatile("ds_read_b64_tr_b16 %0, %1 offset:%2" : "=&v"(d) : "v"(vb), "i"(OFF) : "memory"); return d; }
#define MX_LWAIT() do { asm volatile("s_waitcnt lgkmcnt(0)" ::: "memory"); __builtin_amdgcn_sched_barrier(0); } while (0)
#define MX_RD(l, h, vb, D0, KS) do { l = mx::trrd<(D0) * 512 + (KS) * 4096>(vb); h = mx::trrd<(D0) * 512 + (KS) * 4096 + 2048>(vb); } while (0)
#define MX_CAT(l, h) ((bf16x8){l[0], l[1], l[2], l[3], h[0], h[1], h[2], h[3]})
#define MX_MFMA(a, b, c) __builtin_amdgcn_mfma_f32_32x32x16_bf16((a), (b), (c), 0, 0, 0)
#define MX_PK4(P, B_, OUT) do { unsigned a0 = cvt_pk_bf16(P[B_+0], P[B_+1]), a1 = cvt_pk_bf16(P[B_+2], P[B_+3]); \
        unsigned b0 = cvt_pk_bf16(P[B_+4], P[B_+5]), b1 = cvt_pk_bf16(P[B_+6], P[B_+7]); \
        auto r0 = __builtin_amdgcn_permlane32_swap(a0, b0, false, false); auto r1 = __builtin_amdgcn_permlane32_swap(a1, b1, false, false); \
        u32x4 w = {r0[0], r1[0], r0[1], r1[1]}; OUT = *reinterpret_cast<bf16x8*>(&w); } while (0)
__device__ __forceinline__ bf16x8 scale8(const bf16x8 v, float z) {
    const u32x4 w = *reinterpret_cast<const u32x4*>(&v); float f[8]; unpack8(w, f);
    u32x4 o; o.x = cvt_pk_bf16(f[0] * z, f[1] * z); o.y = cvt_pk_bf16(f[2] * z, f[3] * z); o.z = cvt_pk_bf16(f[4] * z, f[5] * z); o.w = cvt_pk_bf16(f[6] * z, f[7] * z);
    return *reinterpret_cast<const bf16x8*>(&o);
}
__device__ __forceinline__ void retkv_phase(const bf16_t* RK, const bf16_t* RV, bf16_t* kvT, lptr lds, int blk, int G, int tid_) {
    int tid = tid_; asm volatile("" : "+v"(tid));
    const int wid = __builtin_amdgcn_readfirstlane(tid >> 6), lane = tid & 63, r32 = lane & 31, hi = lane >> 5;
    const int sr = tid >> 4, sc = (tid & 15) * 8;
    bf16x8 k8[2], v8[2];
#define KV_LOAD(un) do { const size_t rb_ = (size_t)((un) >> 6) * SEQ + ((un) & 63) * 64; _Pragma("unroll") for (int j = 0; j < 2; ++j) { k8[j] = load8(RK + (rb_ + sr + 32 * j) * HD + sc); v8[j] = load8(RV + (rb_ + sr + 32 * j) * HD + sc); } } while (0)
    if (blk < 16 * 64) KV_LOAD(blk);
    for (int unit = blk; unit < 16 * 64; unit += G) {
        const int bhr = unit >> 6; const float l2g = ret_log2g(bhr & 3);
        __syncthreads();
#pragma unroll
        for (int j = 0; j < 2; ++j) { const int rr = sr + 32 * j;
            *(LAS bf16x8*)(lds + v_st(rr, sc)) = scale8(k8[j], exp2f((float)(63 - rr) * l2g));
            *(LAS bf16x8*)(lds + 16384 + v_st(rr, sc)) = v8[j]; }
        if (unit + G < 16 * 64) KV_LOAD(unit + G);
        __syncthreads();
        const int eb = wid & 3, db0 = 2 * (wid >> 2);
        const int vbK = (int)(unsigned)(uintptr_t)lds + v_rd_base(lane) + db0 * 512, vbV = (int)(unsigned)(uintptr_t)lds + 16384 + v_rd_base(lane) + eb * 512;
        f32x16 c0 = {}, c1 = {};
#define KV_STEP(KS) do { s16x4 al, ah, b0l, b0h, b1l, b1h; MX_RD(al, ah, vbV, 0, KS); MX_RD(b0l, b0h, vbK, 0, KS); MX_RD(b1l, b1h, vbK, 1, KS); MX_LWAIT(); \
            c0 = MX_MFMA(MX_CAT(al, ah), MX_CAT(b0l, b0h), c0); c1 = MX_MFMA(MX_CAT(al, ah), MX_CAT(b1l, b1h), c1); } while (0)
        KV_STEP(0); KV_STEP(1); KV_STEP(2); KV_STEP(3);
#undef KV_STEP
        bf16_t* op = kvT + ((size_t)unit << 14) + 32 * db0 + r32;
#pragma unroll
        for (int r = 0; r < 16; ++r) { const int e = 32 * eb + crow(r, hi); const float n0 = __shfl_xor(c0[r], 1), n1 = __shfl_xor(c1[r], 1);
            if ((r32 & 1) == 0) { *(unsigned*)(op + e * 128) = cvt_pk_bf16(c0[r], n0); *(unsigned*)(op + e * 128 + 32) = cvt_pk_bf16(c1[r], n1); } }
    }
#undef KV_LOAD
}
__device__ __forceinline__ void retscan_phase(const bf16_t* kvT, bf16_t* ST, int blk, int G, int tid) {
    for (int i = blk * NTHREADS + tid; i < 16 * 128 * 64; i += G * NTHREADS) {
        const int bhr = i >> 13, rem2 = (i & 8191) * 2; const float cd = exp2f(64.0f * ret_log2g(bhr & 3));
        float s0 = 0.f, s1 = 0.f;
        for (int n0 = 0; n0 < 64; n0 += 16) {
            unsigned kv[16];
#pragma unroll
            for (int j = 0; j < 16; ++j) kv[j] = *(const unsigned*)(kvT + ((size_t)(bhr * 64 + n0 + j) << 14) + rem2);
#pragma unroll
            for (int j = 0; j < 16; ++j) { *(unsigned*)(ST + ((size_t)(bhr * 64 + n0 + j) << 14) + rem2) = cvt_pk_bf16(s0, s1); s0 = s0 * cd + bf2f(kv[j] & 0xffffu); s1 = s1 * cd + __uint_as_float(kv[j] & 0xffff0000u); }
        }
    }
}
__device__ __forceinline__ void retout_phase(const bf16_t* RQ, const bf16_t* RK, const bf16_t* RV, const bf16_t* RG, const bf16_t* ST, bf16_t* Y, lptr lds, int blk, int G, int tid_) {
    for (int unit = blk; unit < 256; unit += G) {
        int tid = tid_; asm volatile("" : "+v"(tid));
        const int wid = __builtin_amdgcn_readfirstlane(tid >> 6), lane = tid & 63, r32 = lane & 31, hi = lane >> 5;
        const int ci = wid >> 1, tb = wid & 1, bhr = unit >> 4, n = (unit & 15) * 4 + ci, hr = bhr & 3, b = bhr >> 2;
        const float l2g = ret_log2g(hr);
        const size_t rowbase = (size_t)bhr * SEQ + n * 64;
        __syncthreads();
        {
            const int l128 = tb * 64 + lane, row = l128 >> 1, half = l128 & 1; const bf16_t* vp = RV + (rowbase + row) * HD + half * 64; const bf16_t* gp_ = RG + (rowbase + row) * HD + half * 64;
            bf16x8 v[8], gq[8];
#pragma unroll
            for (int j = 0; j < 8; ++j) { v[j] = load8(vp + 8 * j); gq[j] = load8(gp_ + 8 * j); }
#pragma unroll
            for (int j = 0; j < 8; ++j) { *(LAS bf16x8*)(lds + ci * 32768 + v_st(row, half * 64 + 8 * j)) = v[j]; *(LAS bf16x8*)(lds + ci * 32768 + 16384 + row * 256 + half * 128 + 16 * j) = gq[j]; } }
        bf16x8 qf[8], kf0[8];
#pragma unroll
        for (int ks = 0; ks < 8; ++ks) { qf[ks] = load8(RQ + (rowbase + 32 * tb + r32) * HD + 16 * ks + 8 * hi); kf0[ks] = load8(RK + (rowbase + r32) * HD + 16 * ks + 8 * hi); }
        __syncthreads();
        f32x16 p0 = {}, p1 = {};
#pragma unroll
        for (int ks = 0; ks < 8; ++ks) p0 = MX_MFMA(kf0[ks], qf[ks], p0);
        if (tb) {
            bf16x8 kf1[8];
#pragma unroll
            for (int ks = 0; ks < 8; ++ks) kf1[ks] = load8(RK + (rowbase + 32 + r32) * HD + 16 * ks + 8 * hi);
            __builtin_amdgcn_sched_barrier(0);
#pragma unroll
            for (int ks = 0; ks < 8; ++ks) p1 = MX_MFMA(kf1[ks], qf[ks], p1); }
        const int t = 32 * tb + r32;
#pragma unroll
        for (int r = 0; r < 16; ++r) { const int d0 = t - crow(r, hi), d1 = d0 - 32;
            p0[r] = d0 >= 0 ? p0[r] * exp2f((float)d0 * l2g) : 0.f; p1[r] = d1 >= 0 ? p1[r] * exp2f((float)d1 * l2g) : 0.f; }
        bf16x8 pa0, pa1, pa2, pa3;
        MX_PK4(p0, 0, pa0); MX_PK4(p0, 8, pa1); MX_PK4(p1, 0, pa2); MX_PK4(p1, 8, pa3);
        f32x16 o[4] = {};
        const bf16_t* stp = ST + ((size_t)(bhr * 64 + n) << 14) + (size_t)r32 * HD + 8 * hi;
#pragma unroll
        for (int eh = 0; eh < 2; ++eh) {
            bf16x8 sf[16];
#pragma unroll
            for (int i = 0; i < 16; ++i) sf[i] = load8(stp + (2 * eh + (i >> 3)) * 32 * HD + 16 * (i & 7));
            __builtin_amdgcn_sched_barrier(0);
#pragma unroll
            for (int i = 0; i < 16; ++i) o[2 * eh + (i >> 3)] = MX_MFMA(qf[i & 7], sf[i], o[2 * eh + (i >> 3)]);
            __builtin_amdgcn_sched_barrier(0);
        }
#pragma unroll
        for (int r = 0; r < 16; ++r) { const float xi = exp2f((float)(32 * tb + crow(r, hi) + 1) * l2g);
#pragma unroll
            for (int eb = 0; eb < 4; ++eb) o[eb][r] *= xi; }
        const int vb = (int)(unsigned)(uintptr_t)lds + ci * 32768 + v_rd_base(lane);
#define RO_STEP(EB) do { s16x4 l0, h0, l1, h1; MX_RD(l0, h0, vb, EB, 0); MX_RD(l1, h1, vb, EB, 1); MX_LWAIT(); \
            o[EB] = MX_MFMA(pa0, MX_CAT(l0, h0), o[EB]); o[EB] = MX_MFMA(pa1, MX_CAT(l1, h1), o[EB]); \
            if (tb) { s16x4 l2, h2, l3, h3; MX_RD(l2, h2, vb, EB, 2); MX_RD(l3, h3, vb, EB, 3); MX_LWAIT(); \
                o[EB] = MX_MFMA(pa2, MX_CAT(l2, h2), o[EB]); o[EB] = MX_MFMA(pa3, MX_CAT(l3, h3), o[EB]); } } while (0)
        RO_STEP(0); RO_STEP(1); RO_STEP(2); RO_STEP(3);
#undef RO_STEP
        const LAS bf16_t* gp = (const LAS bf16_t*)(lds + ci * 32768 + 16384 + (32 * tb) * 256) + r32; bf16_t* yp = Y + ((size_t)(b * SEQ + n * 64 + 32 * tb)) * DM + 1024 + hr * HD + r32;
#pragma unroll
        for (int r = 0; r < 16; ++r) { const int tr = crow(r, hi);
            float v0 = o[0][r], v1 = o[1][r], v2 = o[2][r], v3 = o[3][r];
            float ss = (v0 * v0 + v1 * v1) + (v2 * v2 + v3 * v3);
            ss += __shfl_xor(ss, 1); ss += __shfl_xor(ss, 2); ss += __shfl_xor(ss, 4); ss += __shfl_xor(ss, 8); ss += __shfl_xor(ss, 16);
            const float rs = rsqrtf(ss * (1.0f / 128.0f) + EPS);
            v0 *= rs * bf2f(gp[tr * HD]); v1 *= rs * bf2f(gp[tr * HD + 32]); v2 *= rs * bf2f(gp[tr * HD + 64]); v3 *= rs * bf2f(gp[tr * HD + 96]);
            const float n0 = __shfl_xor(v0, 1), n1 = __shfl_xor(v1, 1), n2 = __shfl_xor(v2, 1), n3 = __shfl_xor(v3, 1);
            if ((r32 & 1) == 0) { bf16_t* op = yp + (size_t)tr * DM;
                *(unsigned*)(op) = cvt_pk_bf16(v0, n0); *(unsigned*)(op + 32) = cvt_pk_bf16(v1, n1); *(unsigned*)(op + 64) = cvt_pk_bf16(v2, n2); *(unsigned*)(op + 96) = cvt_pk_bf16(v3, n3); } }
    }
}
__device__ __forceinline__ void gmlp_phase(const bf16_t* GU, const bf16_t* GV, const float* lng, const float* lnb, const float* wsp, const float* bsp, bf16_t* Y, lptr lds, int blk, int G, int tid_) {
    for (int pu = blk; pu < 256; pu += G) {
        int tid = tid_; asm volatile("" : "+v"(tid));
        const int wid = __builtin_amdgcn_readfirstlane(tid >> 6), lane = tid & 63, r32 = lane & 31, hi = lane >> 5;
        const int ui = wid >> 2, tb = wid & 3, unit = 2 * pu + ui, g = unit & 3, n = (unit >> 2) & 31, b = unit >> 7;
        const size_t ro = ((size_t)(b * GMG + g) * SEQ + n * 128) * HD;
        __syncthreads();
        {
            const int l256 = tb * 64 + lane, ch = l256 & 15, rsub = l256 >> 4;
            float gg[8], bb[8];
#pragma unroll
            for (int j = 0; j < 8; ++j) { gg[j] = lng[g * 128 + 8 * ch + j]; bb[j] = lnb[g * 128 + 8 * ch + j]; }
            bf16x8 vrow[8], urow[8];
#pragma unroll
            for (int ps = 0; ps < 8; ++ps) { vrow[ps] = load8(GV + ro + (size_t)(ps * 16 + rsub) * HD + 8 * ch); urow[ps] = load8(GU + ro + (size_t)(ps * 16 + rsub) * HD + 8 * ch); }
#pragma unroll
            for (int ps = 0; ps < 8; ++ps) *(LAS bf16x8*)(lds + 65536 + ui * 32768 + (ps * 16 + rsub) * 256 + 16 * ch) = urow[ps];
#pragma unroll
            for (int ps = 0; ps < 8; ++ps) { const int row = ps * 16 + rsub;
                float f[8]; unpack8(*reinterpret_cast<const u32x4*>(&vrow[ps]), f);
                float s = ((f[0] + f[1]) + (f[2] + f[3])) + ((f[4] + f[5]) + (f[6] + f[7]));
                s += __shfl_xor(s, 1); s += __shfl_xor(s, 2); s += __shfl_xor(s, 4); s += __shfl_xor(s, 8);
                const float mu = s * (1.0f / 128.0f); float q = 0.f;
#pragma unroll
                for (int j = 0; j < 8; ++j) { f[j] -= mu; q += f[j] * f[j]; }
                q += __shfl_xor(q, 1); q += __shfl_xor(q, 2); q += __shfl_xor(q, 4); q += __shfl_xor(q, 8);
                const float rs = rsqrtf(q * (1.0f / 128.0f) + EPS);
                u32x4 o; o.x = cvt_pk_bf16(f[0] * rs * gg[0] + bb[0], f[1] * rs * gg[1] + bb[1]); o.y = cvt_pk_bf16(f[2] * rs * gg[2] + bb[2], f[3] * rs * gg[3] + bb[3]);
                o.z = cvt_pk_bf16(f[4] * rs * gg[4] + bb[4], f[5] * rs * gg[5] + bb[5]); o.w = cvt_pk_bf16(f[6] * rs * gg[6] + bb[6], f[7] * rs * gg[7] + bb[7]);
                *(LAS u32x4*)(lds + ui * 32768 + (row >> 6) * 16384 + v_st(row & 63, 8 * ch)) = o; }
        }
        __syncthreads();
        f32x16 acc[4] = {};
        const int vb = (int)(unsigned)(uintptr_t)lds + ui * 32768 + v_rd_base(lane);
        const int t = 32 * tb + r32; const float* wrow = wsp + (size_t)g * 128 * 128 + (size_t)t * 128 + 8 * hi;
        float btv[16];
#pragma unroll
        for (int r = 0; r < 16; ++r) btv[r] = bsp[g * 128 + 32 * tb + crow(r, hi)];
        f32x4 wq[8][2];
#pragma unroll
        for (int ks = 0; ks < 8; ++ks) if (ks <= 2 * tb + 1) { wq[ks][0] = *(const f32x4*)(wrow + 16 * ks); wq[ks][1] = *(const f32x4*)(wrow + 16 * ks + 4); }
#define GM_STEP(KS) do { if ((KS) <= 2 * tb + 1) { const f32x4 w0 = wq[KS][0], w1 = wq[KS][1]; const int sb = 16 * (KS) + 8 * hi; \
            u32x4 aw; aw.x = cvt_pk_bf16(sb + 0 <= t ? w0[0] : 0.f, sb + 1 <= t ? w0[1] : 0.f); aw.y = cvt_pk_bf16(sb + 2 <= t ? w0[2] : 0.f, sb + 3 <= t ? w0[3] : 0.f); \
            aw.z = cvt_pk_bf16(sb + 4 <= t ? w1[0] : 0.f, sb + 5 <= t ? w1[1] : 0.f); aw.w = cvt_pk_bf16(sb + 6 <= t ? w1[2] : 0.f, sb + 7 <= t ? w1[3] : 0.f); \
            const bf16x8 af = *reinterpret_cast<const bf16x8*>(&aw); \
            s16x4 l0, h0, l1, h1, l2, h2, l3, h3; constexpr int TO = ((KS) >> 2) * 16384; \
            l0 = mx::trrd<TO + 0 * 512 + ((KS) & 3) * 4096>(vb); h0 = mx::trrd<TO + 0 * 512 + ((KS) & 3) * 4096 + 2048>(vb); l1 = mx::trrd<TO + 1 * 512 + ((KS) & 3) * 4096>(vb); h1 = mx::trrd<TO + 1 * 512 + ((KS) & 3) * 4096 + 2048>(vb); \
            l2 = mx::trrd<TO + 2 * 512 + ((KS) & 3) * 4096>(vb); h2 = mx::trrd<TO + 2 * 512 + ((KS) & 3) * 4096 + 2048>(vb); l3 = mx::trrd<TO + 3 * 512 + ((KS) & 3) * 4096>(vb); h3 = mx::trrd<TO + 3 * 512 + ((KS) & 3) * 4096 + 2048>(vb); \
            MX_LWAIT(); \
            acc[0] = MX_MFMA(af, MX_CAT(l0, h0), acc[0]); acc[1] = MX_MFMA(af, MX_CAT(l1, h1), acc[1]); acc[2] = MX_MFMA(af, MX_CAT(l2, h2), acc[2]); acc[3] = MX_MFMA(af, MX_CAT(l3, h3), acc[3]); } } while (0)
        GM_STEP(0); GM_STEP(1); GM_STEP(2); GM_STEP(3); GM_STEP(4); GM_STEP(5); GM_STEP(6); GM_STEP(7);
#undef GM_STEP
        const LAS bf16_t* up = (const LAS bf16_t*)(lds + 65536 + ui * 32768 + (32 * tb) * 256) + r32; bf16_t* yp = Y + ((size_t)(b * SEQ + n * 128 + 32 * tb)) * DM + 1536 + g * HD + r32;
#pragma unroll
        for (int r = 0; r < 16; ++r) { const int tr = crow(r, hi); const float bt = btv[r];
            float v0 = bf2f(up[tr * HD]) * (acc[0][r] + bt), v1 = bf2f(up[tr * HD + 32]) * (acc[1][r] + bt), v2 = bf2f(up[tr * HD + 64]) * (acc[2][r] + bt), v3 = bf2f(up[tr * HD + 96]) * (acc[3][r] + bt);
            float ss = (v0 * v0 + v1 * v1) + (v2 * v2 + v3 * v3);
            ss += __shfl_xor(ss, 1); ss += __shfl_xor(ss, 2); ss += __shfl_xor(ss, 4); ss += __shfl_xor(ss, 8); ss += __shfl_xor(ss, 16);
            const float rs = rsqrtf(ss * (1.0f / 128.0f) + EPS);
            v0 *= rs; v1 *= rs; v2 *= rs; v3 *= rs;
            const float n0 = __shfl_xor(v0, 1), n1 = __shfl_xor(v1, 1), n2 = __shfl_xor(v2, 1), n3 = __shfl_xor(v3, 1);
            if ((r32 & 1) == 0) { bf16_t* op = yp + (size_t)tr * DM;
                *(unsigned*)(op) = cvt_pk_bf16(v0, n0); *(unsigned*)(op + 32) = cvt_pk_bf16(v1, n1); *(unsigned*)(op + 64) = cvt_pk_bf16(v2, n2); *(unsigned*)(op + 96) = cvt_pk_bf16(v3, n3); } }
    }
}
__device__ __forceinline__ void fz_phase(const bf16_t* xb, const float* ssq, const bf16_t* wfz, const float* bf, float* logf, LAS float* part  , int blk, int G, int tid_) {
    int tid = tid_; asm volatile("" : "+v"(tid));
    const int wid = __builtin_amdgcn_readfirstlane(tid >> 6), lane = tid & 63, r32 = lane & 31, hi = lane >> 5;
    const int rbl = wid >> 2, kq = wid & 3;
    for (int rb2 = blk; rb2 < MROWS / 64; rb2 += G) {
        const int rb = rb2 * 2 + rbl;
        const bf16_t* ap = xb + (size_t)(32 * rb + r32) * DM + kq * 512 + 8 * hi; const bf16_t* bp = wfz + (size_t)(r32 & 7) * DM + kq * 512 + 8 * hi;
        f32x16 c = {};
#pragma unroll 8
        for (int ks = 0; ks < 32; ++ks) { const bf16x8 a = load8(ap + 16 * ks); bf16x8 bv = load8(bp + 16 * ks); if (r32 >= 8) bv = (bf16x8){0, 0, 0, 0, 0, 0, 0, 0}; c = MX_MFMA(a, bv, c); }
        if (r32 < 8) {
#pragma unroll
            for (int r = 0; r < 16; ++r) part[((rbl * 4 + kq) * 32 + crow(r, hi)) * 8 + r32] = c[r]; }
        __syncthreads();
        {
            const int row64 = tid >> 3, h = tid & 7, rl = row64 >> 5, rr = row64 & 31; const int row = 64 * rb2 + row64;
            const float d = (part[((rl * 4 + 0) * 32 + rr) * 8 + h] + part[((rl * 4 + 1) * 32 + rr) * 8 + h]) + (part[((rl * 4 + 2) * 32 + rr) * 8 + h] + part[((rl * 4 + 3) * 32 + rr) * 8 + h]);
            const f32x4 pp = *(const f32x4*)(ssq + (size_t)row * 32 + h * 4);
            float s = (pp[0] + pp[1]) + (pp[2] + pp[3]); s += __shfl_xor(s, 1); s += __shfl_xor(s, 2); s += __shfl_xor(s, 4);
            const float rs = rsqrtf(s * (1.0f / DM) + EPS);
            logf[((size_t)((row >> 12) * FOXH + h)) * SEQ + (row & 4095)] = logsig_f(d * rs + bf[h]);
        }
        __syncthreads();
    }
}
#undef MX_LWAIT
#undef MX_RD
#undef MX_CAT
#undef MX_MFMA
#undef MX_PK4
}

template <unsigned PHMASK> __global__ void __launch_bounds__(NTHREADS, 2) fwd(Args a) {
    extern __shared__ __attribute__((aligned(16))) unsigned char lds_raw[];
    LAS unsigned char* lds = (LAS unsigned char*)lds_raw;
    const int tid0 = threadIdx.x, G0 = gridDim.x, blk0 = blockIdx.x;
    unsigned char* ws0 = a.ws;
    for (int u = tid0; u < (LDS_BYTES - LDSCTL_OFF) / 4; u += NTHREADS) ((LAS unsigned*)(lds + LDSCTL_OFF))[u] = 0u;
    __syncthreads();
    XcdBarrier bar; bar.bar = (unsigned*)(ws0 + WS_CTL) + CW_BAR; bar.x = 0; bar.st = nullptr;
    if (a.use_bar) bar = xcd_barrier_post((unsigned*)(ws0 + WS_CTL) + CW_BAR, (volatile LAS unsigned*)(lds + MISC_OFF) + 8);
#define GRID_BAR() do { if (a.use_bar) xcd_barrier(bar); } while (0)
    unsigned long long spin_t0 = 0ull, spin_acc = 0ull; (void)spin_t0;
    unsigned long long clk_c = 0ull, clk_r = 0ull;
#define IN(k) (((PHMASK >> (k)) & 1u) != 0u && a.ph_lo <= (k) && (k) < a.ph_hi)
#define REP(k) for (int rep_ = (spin_t0 = (((PROBE_SPIN_MASK >> (k)) & 1u) ? __builtin_amdgcn_s_memrealtime() : 0ull), 0); rep_ < (((PROBE_MASK >> (k)) & 1u) ? 1 + PROBE_REP : 1); ++rep_, spin_acc += (((PROBE_SPIN_MASK >> (k)) & 1u) ? __builtin_amdgcn_s_memrealtime() - spin_t0 : 0ull))

#define LV(x) asm volatile("" : "+v"(x))
#define STAGGER() do { if (STAGGER_TICKS) { const unsigned long long t0_ = __builtin_amdgcn_s_memrealtime(), w_ = (unsigned long long)((blk & 3) * STAGGER_TICKS); while (__builtin_amdgcn_s_memrealtime() - t0_ < w_) __builtin_amdgcn_s_sleep(2); } } while (0)
#define LS(x) asm volatile("" : "+s"(x))
#define PH_ENTER() int tid = tid0, blk = blk0, G = G0; unsigned long long zoff_ = 0ull; LV(tid); LS(blk); LS(G); LS(zoff_); unsigned char* ws = ws0 + zoff_; \
        const int lane = tid & 63, wave = __builtin_amdgcn_readfirstlane(tid >> 6), gw = blk * NWAVES + wave, ngw = G * NWAVES; (void)lane; (void)gw; (void)ngw

    if (a.l_lo == 0 && IN(0)) REP(0) { { PH_ENTER(); prologue_cmax(a, ws, gw, ngw, lane); GRID_BAR(); } { PH_ENTER(); prologue(a, ws, lds, gw, ngw, wave, lane); GRID_BAR(); } }

    for (int l0 = a.l_lo; l0 < a.l_hi; ++l0) {
#define FFN_PAIR(f, PU, PD) do { \
        if (IN(PU)) REP(PU) { PH_ENTER(); int l = l0; LS(l); STAGGER(); const unsigned long long c0_ = PROBE_CLOCK ? (unsigned long long)__builtin_readcyclecounter() : 0ull, r0_ = PROBE_CLOCK ? __builtin_amdgcn_s_memrealtime() : 0ull; \
            pg8::Gemm g{(const bf16_t*)(ws + WS_XQ), (const bf16_t*)(ws + WS_WGU + (size_t)(l * 2 + (f)) * SZ_WGU), MROWS, NGU, DM / 2}; pg8::StaticOrder S; S.init(MROWS, NGU, G, blk); \
            { pg8::Unit u0; if (S.next(0, u0)) quant_rows((const bf16_t*)(ws + WS_XB), ws + WS_XQ, (float*)(ws + WS_QS), (const float*)(ws + WS_SSQ), (unsigned*)(ws + WS_CTL) + CW_QCNT + (l * 2 + (f)) * 64 + u0.pm, u0.pm, u0.pn & 3, (LAS float*)(lds + RSL_OFF), tid); } \
            EpiSwiGLUq E{(bf16_t*)(ws + WS_HID), (const float*)((const unsigned*)(ws + WS_CTL) + CW_CMAX) + (size_t)(l * 2 + (f)) * NGU, (LAS float*)(lds + RSL_OFF), (PROBE_NULLEPI && rep_ > 0) ? 1 : 0, 0, 0}; \
            pg8::gemm_phase<EpiSwiGLUq, pg8::StaticOrder, true, true, false, true>(lds, g, S, E, tid); \
            if (PROBE_CLOCK) { clk_c += (unsigned long long)__builtin_readcyclecounter() - c0_; clk_r += __builtin_amdgcn_s_memrealtime() - r0_; } \
            GRID_BAR(); \
        } \
        if (IN(PD)) REP(PD) { PH_ENTER(); int l = l0; LS(l); \
            pg8::Gemm g{(const bf16_t*)(ws + WS_HID), (const bf16_t*)(ws + WS_WD + (size_t)(l * 2 + (f)) * SZ_WD), MROWS, DM, DFF}; pg8::StaticOrder S; S.init(MROWS, DM, G, blk); \
            EpiResid E{(l == 0 && (f) == 0 && rep_ == 0) ? a.in[0] : (const float*)nullptr, (bf16_t*)(ws + WS_XB), (float*)(ws + WS_SSQ), rep_ == 0 ? 0.5f : 0.f, (PROBE_NULLEPI && rep_ > 0) ? 1 : 0}; \
            pg8::gemm_phase<EpiResid, pg8::StaticOrder, true, true, true>(lds, g, S, E, tid); \
            GRID_BAR(); \
        } } while (0)
        FFN_PAIR(0, 1, 2);
        if (IN(3)) REP(3) { PH_ENTER(); int l = l0; LS(l); STAGGER();
            pg8::Gemm g{(const bf16_t*)(ws + WS_XB), (const bf16_t*)(ws + WS_WIN + (size_t)l * SZ_WIN), MROWS, NWIN, DM}; pg8::StaticOrder S; S.init(MROWS, NWIN, G, blk);
            const float* ropec = (const float*)(ws + WS_ROPE);
            EpiWin E{(const float*)(ws + WS_SSQ), (LAS float*)(lds + RSL_OFF), ropec, ropec + SEQ * 64, (bf16_t*)(ws + WS_FQ), (bf16_t*)(ws + WS_RQ), -1, (float*)(ws + WS_NORM)};
            pg8::gemm_phase<EpiWin, pg8::StaticOrder, true, true>(lds, g, S, E, tid);
            if (NAIVE_MASK & 1) fz_phase((const bf16_t*)(ws + WS_XB), (const float*)(ws + WS_SSQ), (const float*)(ws + WS_WFZ) + (size_t)l * 8 * DM, a.in[7] + l * 8, (float*)(ws + WS_LOGF), blk, G, tid);
            else mx::fz_phase((const bf16_t*)(ws + WS_XB), (const float*)(ws + WS_SSQ), (const bf16_t*)(ws + WS_WFZ) + (size_t)l * 8 * DM, a.in[7] + l * 8, (float*)(ws + WS_LOGF), (LAS float*)lds, blk, G, tid);
            GRID_BAR();
        }
        if (IN(4)) REP(4) { PH_ENTER(); int l = l0; LS(l);
            float* logf = (float*)(ws + WS_LOGF); float* cum = (float*)(ws + WS_CUM); float* rkv = (float*)(ws + WS_RKV);
            bf16_t *RK = (bf16_t*)(ws + WS_RK), *RV = (bf16_t*)(ws + WS_RV), *GU = (bf16_t*)(ws + WS_GU), *GV = (bf16_t*)(ws + WS_GV), *Y = (bf16_t*)(ws + WS_Y);
            for (int bh = blk; bh < NB * FOXH; bh += G) cumsum_unit(logf + (size_t)bh * SEQ, cum + (size_t)bh * SEQ, (LAS float*)lds, tid);
            if (NAIVE_MASK & 2) { for (int un = blk; un < 16 * 64; un += G) { const int bhr = un >> 6, n = un & 63; const size_t ro = ((size_t)bhr * SEQ + n * 64) * HD;
                retkv_unit(RK + ro, RV + ro, rkv + (size_t)un * 128 * 128, ret_log2g(bhr & 3), (LAS float*)lds, tid); } }
            else mx::retkv_phase(RK, RV, (bf16_t*)rkv, (mx::lptr)lds, blk, G, tid);
            if (NAIVE_MASK & 4) { for (int un = blk; un < NB * 32 * GMG; un += G) { const int g = un & 3, n = (un >> 2) & 31, b = un >> 7; const size_t ro = ((size_t)(b * GMG + g) * SEQ + n * 128) * HD;
                gmlp_unit(GU + ro, GV + ro, a.in[8] + l * 512 + g * 128, a.in[9] + l * 512 + g * 128, a.in[10] + ((size_t)l * 4 + g) * 128 * 128, a.in[11] + (l * 4 + g) * 128,
                          Y + ((size_t)(b * SEQ + n * 128)) * DM + 1536 + g * 128, (LAS float*)lds, tid); } }
            else mx::gmlp_phase(GU, GV, a.in[8] + l * 512, a.in[9] + l * 512, a.in[10] + (size_t)l * 4 * 128 * 128, a.in[11] + l * 4 * 128, Y, (mx::lptr)lds, blk, G, tid);
            GRID_BAR();
        }
        if (IN(5)) REP(5) { PH_ENTER();
            float* rkv = (float*)(ws + WS_RKV); float* rsp = (float*)(ws + WS_RSP);
            if (NAIVE_MASK & 2) { for (int i = blk * NTHREADS + tid; i < 16 * 128 * 128; i += G * NTHREADS) { const int bhr = i >> 14, de = i & 16383;
                const float cd = exp2f(64.0f * ret_log2g(bhr & 3)); float st = 0.f;
                for (int n = 0; n < 64; ++n) { const size_t o = ((size_t)(bhr * 64 + n) << 14) + de; rsp[o] = st; st = st * cd + rkv[o]; } } }
            else mx::retscan_phase((const bf16_t*)rkv, (bf16_t*)rsp, blk, G, tid);
            GRID_BAR();
        }
        if (IN(6)) REP(6) {
            { PH_ENTER();
              bf16_t *RQ = (bf16_t*)(ws + WS_RQ), *RK = (bf16_t*)(ws + WS_RK), *RV = (bf16_t*)(ws + WS_RV), *RG = (bf16_t*)(ws + WS_RG), *Y = (bf16_t*)(ws + WS_Y);
              float* rsp = (float*)(ws + WS_RSP);
              if (NAIVE_MASK & 2) { for (int un = blk; un < 16 * 64; un += G) { const int bhr = un >> 6, n = un & 63, b = bhr >> 2, hr = bhr & 3; const size_t ro = ((size_t)bhr * SEQ + n * 64) * HD;
                  retout_unit(RQ + ro, RK + ro, RV + ro, RG + ro, rsp + (size_t)un * 128 * 128, Y + ((size_t)(b * SEQ + n * 64)) * DM + 1024 + hr * 128, ret_log2g(hr), (LAS float*)lds, tid); } }
              else mx::retout_phase(RQ, RK, RV, RG, (const bf16_t*)rsp, Y, (mx::lptr)lds, blk, G, tid); }
            { PH_ENTER(); int l = l0; LS(l);
              fa::attn_phase((const bf16_t*)(ws + WS_FQ), (const bf16_t*)(ws + WS_FK), (const bf16_t*)(ws + WS_FV), (const float*)(ws + WS_CUM), (const float*)(ws + WS_NORM), (bf16_t*)(ws + WS_Y),
                             (unsigned*)(ws + WS_CTL) + CW_QUEUE + 64 * (2 * l + (rep_ & 1)), (unsigned*)(ws + WS_CTL) + CW_FLAGS + (size_t)l * 1024, (float*)(ws + WS_PART), (fa::lptr)lds, tid); }
            GRID_BAR();
        }
        if (IN(7)) REP(7) { PH_ENTER(); int l = l0; LS(l);
            pg8::Gemm g{(const bf16_t*)(ws + WS_Y), (const bf16_t*)(ws + WS_WOUT + (size_t)l * SZ_WOUT), MROWS, DM, DM}; pg8::StaticOrder S; S.init(MROWS, DM, G, blk);
            EpiResid E{(const float*)nullptr, (bf16_t*)(ws + WS_XB), (float*)(ws + WS_SSQ), rep_ == 0 ? 1.0f : 0.f, (PROBE_NULLEPI && rep_ > 0) ? 1 : 0};
            pg8::gemm_phase<EpiResid, pg8::StaticOrder, true, true>(lds, g, S, E, tid);
            GRID_BAR();
        }
        FFN_PAIR(1, 8, 9);
#undef FFN_PAIR
    }
    if (a.l_hi == DEPTH && IN(10)) REP(10) { PH_ENTER();
        const float* fn = a.in[18]; const float* ssq = (const float*)(ws + WS_SSQ);
        f32x4 gn[8];
#pragma unroll
        for (int j = 0; j < 4; ++j) { gn[2 * j] = ((const f32x4*)fn)[(j * 64 + lane) * 2]; gn[2 * j + 1] = ((const f32x4*)fn)[(j * 64 + lane) * 2 + 1]; }
        for (int m = gw; m < MROWS; m += 2 * ngw) {
            const int m2 = m + ngw; const bool has2 = m2 < MROWS; const int mb = has2 ? m2 : m;
            float s0 = lane < 32 ? ssq[(size_t)m * 32 + lane] : 0.f, s1 = lane < 32 ? ssq[(size_t)mb * 32 + lane] : 0.f;
            const u32x4* xa = (const u32x4*)((const bf16_t*)(ws + WS_XB) + (size_t)m * DM); const u32x4* xc = (const u32x4*)((const bf16_t*)(ws + WS_XB) + (size_t)mb * DM);
            u32x4 ra[4], rc[4];
#pragma unroll
            for (int j = 0; j < 4; ++j) { ra[j] = xa[j * 64 + lane]; rc[j] = xc[j * 64 + lane]; }
            s0 = wave_sum(s0); s1 = wave_sum(s1);
            const float rs0 = rsqrtf(s0 * (1.0f / DM) + EPS), rs1 = rsqrtf(s1 * (1.0f / DM) + EPS);
            f32x4* xr0 = (f32x4*)(a.out + (size_t)m * DM); f32x4* xr1 = (f32x4*)(a.out + (size_t)mb * DM);
#pragma unroll
            for (int j = 0; j < 4; ++j) { float f[8]; unpack8(ra[j], f);
                xr0[(j * 64 + lane) * 2] = (f32x4){f[0], f[1], f[2], f[3]} * rs0 * gn[2 * j]; xr0[(j * 64 + lane) * 2 + 1] = (f32x4){f[4], f[5], f[6], f[7]} * rs0 * gn[2 * j + 1]; }
            if (has2) {
#pragma unroll
                for (int j = 0; j < 4; ++j) { float f[8]; unpack8(rc[j], f);
                    xr1[(j * 64 + lane) * 2] = (f32x4){f[0], f[1], f[2], f[3]} * rs1 * gn[2 * j]; xr1[(j * 64 + lane) * 2 + 1] = (f32x4){f[4], f[5], f[6], f[7]} * rs1 * gn[2 * j + 1]; } }
        }
    }
    if (PROBE_CLOCK && blk0 == 0 && tid0 == 0) { const unsigned long long ticks = clk_r ? (clk_c * 10000ull) / clk_r : 0ull;
        const unsigned long long te = __builtin_amdgcn_s_memrealtime(); while (__builtin_amdgcn_s_memrealtime() - te < ticks) __builtin_amdgcn_s_sleep(8); }
    if (PROBE_TILES) { GRID_BAR(); if (blk0 == 0 && tid0 == 0) { unsigned long long tot = 0; for (int l = 0; l < DEPTH; ++l) tot += __hip_atomic_load((unsigned*)(ws0 + WS_CTL) + CW_QUEUE + 64 * (2 * l) + 32, __ATOMIC_RELAXED, __HIP_MEMORY_SCOPE_AGENT);
        const unsigned long long te = __builtin_amdgcn_s_memrealtime(); while (__builtin_amdgcn_s_memrealtime() - te < tot * 10ull) __builtin_amdgcn_s_sleep(8); } }
    if (PROBE_SPIN_MASK != 0u && blk0 == 0 && tid0 == 0) { const unsigned long long te = __builtin_amdgcn_s_memrealtime(); while (__builtin_amdgcn_s_memrealtime() - te < (unsigned long long)PROBE_SPIN_AMP * spin_acc) __builtin_amdgcn_s_sleep(8); }
#undef PH_ENTER
#undef LV
#undef LS
#undef IN
#undef GRID_BAR
}

extern "C" void kernel_launch(void* const* d_in, const int* in_sizes, int n_in, void* d_out, int out_size, void* d_ws, size_t ws_size, hipStream_t stream) {
    static int grid = 0;
    if (grid == 0) {
        if (n_in != 19 || in_sizes[0] != MROWS * DM || out_size != MROWS * DM || ws_size < WS_END) { fprintf(stderr, "kernel_launch: unexpected shapes (n_in %d, in0 %d, out %d, ws %zu < %zu)\n", n_in, n_in > 0 ? in_sizes[0] : -1, out_size, ws_size, (size_t)WS_END); grid = -1; return; }
        int dev = 0, cus = 0;
        if (hipGetDevice(&dev) != hipSuccess || hipDeviceGetAttribute(&cus, hipDeviceAttributeMultiprocessorCount, dev) != hipSuccess) { grid = -1; return; }
#define SETATTR(K) do { if (hipFuncSetAttribute((const void*)(K), hipFuncAttributeMaxDynamicSharedMemorySize, LDS_BYTES) != hipSuccess) { fprintf(stderr, "kernel_launch: hipFuncSetAttribute failed\n"); grid = -1; return; } } while (0)
#if MK_SPLIT
        SETATTR(fwd<1u << 0>); SETATTR(fwd<1u << 1>); SETATTR(fwd<1u << 2>); SETATTR(fwd<1u << 3>); SETATTR(fwd<1u << 4>); SETATTR(fwd<1u << 5>);
        SETATTR(fwd<1u << 6>); SETATTR(fwd<1u << 7>); SETATTR(fwd<1u << 8>); SETATTR(fwd<1u << 9>); SETATTR(fwd<1u << 10>);
#else
        SETATTR(fwd<0x7ffu>);
        int per_cu = 0;
        if (hipOccupancyMaxActiveBlocksPerMultiprocessor(&per_cu, (const void*)fwd<0x7ffu>, NTHREADS, LDS_BYTES) != hipSuccess || per_cu < 1) fprintf(stderr, "kernel_launch: occupancy query reports %d\n", per_cu);
        (void)hipGetLastError();
#endif
        grid = cus;
    }
    if (grid < 0) return;
    (void)hipMemsetAsync((char*)d_ws + WS_CTL, 0, CTL_ZERO_BYTES, stream);
    Args a{};
    for (int i = 0; i < 19; ++i) a.in[i] = (const float*)d_in[i];
    a.out = (float*)d_out; a.ws = (unsigned char*)d_ws; a.pad = 0;
#if MK_SPLIT
    a.use_bar = 0;
#define LAUNCH1(PH, LL, LH) do { Args p = a; p.l_lo = (LL); p.l_hi = (LH); p.ph_lo = (PH); p.ph_hi = (PH) + 1; hipLaunchKernelGGL(fwd<(1u << (PH))>, dim3(grid), dim3(NTHREADS), LDS_BYTES, stream, p); } while (0)
    LAUNCH1(0, 0, 0);
    for (int l = 0; l < DEPTH; ++l) { LAUNCH1(1, l, l + 1); LAUNCH1(2, l, l + 1); LAUNCH1(3, l, l + 1); LAUNCH1(4, l, l + 1); LAUNCH1(5, l, l + 1); LAUNCH1(6, l, l + 1); LAUNCH1(7, l, l + 1); LAUNCH1(8, l, l + 1); LAUNCH1(9, l, l + 1); }
    LAUNCH1(10, DEPTH, DEPTH);
#else
    a.use_bar = 1; a.l_lo = 0; a.l_hi = DEPTH; a.ph_lo = 0; a.ph_hi = 11;
    hipLaunchKernelGGL(fwd<0x7ffu>, dim3(grid), dim3(NTHREADS), LDS_BYTES, stream, a);
#endif
}
```

```cpp
#include <hip/hip_runtime.h>
#include <cstdio>
#include <cstdint>

#ifndef MK_SPLIT
#define MK_SPLIT 0
#endif

#ifndef PROBE_MASK
#define PROBE_MASK 0u
#endif
#ifndef NAIVE_MASK
#define NAIVE_MASK 0
#endif
#ifndef PROBE_NULLEPI
#define PROBE_NULLEPI 0
#endif
#ifndef PROBE_SPIN_MASK
#define PROBE_SPIN_MASK 0u
#endif
#ifndef PROBE_SPIN_AMP
#define PROBE_SPIN_AMP 4
#endif
#ifndef STAGGER_TICKS
#define STAGGER_TICKS 0
#endif
#ifndef PROBE_MMAV
#define PROBE_MMAV 0
#endif
#ifndef PROBE_CLOCK
#define PROBE_CLOCK 0
#endif
#ifndef PROBE_TILES
#define PROBE_TILES 0
#endif
#ifndef PROBE_REP
#define PROBE_REP 1
#endif
#define LAS __attribute__((address_space(3)))
#define GAS __attribute__((address_space(1)))
typedef unsigned short bf16_t;
typedef short bf16x8 __attribute__((ext_vector_type(8)));
typedef float f32x4 __attribute__((ext_vector_type(4)));
typedef float f32x2 __attribute__((ext_vector_type(2)));
typedef unsigned u32x4 __attribute__((ext_vector_type(4)));
typedef unsigned u32x2 __attribute__((ext_vector_type(2)));
typedef int i32x4 __attribute__((ext_vector_type(4)));

constexpr int DM = 2048, NB = 4, SEQ = 4096, DEPTH = 4, MROWS = NB * SEQ, DFF = 5632, HD = 128;
constexpr int FOXH = 8, RETH = 4, GMG = 4;
constexpr int INCOLS = 6152, NWIN = 6144, NGU = 2 * DFF;
constexpr int FZ_COL = 3072;
constexpr float EPS = 1e-6f;
constexpr int NWAVES = 8, NTHREADS = 512;

constexpr size_t MiB = 1u << 20;
constexpr size_t WS_CTL = 0, CTL_ZERO_BYTES = 1 * MiB;
constexpr size_t WS_SSQ = 1 * MiB;
constexpr size_t WS_ROPE = 3 * MiB;
constexpr size_t WS_LOGF = 5 * MiB;
constexpr size_t WS_CUM = 5 * MiB + 512 * 1024;
constexpr size_t WS_WFZ = 6 * MiB;
constexpr size_t WS_NORM = 7 * MiB;
constexpr size_t WS_WGU = 8 * MiB;
constexpr size_t SZ_WGU = (size_t)NGU * DM * 2;
constexpr size_t WS_WD = WS_WGU + 8 * SZ_WGU;
constexpr size_t SZ_WD = (size_t)DM * DFF * 2;
constexpr size_t WS_WIN = WS_WD + 8 * SZ_WD;
constexpr size_t SZ_WIN = (size_t)NWIN * DM * 2;
constexpr size_t WS_WOUT = WS_WIN + 4 * SZ_WIN;
constexpr size_t SZ_WOUT = (size_t)DM * DM * 2;
constexpr size_t WS_XB = WS_WOUT + 4 * SZ_WOUT;
constexpr size_t WS_ACT = WS_XB + (size_t)MROWS * DM * 2;
constexpr size_t WS_HID = WS_ACT;
constexpr size_t SZ_FOX = (size_t)NB * FOXH * SEQ * HD * 2;
constexpr size_t SZ_R = (size_t)NB * RETH * SEQ * HD * 2;
constexpr size_t WS_FQ = WS_ACT, WS_FK = WS_FQ + SZ_FOX, WS_FV = WS_FK + SZ_FOX;
constexpr size_t WS_RQ = WS_FV + SZ_FOX, WS_RK = WS_RQ + SZ_R, WS_RV = WS_RK + SZ_R, WS_RG = WS_RV + SZ_R;
constexpr size_t WS_GU = WS_RG + SZ_R, WS_GV = WS_GU + SZ_R;
constexpr size_t WS_Y = WS_GV + SZ_R;
constexpr size_t WS_RKV = WS_Y + (size_t)MROWS * DM * 2;
constexpr size_t SZ_RKV = (size_t)16 * 64 * 128 * 128 * 4;
constexpr size_t WS_RSP = WS_RKV + SZ_RKV;
constexpr size_t WS_PART = WS_RSP + SZ_RKV;
constexpr size_t SZ_PART = (size_t)512 * 8 * 66 * 64 * 4;
constexpr size_t WS_XQ = WS_PART + SZ_PART;
constexpr size_t WS_QS = WS_XQ + (size_t)MROWS * DM;
constexpr size_t WS_END = WS_QS + (size_t)MROWS * 4;
static_assert(WS_WGU >= WS_WFZ + (size_t)DEPTH * 8 * DM * 4, "ws map");
static_assert(WS_Y + (size_t)MROWS * DM * 2 >= WS_HID + (size_t)MROWS * DFF * 2, "hid overlay fits");

constexpr int CW_BAR = 4096;
constexpr int CW_FLAGS = 32768;
constexpr int CW_QCNT = 40960;
constexpr int CW_CMAX = 131072;
constexpr int CW_QUEUE = 16384;

constexpr int RING_BYTES = 131072;
constexpr int LDSCTL_OFF = RING_BYTES, MISC_OFF = LDSCTL_OFF + 320;
constexpr int LDS_BYTES = 147456;
constexpr int RSL_OFF = LDSCTL_OFF + 1024;

__device__ __forceinline__ float bf2f(unsigned h) { return __uint_as_float(h << 16); }
__device__ __forceinline__ unsigned f2bf(float f) { unsigned u = __float_as_uint(f); return (u + 0x7fffu + ((u >> 16) & 1u)) >> 16; }
__device__ __forceinline__ unsigned pk2(float lo, float hi) { return f2bf(lo) | (f2bf(hi) << 16); }
__device__ __forceinline__ unsigned cvt_pk_bf16(float lo, float hi) { unsigned r; asm volatile("v_cvt_pk_bf16_f32 %0, %1, %2" : "=v"(r) : "v"(lo), "v"(hi)); return r; }
__device__ __forceinline__ float wave_sum(float v) {
#pragma unroll
    for (int o = 1; o < 64; o <<= 1) v += __shfl_xor(v, o);
    return v;
}
__device__ __forceinline__ float silu_f(float x) { return x * __builtin_amdgcn_rcpf(1.0f + __builtin_amdgcn_exp2f(-1.4426950408889634f * x)); }
__device__ __forceinline__ float gelu_tanh_f(float x) { const float u = (2.0f * 1.4426950408889634f * 0.7978845608028654f) * (x + 0.044715f * x * x * x); return x * __builtin_amdgcn_rcpf(1.0f + __builtin_amdgcn_exp2f(-u)); }
__device__ __forceinline__ float logsig_f(float z) { return fminf(z, 0.f) - log1pf(__expf(-fabsf(z))); }
__device__ __forceinline__ void unpack8(const u32x4 w, float* f) {
    f[0] = __uint_as_float(w.x << 16); f[1] = __uint_as_float(w.x & 0xffff0000u);
    f[2] = __uint_as_float(w.y << 16); f[3] = __uint_as_float(w.y & 0xffff0000u);
    f[4] = __uint_as_float(w.z << 16); f[5] = __uint_as_float(w.z & 0xffff0000u);
    f[6] = __uint_as_float(w.w << 16); f[7] = __uint_as_float(w.w & 0xffff0000u);
}
#define LDS_WAIT() asm volatile("s_waitcnt lgkmcnt(0)" ::: "memory")
#define VM_WAIT() asm volatile("s_waitcnt vmcnt(0)" ::: "memory")

#define XB_TMO      128
#define XB_XCNT(j)  (256  + 64 * (j))
#define XB_XSUB(j)  (1280 + 64 * (j))
#define XB_XGEN(j)  (2304 + 64 * (j))
#define XB_TOP      3328
#define XB_TOPGEN   3392
#define XCD_BAR_WORDS 3456
#define XB_SPIN_CAP (1u << 22)
__device__ __forceinline__ unsigned xb_ld(unsigned* p)              { return __hip_atomic_load(p, __ATOMIC_RELAXED, __HIP_MEMORY_SCOPE_AGENT); }
__device__ __forceinline__ unsigned xb_add(unsigned* p, unsigned v) { return __hip_atomic_fetch_add(p, v, __ATOMIC_RELAXED, __HIP_MEMORY_SCOPE_AGENT); }
__device__ __forceinline__ unsigned xb_xcc_id() { return (unsigned)__builtin_amdgcn_s_getreg((3 << 11) | 20) & 0xFu; }
#define XB_SPIN(cond, bar) do { unsigned _sp = 0; while (cond) { __builtin_amdgcn_s_sleep(1); \
    if ((++_sp & 255u) == 0u) { if (xb_ld(&(bar)[XB_TMO])) break; if (_sp > XB_SPIN_CAP) { atomicAdd(&(bar)[XB_TMO], 1u); break; } } } } while (0)
struct XcdBarrier { unsigned* bar; unsigned x; volatile LAS unsigned* st; };
__device__ __forceinline__ XcdBarrier xcd_barrier_post(unsigned* bar, volatile LAS unsigned* st) {
    XcdBarrier b; b.bar = bar; b.x = xb_xcc_id(); b.st = st;
    if (threadIdx.x == 0) (void)xb_add(&bar[XB_XCNT(b.x)], 1u);
    return b;
}
__device__ __forceinline__ void xcd_barrier_complete(unsigned* bar, unsigned x, unsigned& nloc, unsigned& nx) {
    const unsigned G = gridDim.x * gridDim.y * gridDim.z;
    unsigned sum, cnt, mine, sp = 0u;
    for (;;) {
        sum = 0u; cnt = 0u; mine = 0u;
#pragma unroll
        for (unsigned j = 0; j < 16; ++j) { const unsigned c = xb_ld(&bar[XB_XCNT(j)]); sum += c; cnt += (c > 0u) ? 1u : 0u; mine = (j == x) ? c : mine; }
        if (sum == G) break;
        __builtin_amdgcn_s_sleep(1);
        if ((++sp & 255u) == 0u) { if (xb_ld(&bar[XB_TMO])) break; if (sp > XB_SPIN_CAP) { atomicAdd(&bar[XB_TMO], 1u); break; } }
    }
    nloc = mine > 0u ? mine : 1u; nx = cnt > 0u ? cnt : 1u;
}
__device__ __forceinline__ void xcd_barrier(const XcdBarrier& b) {
    asm volatile("s_waitcnt vmcnt(0)" ::: "memory");
    __syncthreads();
    if (threadIdx.x == 0) {
        unsigned long long zb_ = 0ull; asm volatile("" : "+s"(zb_));
        unsigned* bar = b.bar + zb_; unsigned bx = b.x; asm volatile("" : "+s"(bx));
        __builtin_amdgcn_s_waitcnt(0);
        unsigned nloc = b.st[0], nx = b.st[1];
        if (nloc == 0u) { xcd_barrier_complete(bar, bx, nloc, nx); b.st[0] = nloc; b.st[1] = nx; }
        const unsigned old = xb_add(&bar[XB_XSUB(bx)], 1u);
        const unsigned gen = old / nloc;
        if (old + 1u == (gen + 1u) * nloc) {
            __builtin_amdgcn_fence(__ATOMIC_RELEASE, "agent");
            asm volatile("s_waitcnt vmcnt(0)" ::: "memory");
            const unsigned og = xb_add(&bar[XB_TOP], 1u);
            const unsigned tg = og / nx;
            if (og + 1u == (tg + 1u) * nx) xb_add(&bar[XB_TOPGEN], 1u);
            else XB_SPIN(xb_ld(&bar[XB_TOPGEN]) == tg, bar);
            __builtin_amdgcn_fence(__ATOMIC_ACQUIRE, "agent");
            xb_add(&bar[XB_XGEN(bx)], 1u);
            asm volatile("s_waitcnt vmcnt(0)" ::: "memory");
        } else {
            XB_SPIN(xb_ld(&bar[XB_XGEN(bx)]) == gen, bar);
            __builtin_amdgcn_fence(__ATOMIC_ACQUIRE, "agent");
            asm volatile("s_waitcnt vmcnt(0)" ::: "memory");
        }
    }
    __syncthreads();
}

namespace pg8 {
#define PG8_LAS __attribute__((address_space(3)))
constexpr int BM = 256, BK = 64, HALF = 128, HTB = HALF * BK * 2, STAGE_BYTES = 8 * HTB, NXCD = 8, WGM = 8;
__host__ __device__ __forceinline__ int lds_byte(int r, int c) { const int st = (r >> 4) * 2 + (c >> 5), rr = r & 15, cc = c & 31, ob = rr * 64 + cc * 2; return st * 1024 + (ob ^ (((ob >> 9) & 1) << 5)); }
__host__ __device__ __forceinline__ void stage_rc(int b, int& R, int& C) { const int st = b / 1024, sb = b % 1024, swz = sb ^ (((sb >> 9) & 1) << 5); R = (st >> 1) * 16 + swz / 64; C = (st & 1) * 32 + (swz % 64) / 2; }
__host__ __device__ __forceinline__ int perm32(int rho) { const int n = rho >> 4, i = rho & 15; return 8 * (i >> 2) + 4 * n + (i & 3); }
struct Unit { int pm, pn; };
struct Gemm { const bf16_t* A; const bf16_t* Bt; int M, N, K; };
struct StaticOrder {
    int nM, nN, nwg, G, c;
    __host__ __device__ void init(int M, int N, int G_, int c_) { nM = M / BM; nN = N / BM; nwg = nM * nN; G = G_; c = c_; }
    __host__ __device__ __forceinline__ bool next(int i, Unit& u) const {
        const long L = (long)i * G + c; if (L >= nwg) return false;
        int wgid = (int)L; { const int q = nwg / NXCD, r = nwg % NXCD, xcd = wgid % NXCD, off = wgid / NXCD; wgid = (xcd < r ? xcd * (q + 1) : r * (q + 1) + (xcd - r) * q) + off; }
        const int nig = WGM * nN, gid = wgid / nig, fm = gid * WGM, gsz = (nM - fm) < WGM ? (nM - fm) : WGM;
        u.pm = fm + ((wgid % nig) % gsz); u.pn = (wgid % nig) / gsz; return true;
    }
    __device__ __forceinline__ void a_ready(const Unit&) const {}
    __device__ __forceinline__ void done(const Unit&) const {}
};
__device__ __forceinline__ f32x4 mma1(const bf16x8 a, const bf16x8 b, const f32x4 c) { return __builtin_amdgcn_mfma_f32_16x16x32_bf16(a, b, c, 0, 0, 0); }
__device__ __forceinline__ i32x4 mma1(const i32x4 a, const i32x4 b, const i32x4 c) { return __builtin_amdgcn_mfma_i32_16x16x64_i8(a, b, c, 0, 0, 0); }
template <int V> __device__ __forceinline__ f32x4 mma1v(const bf16x8 a, const bf16x8 b, const f32x4 c) { return mma1(a, b, c); }
template <int V> __device__ __forceinline__ i32x4 mma1v(const i32x4 a, const i32x4 b, const i32x4 c) {
    if constexpr (V == 1) { const f32x4 r = __builtin_amdgcn_mfma_f32_16x16x32_bf16(__builtin_bit_cast(bf16x8, a), __builtin_bit_cast(bf16x8, b), __builtin_bit_cast(f32x4, c), 0, 0, 0); return __builtin_bit_cast(i32x4, r); }
    else return mma1(a, b, c);
}
template <bool I8> struct AccT { typedef f32x4 acc; typedef bf16x8 frag; };
template <> struct AccT<true> { typedef i32x4 acc; typedef i32x4 frag; };
template <class Epi, class Sched, bool ALIGN_EPI = false, bool SP2 = false, bool A_TILED = false, bool I8 = false, int MMAV = 0>
__device__ __forceinline__ void gemm_phase(PG8_LAS unsigned char* lds, const Gemm g, const Sched& S, Epi& E, const int tid) {
    typedef typename AccT<I8>::acc acc_t; typedef typename AccT<I8>::frag frag_t;
    const int wid = __builtin_amdgcn_readfirstlane(tid >> 6), lane = tid & 63, wr = wid >> 2, wc = wid & 3, fr = lane & 15, fq = lane >> 4;
    const int K = g.K, nt = K / BK;
    unsigned voffA[2], voffB[2];
#pragma unroll
    for (int i = 0; i < 2; ++i) { int R, C; stage_rc(tid * 16 + i * 8192, R, C); const int Rb = Epi::PERM ? ((R & ~31) + perm32(R & 31)) : R;
        voffA[i] = A_TILED ? (unsigned)(R * BK + C) * 2u : (unsigned)(R * K + C) * 2u; voffB[i] = (unsigned)(Rb * BK + C) * 2u; }
    const size_t kstep = A_TILED ? (size_t)BM * BK * 2 : (size_t)(BK * 2);
    const size_t hstep = A_TILED ? (size_t)HALF * BK * 2 : (size_t)HALF * K * 2;
    const size_t tstep = (size_t)BM * K * 2;
    const size_t kstepB = (size_t)BM * BK * 2, hstepB = (size_t)HALF * BK * 2;
    const unsigned ldsw = (unsigned)wid * 1024u;
    const int aoff = lds_byte(wr * 64 + fr, fq * 8), boff = lds_byte(wc * 32 + fr, fq * 8);
#define PG8_SA(b, h) (((b) * 2 + (h)) * HTB)
#define PG8_SB(b, h) ((4 + (b) * 2 + (h)) * HTB)
#define PG8_STAGE(bufoff, gbase, voff) do { _Pragma("unroll") for (int _i = 0; _i < 2; ++_i) \
        __builtin_amdgcn_global_load_lds((const unsigned*)((const char*)(gbase) + (voff)[_i]), (PG8_LAS unsigned*)(lds + (bufoff) + ldsw + _i * 8192), 16, 0, 0); } while (0)
#define PG8_LDA(dst, b, h) do { _Pragma("unroll") for (int m = 0; m < 4; ++m) _Pragma("unroll") for (int k = 0; k < 2; ++k) dst[m][k] = *(const PG8_LAS frag_t*)(lds + PG8_SA(b, h) + aoff + m * 2048 + k * 1024); } while (0)
#define PG8_LDB(dst, b, h) do { _Pragma("unroll") for (int n = 0; n < 2; ++n) _Pragma("unroll") for (int k = 0; k < 2; ++k) dst[n][k] = *(const PG8_LAS frag_t*)(lds + PG8_SB(b, h) + boff + n * 2048 + k * 1024); } while (0)
#define PG8_MMA(ai, bj, At, Bt) do { __builtin_amdgcn_s_setprio(1); _Pragma("unroll") for (int m = 0; m < 4; ++m) _Pragma("unroll") for (int n = 0; n < 2; ++n) _Pragma("unroll") for (int k = 0; k < 2; ++k) \
        acc[ai][bj][m][n] = mma1v<MMAV>(Bt[n][k], At[m][k], acc[ai][bj][m][n]); __builtin_amdgcn_s_setprio(0); } while (0)
#define PG8_WAIT_V(n) asm volatile("s_waitcnt vmcnt(" #n ")" ::: "memory")
#define PG8_WAIT_L(n) asm volatile("s_waitcnt lgkmcnt(" #n ")" ::: "memory")
#define PG8_BAR __builtin_amdgcn_s_barrier()
#define PG8_SCHED __builtin_amdgcn_sched_barrier(0)
    Unit cur, nxt; int ui = 0;
    if (!S.next(0, cur)) return;
    acc_t acc[2][2][4][2];
#pragma unroll
    for (int a = 0; a < 2; ++a)
#pragma unroll
        for (int b = 0; b < 2; ++b)
#pragma unroll
            for (int m = 0; m < 4; ++m)
#pragma unroll
                for (int n = 0; n < 2; ++n) acc[a][b][m][n] = acc_t{};
    frag_t At[4][2], B0[2][2], B1[2][2];
    const char* cA = (const char*)g.A + (size_t)cur.pm * tstep; const char* cB = (const char*)g.Bt + (size_t)cur.pn * tstep;
    S.a_ready(cur);
    if constexpr (SP2) {
        PG8_STAGE(PG8_SB(0, 0), cB, voffB); PG8_STAGE(PG8_SB(0, 1), cB + hstepB, voffB); PG8_STAGE(PG8_SA(0, 0), cA, voffA); PG8_STAGE(PG8_SA(0, 1), cA + hstep, voffA);
        if (wr == 1) PG8_BAR;
        PG8_WAIT_V(2); PG8_BAR;
        PG8_STAGE(PG8_SB(1, 0), cB + kstepB, voffB); PG8_STAGE(PG8_SA(1, 0), cA + kstep, voffA); PG8_STAGE(PG8_SB(1, 1), cB + hstepB + kstepB, voffB);
        PG8_WAIT_V(6); PG8_BAR;
    } else {
        PG8_STAGE(PG8_SB(0, 0), cB, voffB); PG8_STAGE(PG8_SA(0, 0), cA, voffA); PG8_STAGE(PG8_SB(0, 1), cB + hstepB, voffB); PG8_STAGE(PG8_SA(0, 1), cA + hstep, voffA);
        if (wr == 1) PG8_BAR;
        PG8_WAIT_V(4); PG8_BAR;
        PG8_STAGE(PG8_SB(1, 0), cB + kstepB, voffB); PG8_STAGE(PG8_SA(1, 0), cA + kstep, voffA); PG8_STAGE(PG8_SB(1, 1), cB + hstepB + kstepB, voffB);
        PG8_WAIT_V(6); PG8_BAR;
    }
    for (;;) {
        const bool has_next = S.next(ui + 1, nxt);
        const char* nA = has_next ? (const char*)g.A + (size_t)nxt.pm * tstep : cA; const char* nB = has_next ? (const char*)g.Bt + (size_t)nxt.pn * tstep : cB;
        for (int t = 0; t < nt; t += 2) {
            const bool last = (t == nt - 2);
            const char* a1 = cA + (size_t)(t + 1) * kstep;
            const char* a2 = last ? nA : cA + (size_t)(t + 2) * kstep; const char* b2 = last ? nB : cB + (size_t)(t + 2) * kstepB;
            const char* a3 = a2 + kstep; const char* b3 = b2 + kstepB;
            if (last && has_next) S.a_ready(nxt);
            if constexpr (SP2) {
            PG8_LDB(B0, 0, 0); PG8_LDB(B1, 0, 1); PG8_SCHED; PG8_LDA(At, 0, 0); PG8_STAGE(PG8_SA(1, 1), a1 + hstep, voffA);
            PG8_WAIT_V(8); PG8_WAIT_L(0); PG8_BAR; PG8_MMA(0, 0, At, B0); PG8_MMA(0, 1, At, B1); PG8_BAR; PG8_SCHED;
            PG8_LDA(At, 0, 1); PG8_STAGE(PG8_SB(0, 0), b2, voffB); PG8_STAGE(PG8_SB(0, 1), b2 + hstepB, voffB); PG8_STAGE(PG8_SA(0, 0), a2, voffA);
            PG8_WAIT_V(8); PG8_WAIT_L(0); PG8_BAR; PG8_MMA(1, 0, At, B0); PG8_MMA(1, 1, At, B1); PG8_BAR; PG8_SCHED;
            PG8_LDB(B0, 1, 0); PG8_LDB(B1, 1, 1); PG8_SCHED; PG8_LDA(At, 1, 0); PG8_STAGE(PG8_SA(0, 1), a2 + hstep, voffA);
            PG8_WAIT_V(8); PG8_WAIT_L(0); PG8_BAR; PG8_MMA(0, 0, At, B0); PG8_MMA(0, 1, At, B1); PG8_BAR; PG8_SCHED;
            PG8_LDA(At, 1, 1); PG8_STAGE(PG8_SB(1, 0), b3, voffB); PG8_STAGE(PG8_SB(1, 1), b3 + hstepB, voffB); PG8_STAGE(PG8_SA(1, 0), a3, voffA);
            PG8_WAIT_V(8); PG8_WAIT_L(0); PG8_BAR; PG8_MMA(1, 0, At, B0); PG8_MMA(1, 1, At, B1); PG8_BAR; PG8_SCHED;
            } else {
            PG8_LDB(B0, 0, 0); PG8_SCHED; PG8_LDA(At, 0, 0); PG8_STAGE(PG8_SA(1, 1), a1 + hstep, voffA);
            PG8_WAIT_L(8); PG8_BAR; PG8_WAIT_L(0); PG8_MMA(0, 0, At, B0); PG8_BAR; PG8_SCHED;
            PG8_LDB(B1, 0, 1); PG8_STAGE(PG8_SB(0, 0), b2, voffB);
            PG8_BAR; PG8_WAIT_L(0); PG8_MMA(0, 1, At, B1); PG8_BAR;
            PG8_LDA(At, 0, 1); PG8_STAGE(PG8_SA(0, 0), a2, voffA);
            PG8_BAR; PG8_WAIT_L(0); PG8_MMA(1, 0, At, B0); PG8_BAR; PG8_SCHED;
            PG8_STAGE(PG8_SB(0, 1), b2 + hstepB, voffB);
            PG8_WAIT_V(6); PG8_BAR; PG8_MMA(1, 1, At, B1); PG8_BAR;
            PG8_LDB(B0, 1, 0); PG8_SCHED; PG8_LDA(At, 1, 0); PG8_STAGE(PG8_SA(0, 1), a2 + hstep, voffA);
            PG8_WAIT_L(8); PG8_BAR; PG8_WAIT_L(0); PG8_MMA(0, 0, At, B0); PG8_BAR; PG8_SCHED;
            PG8_LDB(B1, 1, 1); PG8_STAGE(PG8_SB(1, 0), b3, voffB);
            PG8_BAR; PG8_WAIT_L(0); PG8_MMA(0, 1, At, B1); PG8_BAR;
            PG8_LDA(At, 1, 1); PG8_STAGE(PG8_SA(1, 0), a3, voffA);
            PG8_BAR; PG8_WAIT_L(0); PG8_MMA(1, 0, At, B0); PG8_BAR; PG8_SCHED;
            PG8_STAGE(PG8_SB(1, 1), b3 + hstepB, voffB);
            PG8_WAIT_V(6); PG8_BAR; PG8_MMA(1, 1, At, B1); PG8_BAR;
            }
        }
        if constexpr (ALIGN_EPI) { if (wr == 0) PG8_BAR; }
        E(acc, cur, wr, wc, fr, fq, tid); S.done(cur);
        if (!has_next) break;
#pragma unroll
        for (int a = 0; a < 2; ++a)
#pragma unroll
            for (int b = 0; b < 2; ++b)
#pragma unroll
                for (int m = 0; m < 4; ++m)
#pragma unroll
                    for (int n = 0; n < 2; ++n) acc[a][b][m][n] = acc_t{};
        cur = nxt; cA = nA; cB = nB; ++ui;
        if constexpr (ALIGN_EPI) { if (wr == 1) PG8_BAR; }
    }
    PG8_WAIT_V(0);
    if constexpr (!ALIGN_EPI) { if (wr == 0) PG8_BAR; }
    PG8_BAR;
#undef PG8_SA
#undef PG8_SB
#undef PG8_STAGE
#undef PG8_LDA
#undef PG8_LDB
#undef PG8_MMA
#undef PG8_WAIT_V
#undef PG8_WAIT_L
#undef PG8_BAR
#undef PG8_SCHED
}
}

__device__ __forceinline__ float row_rstd(const float* ssq, int row, int fq) {
    const f32x4* p = (const f32x4*)(ssq + (size_t)row * 32 + fq * 8);
    const f32x4 a = p[0], b = p[1];
    float s = ((a.x + a.y) + (a.z + a.w)) + ((b.x + b.y) + (b.z + b.w));
    s += __shfl_xor(s, 16); s += __shfl_xor(s, 32);
    return rsqrtf(s * (1.0f / DM) + EPS);
}
__device__ __forceinline__ void stage_rstd(const float* ssq, int pm, LAS float* rsl, int tid) {
    const int r = tid >> 1, hs = tid & 1;
    const f32x4* p = (const f32x4*)(ssq + (size_t)(pm * 256 + r) * 32 + hs * 16);
    const f32x4 a = p[0], b = p[1], c = p[2], d = p[3];
    float s = (((a.x + a.y) + (a.z + a.w)) + ((b.x + b.y) + (b.z + b.w))) + (((c.x + c.y) + (c.z + c.w)) + ((d.x + d.y) + (d.z + d.w)));
    s += __shfl_xor(s, 1);
    if (hs == 0) rsl[r] = rsqrtf(s * (1.0f / DM) + EPS);
    asm volatile("s_waitcnt lgkmcnt(0)" ::: "memory"); __builtin_amdgcn_s_barrier(); asm volatile("" ::: "memory");
}
__device__ __forceinline__ u32x4 pack8bf(const f32x4 a, const f32x4 b) {
    u32x4 w; w.x = cvt_pk_bf16(a[0], a[1]); w.y = cvt_pk_bf16(a[2], a[3]); w.z = cvt_pk_bf16(b[0], b[1]); w.w = cvt_pk_bf16(b[2], b[3]); return w;
}
struct EpiSwiGLU {
    static constexpr bool PERM = true, AFTER_DRAIN = false;
    bf16_t* H; const float* ssq; LAS float* rsl; int cur_pm; int skip;
    __device__ __forceinline__ void operator()(const f32x4 (&acc)[2][2][4][2], const pg8::Unit& u, int wr, int wc, int fr_, int fq_, int tid) {
        int fr = fr_, fq = fq_; asm volatile("" : "+v"(fr), "+v"(fq));
        if (skip) return;
        const int row0 = u.pm * 256 + wr * 64 + fr, col0 = u.pn * 128 + wc * 32 + 8 * fq;
        if (u.pm != cur_pm) { stage_rstd(ssq, u.pm, rsl, tid); cur_pm = u.pm; }
#pragma unroll
        for (int ai = 0; ai < 2; ++ai)
#pragma unroll
            for (int m = 0; m < 4; ++m) {
                const int row = row0 + ai * 128 + m * 16;
                const float rs = rsl[wr * 64 + fr + ai * 128 + m * 16];
                f32x4 h[2];
#pragma unroll
                for (int n = 0; n < 2; ++n) { const f32x4 g = acc[ai][0][m][n] * rs, up = acc[ai][1][m][n] * rs;
#pragma unroll
                    for (int i = 0; i < 4; ++i) h[n][i] = silu_f(g[i]) * up[i]; }
                *(u32x4*)(H + ((size_t)(u.pm * (DFF / 64) + (col0 >> 6)) * 256 + (size_t)(row & 255)) * 64 + (col0 & 63)) = pack8bf(h[0], h[1]);
            }
    }
};
__device__ __forceinline__ unsigned pack4q(unsigned b0, unsigned b1, unsigned b2, unsigned b3) {
    return __builtin_amdgcn_perm(b1, b0, 0x0c0c0400u) | __builtin_amdgcn_perm(b3, b2, 0x04000c0cu);
}
constexpr float QMAGIC = 12582912.0f;
struct EpiSwiGLUq {
    static constexpr bool PERM = true, AFTER_DRAIN = false;
    bf16_t* H; const float* cmax; LAS float* rsl; int skip;
    __device__ __forceinline__ void operator()(const i32x4 (&acc)[2][2][4][2], const pg8::Unit& u, int wr, int wc, int fr_, int fq_, int tid) {
        int fr = fr_, fq = fq_; asm volatile("" : "+v"(fr), "+v"(fq));
        if (skip) return;
        const int row0 = u.pm * 256 + wr * 64 + fr, col0 = u.pn * 128 + wc * 32 + 8 * fq;
        const float* cp = cmax + u.pn * 256 + wc * 32 + 8 * fq;
        f32x4 cs[2][2];
        cs[0][0] = *(const f32x4*)(cp) * (1.0f / 127.0f); cs[0][1] = *(const f32x4*)(cp + 4) * (1.0f / 127.0f);
        cs[1][0] = *(const f32x4*)(cp + 128) * (1.0f / 127.0f); cs[1][1] = *(const f32x4*)(cp + 132) * (1.0f / 127.0f);
#pragma unroll
        for (int ai = 0; ai < 2; ++ai)
#pragma unroll
            for (int m = 0; m < 4; ++m) {
                const int row = row0 + ai * 128 + m * 16;
                const float rs = rsl[wr * 64 + fr + ai * 128 + m * 16];
                f32x4 h[2];
#pragma unroll
                for (int n = 0; n < 2; ++n) {
#pragma unroll
                    for (int i = 0; i < 4; ++i) { const float g = (float)acc[ai][0][m][n][i] * (rs * cs[0][n][i]), up = (float)acc[ai][1][m][n][i] * (rs * cs[1][n][i]); h[n][i] = silu_f(g) * up; } }
                *(u32x4*)(H + ((size_t)(u.pm * (DFF / 64) + (col0 >> 6)) * 256 + (size_t)(row & 255)) * 64 + (col0 & 63)) = pack8bf(h[0], h[1]);
            }
    }
};
__device__ __forceinline__ void quant_rows(const bf16_t* xb, unsigned char* xq, float* qs, const float* ssq, unsigned* cnt, int pm, int quarter, LAS float* rsl, int tid_) {
    int tid = tid_; asm volatile("" : "+v"(tid));
    const int wave = __builtin_amdgcn_readfirstlane(tid >> 6), lane = tid & 63;
#pragma unroll 1
    for (int trip = 0; trip < 2; ++trip) {
        const int rbase = pm * 256 + quarter * 64 + wave * 8 + trip * 4;
        u32x4 v[4][4];
#pragma unroll
        for (int q = 0; q < 4; ++q)
#pragma unroll
            for (int j = 0; j < 4; ++j) v[q][j] = *(const u32x4*)(xb + (size_t)(rbase + q) * DM + (j * 64 + lane) * 8);
#pragma unroll
        for (int q = 0; q < 4; ++q) {
            unsigned mx = 0u;
#pragma unroll
            for (int j = 0; j < 4; ++j)
#pragma unroll
                for (int e = 0; e < 4; ++e) { const unsigned w = v[q][j][e]; mx = max(mx, max(w & 0x7fffu, (w >> 16) & 0x7fffu)); }
#pragma unroll
            for (int o = 1; o < 64; o <<= 1) mx = max(mx, (unsigned)__shfl_xor((int)mx, o));
            const float amax = __uint_as_float(mx << 16);
            const float inv = mx ? 127.0f / amax : 0.f;
#pragma unroll
            for (int j = 0; j < 4; ++j) { float f[8]; unpack8(v[q][j], f); unsigned b[8];
#pragma unroll
                for (int e = 0; e < 8; ++e) b[e] = __float_as_uint(__builtin_fmaf(f[e], inv, QMAGIC));
                u32x2 o; o.x = pack4q(b[0], b[1], b[2], b[3]); o.y = pack4q(b[4], b[5], b[6], b[7]);
                *(u32x2*)(xq + (size_t)(rbase + q) * DM + (j * 64 + lane) * 8) = o; }
            if (lane == 0) qs[rbase + q] = amax * (1.0f / 127.0f);
        }
    }
    __builtin_amdgcn_fence(__ATOMIC_RELEASE, "agent");
    asm volatile("s_waitcnt vmcnt(0)" ::: "memory");
    __syncthreads();
    if (tid == 0) {
        __hip_atomic_fetch_add(cnt, 1u, __ATOMIC_RELEASE, __HIP_MEMORY_SCOPE_AGENT);
        unsigned spins = 0;
        while (__hip_atomic_load(cnt, __ATOMIC_RELAXED, __HIP_MEMORY_SCOPE_AGENT) < 4u) { __builtin_amdgcn_s_sleep(2); if (++spins > (1u << 22)) break; }
        __builtin_amdgcn_fence(__ATOMIC_ACQUIRE, "agent");
        asm volatile("s_waitcnt vmcnt(0)" ::: "memory");
    }
    __syncthreads();
    {
        const int r = tid >> 1, hs = tid & 1;
        const f32x4* p = (const f32x4*)(ssq + (size_t)(pm * 256 + r) * 32 + hs * 16);
        const f32x4 a = p[0], b = p[1], c = p[2], d = p[3];
        const float sc = qs[pm * 256 + r];
        float s = (((a.x + a.y) + (a.z + a.w)) + ((b.x + b.y) + (b.z + b.w))) + (((c.x + c.y) + (c.z + c.w)) + ((d.x + d.y) + (d.z + d.w)));
        s += __shfl_xor(s, 1);
        if (hs == 0) rsl[r] = rsqrtf(s * (1.0f / DM) + EPS) * sc;
        asm volatile("s_waitcnt lgkmcnt(0)" ::: "memory"); __builtin_amdgcn_s_barrier(); asm volatile("" ::: "memory");
    }
}
struct EpiResid {
    static constexpr bool PERM = true, AFTER_DRAIN = false;
    const float* xin32; bf16_t* xb; float* ssq; float alpha; int skip;
    __device__ __forceinline__ void operator()(const f32x4 (&acc)[2][2][4][2], const pg8::Unit& u, int wr, int wc, int fr_, int fq_, int tid) {
        int fr = fr_, fq = fq_; asm volatile("" : "+v"(fr), "+v"(fq));
        if (skip) return;
        const int row0 = u.pm * 256 + wr * 64 + fr, col0 = u.pn * 256 + wc * 32 + 8 * fq;
        const size_t base = (size_t)row0 * DM + col0;
        f32x4 cur[4], nxt[4];
#define ER_LD(dst, g) do { const size_t o_ = base + (size_t)((((g) >> 2) * 128 + ((g) & 3) * 16)) * DM; \
            if (xin32) { const float* p_ = xin32 + o_; dst[0] = *(const f32x4*)(p_); dst[1] = *(const f32x4*)(p_ + 4); dst[2] = *(const f32x4*)(p_ + 128); dst[3] = *(const f32x4*)(p_ + 132); } \
            else { const u32x4 w0 = *(const u32x4*)(xb + o_), w1 = *(const u32x4*)(xb + o_ + 128); float f_[8]; unpack8(w0, f_); dst[0] = (f32x4){f_[0], f_[1], f_[2], f_[3]}; dst[1] = (f32x4){f_[4], f_[5], f_[6], f_[7]}; \
                   unpack8(w1, f_); dst[2] = (f32x4){f_[0], f_[1], f_[2], f_[3]}; dst[3] = (f32x4){f_[4], f_[5], f_[6], f_[7]}; } } while (0)
        ER_LD(cur, 0);
#pragma unroll
        for (int g = 0; g < 8; ++g) {
            const int ai = g >> 2, m = g & 3;
            if (g < 7) ER_LD(nxt, g + 1);
            const size_t off = base + (size_t)(ai * 128 + m * 16) * DM; float s = 0.f;
#pragma unroll
            for (int bj = 0; bj < 2; ++bj) {
                const f32x4 n0 = cur[2 * bj] + acc[ai][bj][m][0] * alpha, n1 = cur[2 * bj + 1] + acc[ai][bj][m][1] * alpha;
                const u32x4 w = pack8bf(n0, n1);
                *(u32x4*)(xb + off + bj * 128) = w;
                float q[8]; unpack8(w, q);
                s += ((q[0] * q[0] + q[1] * q[1]) + (q[2] * q[2] + q[3] * q[3])) + ((q[4] * q[4] + q[5] * q[5]) + (q[6] * q[6] + q[7] * q[7]));
            }
            s += __shfl_xor(s, 16); s += __shfl_xor(s, 32);
            if (fq == 0) ssq[(size_t)(row0 + ai * 128 + m * 16) * 32 + u.pn * 4 + wc] = s;
#pragma unroll
            for (int j = 0; j < 4; ++j) cur[j] = nxt[j];
        }
#undef ER_LD
    }
};
struct EpiWin {
    static constexpr bool PERM = true, AFTER_DRAIN = false;
    const float* ssq; LAS float* rsl; const float* __restrict__ ropec; const float* __restrict__ ropes;
    bf16_t *FQ, *RQ; int cur_pm;
    float* norms4;
    __device__ __forceinline__ void operator()(const f32x4 (&acc)[2][2][4][2], const pg8::Unit& u, int wr, int wc, int fr_, int fq_, int tid) {
        int fr = fr_, fq = fq_; asm volatile("" : "+v"(fr), "+v"(fq));
        const int pn = u.pn, b = u.pm >> 4, s0 = (u.pm & 15) * 256 + wr * 64 + fr, rl0 = wr * 64 + fr;
        if (u.pm != cur_pm) { stage_rstd(ssq, u.pm, rsl, tid); cur_pm = u.pm; }
        if (pn < 12) {
            const int t = pn >> 2; bf16_t* base = FQ + (size_t)t * (SZ_FOX / 2);
            float mx[2][2] = {{0.f, 0.f}, {0.f, 0.f}};
#pragma unroll
            for (int ai = 0; ai < 2; ++ai)
#pragma unroll
                for (int m = 0; m < 4; ++m) {
                    const int s = s0 + ai * 128 + m * 16; const float rs = rsl[rl0 + ai * 128 + m * 16];
#pragma unroll
                    for (int bj = 0; bj < 2; ++bj) { const int head = 2 * (pn & 3) + bj;
                        const u32x4 w = pack8bf(acc[ai][bj][m][0] * rs, acc[ai][bj][m][1] * rs);
                        *(u32x4*)(base + ((size_t)(b * FOXH + head) * SEQ + s) * HD + wc * 32 + 8 * fq) = w;
                        if (t < 2) { float f[8]; unpack8(w, f);
                            float ss = ((f[0] * f[0] + f[1] * f[1]) + (f[2] * f[2] + f[3] * f[3])) + ((f[4] * f[4] + f[5] * f[5]) + (f[6] * f[6] + f[7] * f[7]));
                            ss += __shfl_xor(ss, 16); ss += __shfl_xor(ss, 32); mx[ai][bj] = fmaxf(mx[ai][bj], ss); } }
                }
            if (t < 2) {
#pragma unroll
                for (int ai = 0; ai < 2; ++ai)
#pragma unroll
                    for (int bj = 0; bj < 2; ++bj) { float v = mx[ai][bj];
                        v = fmaxf(v, __shfl_xor(v, 1)); v = fmaxf(v, __shfl_xor(v, 2)); v = fmaxf(v, __shfl_xor(v, 4)); v = fmaxf(v, __shfl_xor(v, 8));
                        if (fr == 0 && fq == 0) norms4[((((1 - t) * 32 + b * FOXH + 2 * (pn & 3) + bj) * 64 + (((u.pm & 15) * 4 + 2 * ai + wr))) << 2) + wc] = v; }
            }
        } else if (pn < 16) {
            const int seg = (pn - 12) >> 1, hh = 2 * ((pn - 12) & 1) + (wc >> 1), dp = 32 * (wc & 1) + 8 * fq;
            bf16_t* base = RQ + (size_t)seg * (SZ_R / 2); const float ksc = seg ? 0.08838834764831845f : 1.0f;
#pragma unroll
            for (int ai = 0; ai < 2; ++ai)
#pragma unroll
                for (int m = 0; m < 4; ++m) {
                    const int s = s0 + ai * 128 + m * 16; const float rs = rsl[rl0 + ai * 128 + m * 16] * ksc;
                    const f32x4 c0 = *(const f32x4*)(ropec + (size_t)s * 64 + dp), c1 = *(const f32x4*)(ropec + (size_t)s * 64 + dp + 4);
                    const f32x4 n0 = *(const f32x4*)(ropes + (size_t)s * 64 + dp), n1 = *(const f32x4*)(ropes + (size_t)s * 64 + dp + 4);
                    const f32x4 a0 = acc[ai][0][m][0] * rs, a1 = acc[ai][0][m][1] * rs, b0 = acc[ai][1][m][0] * rs, b1 = acc[ai][1][m][1] * rs;
                    bf16_t* dst = base + ((size_t)(b * RETH + hh) * SEQ + s) * HD + dp;
                    *(u32x4*)(dst) = pack8bf(a0 * c0 - b0 * n0, a1 * c1 - b1 * n1);
                    *(u32x4*)(dst + 64) = pack8bf(a0 * n0 + b0 * c0, a1 * n1 + b1 * c1);
                    if (m & 1) asm volatile("" ::: "memory");
                }
        } else {
            const int idx = pn - 16, kind = idx >> 1;
            bf16_t* base = RQ + (size_t)(2 + kind) * (SZ_R / 2);
#pragma unroll
            for (int ai = 0; ai < 2; ++ai)
#pragma unroll
                for (int m = 0; m < 4; ++m) {
                    const int s = s0 + ai * 128 + m * 16; const float rs = rsl[rl0 + ai * 128 + m * 16];
#pragma unroll
                    for (int bj = 0; bj < 2; ++bj) { const int head = 2 * (idx & 1) + bj;
                        f32x4 v0 = acc[ai][bj][m][0] * rs, v1 = acc[ai][bj][m][1] * rs;
                        if (kind == 1) {
#pragma unroll
                            for (int i = 0; i < 4; ++i) { v0[i] = silu_f(v0[i]); v1[i] = silu_f(v1[i]); } }
                        if (kind >= 2) {
#pragma unroll
                            for (int i = 0; i < 4; ++i) { v0[i] = gelu_tanh_f(v0[i]); v1[i] = gelu_tanh_f(v1[i]); } }
                        *(u32x4*)(base + ((size_t)(b * RETH + head) * SEQ + s) * HD + wc * 32 + 8 * fq) = pack8bf(v0, v1); }
                }
        }
    }
};

struct Args {
    const float* in[19]; float* out; unsigned char* ws;
    int l_lo, l_hi, ph_lo, ph_hi;
    int use_bar, pad;
};

__device__ __forceinline__ void tr_item(const float* W, int ldw, int src_col0, int k0, const float* gain, bf16_t* WT, int K, int dst_row0, LAS float* scr, int lane) {
    float v[32];
    const float* wp = W + (size_t)(k0 + (lane >> 5)) * ldw + src_col0 + (lane & 31);
#pragma unroll
    for (int i = 0; i < 32; ++i) v[i] = wp[(size_t)(2 * i) * ldw];
    if (gain) {
#pragma unroll
        for (int i = 0; i < 32; ++i) v[i] *= gain[k0 + 2 * i + (lane >> 5)]; }
#pragma unroll
    for (int i = 0; i < 32; ++i) scr[(2 * i + (lane >> 5)) * 33 + (lane & 31)] = v[i];
    LDS_WAIT(); asm volatile("" ::: "memory");
    const int c = lane & 7;
#pragma unroll
    for (int j = 0; j < 4; ++j) { const int n = (lane >> 3) + 8 * j; const LAS float* s = scr + (8 * c) * 33 + n;
        u32x4 o; o.x = pk2(s[0 * 33], s[1 * 33]); o.y = pk2(s[2 * 33], s[3 * 33]); o.z = pk2(s[4 * 33], s[5 * 33]); o.w = pk2(s[6 * 33], s[7 * 33]);
        const int nn = dst_row0 + n;
        *(u32x4*)(WT + ((size_t)(nn >> 8) * (K >> 6) + (k0 >> 6)) * (256 * 64) + (size_t)(nn & 255) * 64 + 8 * c) = o; }
    LDS_WAIT(); asm volatile("" ::: "memory");
}
__device__ __forceinline__ void tr_item_q(const float* W, int ldw, int src_col0, int k0, const float* gain, unsigned char* WT, int K, int dst_row0, const unsigned* cmax, LAS float* scr, int lane) {
    float v[32];
    const float* wp = W + (size_t)(k0 + (lane >> 5)) * ldw + src_col0 + (lane & 31);
#pragma unroll
    for (int i = 0; i < 32; ++i) v[i] = wp[(size_t)(2 * i) * ldw];
    const float cm = __uint_as_float(cmax[dst_row0 + (lane & 31)]);
    const float inv = cm > 0.f ? 127.0f / cm : 0.f;
#pragma unroll
    for (int i = 0; i < 32; ++i) v[i] = __builtin_fmaf(v[i] * gain[k0 + 2 * i + (lane >> 5)], inv, QMAGIC);
#pragma unroll
    for (int i = 0; i < 32; ++i) scr[(2 * i + (lane >> 5)) * 33 + (lane & 31)] = v[i];
    LDS_WAIT(); asm volatile("" ::: "memory");
    const int c = lane & 7;
#pragma unroll
    for (int j = 0; j < 4; ++j) { const int n = (lane >> 3) + 8 * j; const LAS unsigned* sq = (const LAS unsigned*)scr + (8 * c) * 33 + n;
        u32x2 o; o.x = pack4q(sq[0 * 33], sq[1 * 33], sq[2 * 33], sq[3 * 33]); o.y = pack4q(sq[4 * 33], sq[5 * 33], sq[6 * 33], sq[7 * 33]);
        const int nn = dst_row0 + n;
        *(u32x2*)(WT + ((size_t)(nn >> 8) * (K >> 7) + (k0 >> 7)) * (256 * 128) + (size_t)(nn & 255) * 128 + (k0 & 127) + 8 * c) = o; }
    LDS_WAIT(); asm volatile("" ::: "memory");
}
__device__ __forceinline__ void prologue_cmax(const Args& a, unsigned char* ws, int gw, int ngw, int lane) {
    unsigned* cmax = (unsigned*)(ws + WS_CTL) + CW_CMAX;
    for (int it = gw; it < DEPTH * 4 * (DFF / 256) * (DM / 128); it += ngw) {
        const int kc = it & 15, r = it >> 4, cs = r % (DFF / 256), mi = r / (DFF / 256), l = mi >> 2, which = mi & 3, f = which >> 1, isup = which & 1;
        const float* W = a.in[f ? (isup ? 16 : 15) : (isup ? 3 : 2)] + (size_t)l * DM * DFF + (size_t)(128 * kc) * DFF + 256 * cs + 4 * lane;
        const float* gain = a.in[f ? 14 : 1] + (size_t)l * DM + 128 * kc;
        f32x4 mx = (f32x4){0.f, 0.f, 0.f, 0.f};
#pragma unroll 1
        for (int k0 = 0; k0 < 128; k0 += 16) {
            f32x4 v[16];
#pragma unroll
            for (int i = 0; i < 16; ++i) v[i] = *(const f32x4*)(W + (size_t)(k0 + i) * DFF);
#pragma unroll
            for (int i = 0; i < 16; ++i) { const float g = fabsf(gain[k0 + i]);
#pragma unroll
                for (int e = 0; e < 4; ++e) mx[e] = fmaxf(mx[e], fabsf(v[i][e] * g)); }
        }
        const int n = 256 * cs + 4 * lane;
        unsigned* dst = cmax + (size_t)(l * 2 + f) * NGU + 256 * (n >> 7) + (n & 127) + 128 * isup;
#pragma unroll
        for (int e = 0; e < 4; ++e) __hip_atomic_fetch_max(dst + e, __float_as_uint(mx[e]), __ATOMIC_RELAXED, __HIP_MEMORY_SCOPE_AGENT);
    }
}
__device__ __forceinline__ void prologue_wgu(const Args& a, unsigned char* ws, LAS unsigned char* lds, int blk, int G, int tid_) {
    int tid = tid_; asm volatile("" : "+v"(tid));
    const int wave = __builtin_amdgcn_readfirstlane(tid >> 6), lane = tid & 63, c = lane & 31, p = lane >> 5;
    LAS unsigned* T = (LAS unsigned*)lds;
    LAS float* red = (LAS float*)(lds + RSL_OFF);
    LAS float* cinv = (LAS float*)(lds + LDSCTL_OFF + 2048);
    float* cmaxg = (float*)((unsigned*)(ws + WS_CTL) + CW_CMAX);
    for (int it = blk; it < DEPTH * 4 * (DFF / 32); it += G) {
        const int nb = it % (DFF / 32), mi = it / (DFF / 32), l = mi >> 2, which = mi & 3, f = which >> 1, isup = which & 1, n0 = 32 * nb;
        const float* W = a.in[f ? (isup ? 16 : 15) : (isup ? 3 : 2)] + (size_t)l * DM * DFF + n0 + c;
        const float* gain = a.in[f ? 14 : 1] + (size_t)l * DM;
        float mx = 0.f;
#pragma unroll 1
        for (int bt = 0; bt < 4; ++bt) {
            const int kb = 256 * wave + 64 * bt + 2 * p;
            float v0[16], v1[16]; f32x2 gg[16];
#pragma unroll
            for (int j = 0; j < 16; ++j) { const float* wp = W + (size_t)(kb + 4 * j) * DFF; v0[j] = wp[0]; v1[j] = wp[DFF]; gg[j] = *(const f32x2*)(gain + kb + 4 * j); }
#pragma unroll
            for (int j = 0; j < 16; ++j) { const int k = kb + 4 * j; const float p0 = v0[j] * gg[j].x, p1 = v1[j] * gg[j].y;
                const unsigned w = cvt_pk_bf16(p0, p1);
                mx = fmaxf(mx, fmaxf(fabsf(p0), fabsf(p1)));
                const int kp = k >> 1;
                T[kp * 32 + (c ^ (((kp >> 3) & 7) << 2))] = w; }
        }
        mx = fmaxf(mx, __shfl_xor(mx, 32));
        if (p == 0) red[wave * 32 + c] = mx;
        LDS_WAIT(); __syncthreads();
        if (tid < 32) { float m = red[tid];
#pragma unroll
            for (int w8 = 1; w8 < 8; ++w8) m = fmaxf(m, red[w8 * 32 + tid]);
            cinv[tid] = m > 0.f ? 127.0f / m : 0.f;
            cmaxg[(size_t)(l * 2 + f) * NGU + 256 * (n0 >> 7) + (n0 & 127) + 128 * isup + tid] = m; }
        LDS_WAIT(); __syncthreads();
        {
            const int cq = lane >> 3, chunk = lane & 7, cc = 8 * (wave & 3) + cq;
            const float inv = cinv[cc];
            const int nn = 256 * (n0 >> 7) + (n0 & 127) + 128 * isup + cc;
            unsigned char* WT = ws + WS_WGU + (size_t)(l * 2 + f) * SZ_WGU + ((size_t)(nn >> 8) * 16) * 32768 + (size_t)(nn & 255) * 128 + 16 * chunk;
#pragma unroll
            for (int i = 0; i < 8; ++i) { const int kt = (wave >> 2) * 8 + i; unsigned b[16];
#pragma unroll
                for (int t = 0; t < 8; ++t) { const int kp = 64 * kt + 8 * chunk + t; const unsigned w = T[kp * 32 + (cc ^ (((kp >> 3) & 7) << 2))];
                    b[2 * t] = __float_as_uint(__builtin_fmaf(__uint_as_float(w << 16), inv, QMAGIC)); b[2 * t + 1] = __float_as_uint(__builtin_fmaf(__uint_as_float(w & 0xffff0000u), inv, QMAGIC)); }
                u32x4 o; o.x = pack4q(b[0], b[1], b[2], b[3]); o.y = pack4q(b[4], b[5], b[6], b[7]); o.z = pack4q(b[8], b[9], b[10], b[11]); o.w = pack4q(b[12], b[13], b[14], b[15]);
                *(u32x4*)(WT + (size_t)kt * 32768) = o; }
        }
        LDS_WAIT(); __syncthreads();
    }
}
constexpr int IT_GU = (DM / 64) * (DFF / 32);
constexpr int IT_D = (DFF / 64) * (DM / 32);
constexpr int IT_WIN = (DM / 64) * (NWIN / 32);
constexpr int IT_WOUT = (DM / 64) * (DM / 32);
constexpr int IT_LAYER = 2 * IT_D + IT_WIN + IT_WOUT;
__device__ __forceinline__ int win_src_col(int db) {
    const int t = db >> 3, bb = db & 7, bj = bb >> 2, j0 = 32 * (bb & 3);
    if (t < 12) return 32 * db;
    if (t < 16) { const int seg = (t - 12) >> 1, ts = (t - 12) & 1, hh = 2 * ts + (j0 >> 6), d = 64 * bj + (j0 & 63); return 3080 + seg * 512 + hh * 128 + d; }
    return 8 + 32 * db;
}
__device__ __forceinline__ void prologue(const Args& a, unsigned char* ws, LAS unsigned char* lds, int gw, int ngw, int wave, int lane) {
    LAS float* scr = (LAS float*)(lds + wave * 16384);
    for (int it = gw; it < DEPTH * IT_LAYER; it += ngw) {
        const int l = it / IT_LAYER; int r = it - l * IT_LAYER;
        if (r < 2 * IT_D) {
            const int f = r / IT_D; r -= f * IT_D;
            const float* W = a.in[f ? 17 : 4] + (size_t)l * DFF * DM;
            const int kb = r / (DM / 32), nb = r % (DM / 32);
            bf16_t* WT = (bf16_t*)(ws + WS_WD + (size_t)(l * 2 + f) * SZ_WD);
            tr_item(W, DM, 32 * nb, 64 * kb, nullptr, WT, DFF, 32 * nb, scr, lane);
        } else if (r < 2 * IT_D + IT_WIN) {
            r -= 2 * IT_D;
            const float* W = a.in[6] + (size_t)l * DM * INCOLS; const float* gain = a.in[5] + (size_t)l * DM;
            const int kb = r / (NWIN / 32), db = r % (NWIN / 32);
            bf16_t* WT = (bf16_t*)(ws + WS_WIN + (size_t)l * SZ_WIN);
            tr_item(W, INCOLS, win_src_col(db), 64 * kb, gain, WT, DM, 32 * db, scr, lane);
        } else {
            r -= 2 * IT_D + IT_WIN;
            const float* W = a.in[13] + (size_t)l * DM * DM; const float* gain = a.in[12] + (size_t)l * DM;
            const int kb = r / (DM / 32), nb = r % (DM / 32);
            bf16_t* WT = (bf16_t*)(ws + WS_WOUT + (size_t)l * SZ_WOUT);
            tr_item(W, DM, 32 * nb, 64 * kb, gain, WT, DM, 32 * nb, scr, lane);
        }
    }
    {
        const float* x = a.in[0]; bf16_t* xb = (bf16_t*)(ws + WS_XB); float* ssq = (float*)(ws + WS_SSQ);
        for (int m = gw; m < MROWS; m += 2 * ngw) {
            const int m2 = m + ngw; const bool has2 = m2 < MROWS;
            const f32x4* xr0 = (const f32x4*)(x + (size_t)m * DM); const f32x4* xr1 = (const f32x4*)(x + (size_t)(has2 ? m2 : m) * DM);
            f32x4 v[2][8];
#pragma unroll
            for (int j = 0; j < 4; ++j) { v[0][2 * j] = xr0[(j * 64 + lane) * 2]; v[0][2 * j + 1] = xr0[(j * 64 + lane) * 2 + 1]; v[1][2 * j] = xr1[(j * 64 + lane) * 2]; v[1][2 * j + 1] = xr1[(j * 64 + lane) * 2 + 1]; }
#pragma unroll
            for (int q = 0; q < 2; ++q) { if (q == 1 && !has2) break; const int mm = q ? m2 : m; float s = 0.f;
#pragma unroll
                for (int j = 0; j < 4; ++j) { const f32x4 v0 = v[q][2 * j], v1 = v[q][2 * j + 1];
                    s += (v0[0] * v0[0] + v0[1] * v0[1]) + (v0[2] * v0[2] + v0[3] * v0[3]) + (v1[0] * v1[0] + v1[1] * v1[1]) + (v1[2] * v1[2] + v1[3] * v1[3]);
                    u32x4 w; w.x = pk2(v0[0], v0[1]); w.y = pk2(v0[2], v0[3]); w.z = pk2(v1[0], v1[1]); w.w = pk2(v1[2], v1[3]);
                    *(u32x4*)(xb + (size_t)mm * DM + (j * 64 + lane) * 8) = w; }
                s = wave_sum(s);
                if (lane < 32) ssq[(size_t)mm * 32 + lane] = lane == 0 ? s : 0.f; }
        }
    }
    {
        float* rc = (float*)(ws + WS_ROPE); float* rs = rc + SEQ * 64;
        const int gt = gw * 64 + lane, ngt = ngw * 64;
        for (int i = gt; i < SEQ * 64; i += ngt) { const int s = i >> 6, j = i & 63;
            const float inv = exp2f(-(float)j * (13.287712379549449f / 64.0f));
            const float ang = (float)s * inv;
            const double rev = (double)ang * 0.15915494309189535; const float fr = (float)(rev - rint(rev));
            rc[i] = __builtin_amdgcn_cosf(fr); rs[i] = __builtin_amdgcn_sinf(fr); }
        for (int i = gt; i < DEPTH * 8 * DM; i += ngt) { const int l = i / (8 * DM), r = i - l * 8 * DM, h = r / DM, k = r - h * DM;
            const float v = a.in[6][((size_t)l * DM + k) * INCOLS + FZ_COL + h] * a.in[5][(size_t)l * DM + k];
            if (NAIVE_MASK & 1) ((float*)(ws + WS_WFZ))[i] = v; else ((bf16_t*)(ws + WS_WFZ))[i] = (bf16_t)f2bf(v); }
    }
}

__device__ __forceinline__ void fz_phase(const bf16_t* xb, const float* ssq, const float* wfz, const float* bf, float* logf, int blk, int nblk, int tid) {
    const int r = tid >> 3, ks = tid & 7, lane = tid & 63;
    for (int rb = blk; rb < MROWS / 64; rb += nblk) {
        const int row = rb * 64 + r;
        float acc[8];
#pragma unroll
        for (int h = 0; h < 8; ++h) acc[h] = 0.f;
        const u32x4* xp = (const u32x4*)(xb + (size_t)row * DM + ks * 256);
        for (int c = 0; c < 32; ++c) {
            float xv[8]; unpack8(xp[c], xv);
#pragma unroll
            for (int h = 0; h < 8; ++h) { const f32x4* wp = (const f32x4*)(wfz + h * DM + ks * 256 + c * 8); const f32x4 w0 = wp[0], w1 = wp[1];
                acc[h] += (xv[0] * w0[0] + xv[1] * w0[1]) + (xv[2] * w0[2] + xv[3] * w0[3]) + (xv[4] * w1[0] + xv[5] * w1[1]) + (xv[6] * w1[2] + xv[7] * w1[3]); }
        }
#pragma unroll
        for (int h = 0; h < 8; ++h) { acc[h] += __shfl_xor(acc[h], 1); acc[h] += __shfl_xor(acc[h], 2); acc[h] += __shfl_xor(acc[h], 4); }
        const f32x4 pp = *(const f32x4*)(ssq + (size_t)row * 32 + ks * 4);
        float s = (pp[0] + pp[1]) + (pp[2] + pp[3]); s += __shfl_xor(s, 1); s += __shfl_xor(s, 2); s += __shfl_xor(s, 4);
        const float rs = rsqrtf(s * (1.0f / DM) + EPS);
        float mine = acc[0];
#pragma unroll
        for (int h = 1; h < 8; ++h) mine = (ks == h) ? acc[h] : mine;
        const int b = row >> 12, sp = row & 4095;
        logf[((size_t)(b * FOXH + ks)) * SEQ + sp] = logsig_f(mine * rs + bf[ks]);
        (void)lane;
    }
}

__device__ __forceinline__ float ret_log2g(int hr) { return log2f(1.0f - exp2f(-(5.0f + (float)hr))); }

__device__ __forceinline__ void cumsum_unit(const float* lf, float* cum, LAS float* sm, int tid) {
    const int lane = tid & 63, w = tid >> 6;
    const f32x4 a = ((const f32x4*)lf)[2 * tid], b = ((const f32x4*)lf)[2 * tid + 1];
    float v0 = a[0], v1 = v0 + a[1], v2 = v1 + a[2], v3 = v2 + a[3], v4 = v3 + b[0], v5 = v4 + b[1], v6 = v5 + b[2], v7 = v6 + b[3];
    const float tot = v7; float sc = tot;
#pragma unroll
    for (int o = 1; o < 64; o <<= 1) { const float n = __shfl_up(sc, o); if (lane >= o) sc += n; }
    if (lane == 63) sm[w] = sc;
    __syncthreads();
    float base = 0.f;
    for (int i = 0; i < w; ++i) base += sm[i];
    const float ex = base + sc - tot;
    ((f32x4*)cum)[2 * tid] = (f32x4){v0 + ex, v1 + ex, v2 + ex, v3 + ex};
    ((f32x4*)cum)[2 * tid + 1] = (f32x4){v4 + ex, v5 + ex, v6 + ex, v7 + ex};
    __syncthreads();
}
__device__ __forceinline__ void retkv_unit(const bf16_t* K, const bf16_t* V, float* kv, float l2g, LAS float* lds, int tid) {
    LAS float* Kz = lds; LAS float* Vs = lds + 64 * 128;
    { const int s = tid >> 3, c0 = (tid & 7) * 16; const float z = exp2f((float)(63 - s) * l2g);
      const u32x4* kp = (const u32x4*)(K + s * 128 + c0); const u32x4* vp = (const u32x4*)(V + s * 128 + c0);
      float f[8];
#pragma unroll
      for (int j = 0; j < 2; ++j) { unpack8(kp[j], f);
#pragma unroll
          for (int i = 0; i < 8; ++i) Kz[s * 128 + c0 + j * 8 + i] = f[i] * z;
          unpack8(vp[j], f);
#pragma unroll
          for (int i = 0; i < 8; ++i) Vs[s * 128 + c0 + j * 8 + i] = f[i]; } }
    __syncthreads();
    const int e = tid & 127, dg = tid >> 7;
    float acc[32];
#pragma unroll
    for (int i = 0; i < 32; ++i) acc[i] = 0.f;
    for (int s = 0; s < 64; ++s) { const float v = Vs[s * 128 + e];
#pragma unroll
        for (int i = 0; i < 32; ++i) acc[i] += Kz[s * 128 + dg * 32 + i] * v; }
#pragma unroll
    for (int i = 0; i < 32; ++i) kv[(size_t)(dg * 32 + i) * 128 + e] = acc[i];
    __syncthreads();
}
__device__ __forceinline__ void gmlp_unit(const bf16_t* U, const bf16_t* V, const float* lng, const float* lnb, const float* wsp, const float* bsp, bf16_t* Y  , LAS float* lds, int tid) {
    LAS float* vln = lds; LAS float* Wt = lds + 128 * 128;
    const int lane = tid & 63, w = tid >> 6;
    for (int i = 0; i < 16; ++i) { const int s = 16 * w + i;
        const unsigned pr = *(const unsigned*)(V + s * 128 + 2 * lane); const float a = bf2f(pr & 0xffffu), b = bf2f(pr >> 16);
        const float mu = wave_sum(a + b) * (1.0f / 128.0f); const float da = a - mu, db = b - mu;
        const float var = wave_sum(da * da + db * db) * (1.0f / 128.0f); const float rs = rsqrtf(var + EPS);
        vln[s * 128 + 2 * lane] = da * rs * lng[2 * lane] + lnb[2 * lane]; vln[s * 128 + 2 * lane + 1] = db * rs * lng[2 * lane + 1] + lnb[2 * lane + 1]; }
    for (int i = tid; i < 128 * 128; i += NTHREADS) { const int t = i >> 7, s = i & 127; Wt[i] = (s <= t) ? wsp[i] : 0.f; }
    __syncthreads();
    const int c = tid & 127, tg = tid >> 7;
    float acc[32];
#pragma unroll
    for (int i = 0; i < 32; ++i) acc[i] = 0.f;
    for (int s4 = 0; s4 < 32; ++s4) {
        const float x0 = vln[(4 * s4) * 128 + c], x1 = vln[(4 * s4 + 1) * 128 + c], x2 = vln[(4 * s4 + 2) * 128 + c], x3 = vln[(4 * s4 + 3) * 128 + c];
#pragma unroll
        for (int i = 0; i < 32; ++i) { const f32x4 wv = *(const LAS f32x4*)(Wt + (tg * 32 + i) * 128 + 4 * s4); acc[i] += (wv[0] * x0 + wv[1] * x1) + (wv[2] * x2 + wv[3] * x3); }
    }
    __syncthreads();
#pragma unroll
    for (int i = 0; i < 32; ++i) { const int t = tg * 32 + i; const float uu = bf2f(U[t * 128 + c]); vln[t * 128 + c] = uu * (acc[i] + bsp[t]); }
    __syncthreads();
    for (int i = 0; i < 16; ++i) { const int t = 16 * w + i; const float a = vln[t * 128 + 2 * lane], b = vln[t * 128 + 2 * lane + 1];
        const float rs = rsqrtf(wave_sum(a * a + b * b) * (1.0f / 128.0f) + EPS);
        *(unsigned*)(Y + (size_t)t * DM + 2 * lane) = pk2(a * rs, b * rs); }
    __syncthreads();
}
__device__ __forceinline__ void retout_unit(const bf16_t* Q, const bf16_t* K, const bf16_t* V, const bf16_t* G, const float* sp, bf16_t* Y, float l2g, LAS float* lds, int tid) {
    LAS float* Qs = lds; LAS float* Ks = lds + 64 * 129; LAS float* Vs = lds + 2 * 64 * 129; LAS float* Sc = Vs + 64 * 128;
    const int lane = tid & 63, w = tid >> 6;
    { const int s = tid >> 3, c0 = (tid & 7) * 16; float f[8];
      const u32x4* qp = (const u32x4*)(Q + s * 128 + c0); const u32x4* kp = (const u32x4*)(K + s * 128 + c0); const u32x4* vp = (const u32x4*)(V + s * 128 + c0);
#pragma unroll
      for (int j = 0; j < 2; ++j) {
          unpack8(qp[j], f);
#pragma unroll
          for (int i = 0; i < 8; ++i) Qs[s * 129 + c0 + j * 8 + i] = f[i];
          unpack8(kp[j], f);
#pragma unroll
          for (int i = 0; i < 8; ++i) Ks[s * 129 + c0 + j * 8 + i] = f[i];
          unpack8(vp[j], f);
#pragma unroll
          for (int i = 0; i < 8; ++i) Vs[s * 128 + c0 + j * 8 + i] = f[i]; } }
    __syncthreads();
    {
        float acc[8];
#pragma unroll
        for (int j = 0; j < 8; ++j) acc[j] = 0.f;
        for (int d = 0; d < 128; ++d) { const float kk = Ks[lane * 129 + d];
#pragma unroll
            for (int j = 0; j < 8; ++j) acc[j] += Qs[(8 * w + j) * 129 + d] * kk; }
#pragma unroll
        for (int j = 0; j < 8; ++j) { const int t = 8 * w + j; Sc[t * 64 + lane] = (lane <= t) ? acc[j] * exp2f((float)(t - lane) * l2g) : 0.f; }
    }
    __syncthreads();
    const int e = tid & 127, tg = tid >> 7;
    float o[16];
#pragma unroll
    for (int j = 0; j < 16; ++j) o[j] = 0.f;
    for (int d = 0; d < 128; ++d) { const float sv = sp[(size_t)d * 128 + e];
#pragma unroll
        for (int j = 0; j < 16; ++j) o[j] += Qs[(tg * 16 + j) * 129 + d] * sv; }
#pragma unroll
    for (int j = 0; j < 16; ++j) o[j] *= exp2f((float)(tg * 16 + j + 1) * l2g);
    for (int s = 0; s < 64; ++s) { const float v = Vs[s * 128 + e];
#pragma unroll
        for (int j = 0; j < 16; ++j) o[j] += Sc[(tg * 16 + j) * 64 + s] * v; }
    __syncthreads();
#pragma unroll
    for (int j = 0; j < 16; ++j) Ks[(tg * 16 + j) * 128 + e] = o[j];
    __syncthreads();
    for (int i = 0; i < 8; ++i) { const int t = 8 * w + i; const float a = Ks[t * 128 + 2 * lane], b = Ks[t * 128 + 2 * lane + 1];
        const float rs = rsqrtf(wave_sum(a * a + b * b) * (1.0f / 128.0f) + EPS);
        const unsigned gp = *(const unsigned*)(G + t * 128 + 2 * lane);
        *(unsigned*)(Y + (size_t)t * DM + 2 * lane) = pk2(a * rs * bf2f(gp & 0xffffu), b * rs * bf2f(gp >> 16)); }
    __syncthreads();
}
__device__ __forceinline__ void attn_naive(const bf16_t* FQ, const bf16_t* FK, const bf16_t* FV, const float* cum, bf16_t* Y, int gw, int ngw, int lane) {
    const int sub = lane & 3, rl = lane >> 2;
    for (int it = gw; it < 4 * 2048; it += ngw) {
        const int vw = it & 2047, i = it >> 11;
        const int bh = (vw >> 7) + ((i >> 1) << 4), gg = vw & 127, g = (i & 1) ? 255 - gg : gg, t = g * 16 + rl;
        float q[32], o[32];
        { const u32x4* qp = (const u32x4*)(FQ + ((size_t)bh * SEQ + t) * HD + sub * 32);
#pragma unroll
          for (int j = 0; j < 4; ++j) { float f[8]; unpack8(qp[j], f);
#pragma unroll
              for (int k = 0; k < 8; ++k) q[j * 8 + k] = f[k] * 0.08838834764831845f; } }
#pragma unroll
        for (int j = 0; j < 32; ++j) o[j] = 0.f;
        float m = -1e30f, l = 0.f; const float ct = cum[(size_t)bh * SEQ + t];
        const int smax = g * 16 + 15;
        for (int s = 0; s <= smax; ++s) {
            const u32x4* kp = (const u32x4*)(FK + ((size_t)bh * SEQ + s) * HD + sub * 32);
            float d = 0.f;
#pragma unroll
            for (int j = 0; j < 4; ++j) { float f[8]; unpack8(kp[j], f);
#pragma unroll
                for (int k = 0; k < 8; ++k) d += q[j * 8 + k] * f[k]; }
            d += __shfl_xor(d, 1); d += __shfl_xor(d, 2);
            const float logit = d + ct - cum[(size_t)bh * SEQ + s];
            const bool valid = s <= t;
            const float mn = valid ? fmaxf(m, logit) : m;
            const float corr = __expf(m - mn), p = valid ? __expf(logit - mn) : 0.f;
            l = l * corr + p; m = mn;
            const u32x4* vp = (const u32x4*)(FV + ((size_t)bh * SEQ + s) * HD + sub * 32);
#pragma unroll
            for (int j = 0; j < 4; ++j) { float f[8]; unpack8(vp[j], f);
#pragma unroll
                for (int k = 0; k < 8; ++k) o[j * 8 + k] = o[j * 8 + k] * corr + p * f[k]; }
        }
        const float inv = 1.0f / l; float ss = 0.f;
#pragma unroll
        for (int j = 0; j < 32; ++j) { o[j] *= inv; ss += o[j] * o[j]; }
        ss += __shfl_xor(ss, 1); ss += __shfl_xor(ss, 2);
        const float rs = rsqrtf(ss * (1.0f / 128.0f) + EPS);
        const int b = bh >> 3, h = bh & 7;
        bf16_t* yp = Y + ((size_t)(b * SEQ + t)) * DM + h * HD + sub * 32;
#pragma unroll
        for (int j = 0; j < 4; ++j) { u32x4 wv; wv.x = pk2(o[j * 8] * rs, o[j * 8 + 1] * rs); wv.y = pk2(o[j * 8 + 2] * rs, o[j * 8 + 3] * rs); wv.z = pk2(o[j * 8 + 4] * rs, o[j * 8 + 5] * rs); wv.w = pk2(o[j * 8 + 6] * rs, o[j * 8 + 7] * rs);
            *(u32x4*)(yp + j * 8) = wv; }
    }
}


namespace fa {
constexpr int NW = 8, QBLK = 32, KVBLK = 64, QB = 256, D = 128;
constexpr int SHM_V = 16384, SHM_K = 16384;
constexpr int OFF_WS = 2 * SHM_V + 2 * SHM_K;
constexpr int OFF_CS = OFF_WS + NW * 64 * 4;
constexpr int OFF_SH = OFF_CS + SEQ * 4;
constexpr int LDS_NEED = OFF_SH + 64;
constexpr float C2 = 1.4426950408889634f * 0.08838834764831845f;
constexpr float THR2 = 8.f * 1.4426950408889634f;
typedef float f32x16 __attribute__((ext_vector_type(16)));
typedef short s16x4 __attribute__((ext_vector_type(4)));
typedef LAS char* lptr;
#define KSWZ(row, colB) ((row) * 256 + ((colB) ^ (((row) & 7) << 4)))
#define SBAR() __builtin_amdgcn_sched_barrier(0)
__device__ __forceinline__ int v_st(int k, int c) { const int kk = (k & ~0xC) | ((k & 4) << 1) | ((k & 8) >> 1); return ((kk >> 3) * 4 + (c >> 5)) * 512 + ((kk & 7) * 32 + (c & 31)) * 2; }
__device__ __forceinline__ int v_rd_base(int lane) { return ((lane & 3) << 3) | (((lane >> 2) & 3) << 6) | (((lane >> 4) & 1) << 5) | (((lane >> 5) & 1) << 8); }
constexpr int v_rd_off(int d0, int ks, int half) { return d0 * 512 + ks * 4096 + half * 2048; }
__device__ __forceinline__ int crow(int r, int hi) { return (r & 3) + 8 * (r >> 2) + 4 * hi; }
__device__ __forceinline__ bf16x8 load8(const bf16_t* p) { return *reinterpret_cast<const bf16x8*>(p); }
__device__ __forceinline__ void bias_tile(f32x16& p0, f32x16& p1, const LAS float* cs) {
#pragma unroll
    for (int i = 0; i < 4; ++i) { const f32x4 a = *(const LAS f32x4*)(cs + 8 * i), b = *(const LAS f32x4*)(cs + 32 + 8 * i);
#pragma unroll
        for (int j = 0; j < 4; ++j) { p0[4 * i + j] = fmaf(p0[4 * i + j], C2, a[j]); p1[4 * i + j] = fmaf(p1[4 * i + j], C2, b[j]); } }
}
__device__ __forceinline__ void mask_tile(f32x16& p0, f32x16& p1, int dq) {
    const float NEG = -__builtin_inff();
#pragma unroll
    for (int r = 0; r < 16; ++r) { const int c = (r & 3) + 8 * (r >> 2);
        if (dq - c < 0) p0[r] = NEG;
        if (dq - c - 32 < 0) p1[r] = NEG; }
}
__device__ __forceinline__ void partialSM(f32x16& p0, f32x16& p1, float& m_reg, float& alpha) {
    float pmax = p0[0];
#pragma unroll
    for (int r = 1; r < 16; ++r) pmax = fmaxf(pmax, p0[r]);
#pragma unroll
    for (int r = 0; r < 16; ++r) pmax = fmaxf(pmax, p1[r]);
    { auto rr = __builtin_amdgcn_permlane32_swap(__float_as_uint(pmax), __float_as_uint(pmax), false, false);
      pmax = fmaxf(__uint_as_float(rr[0]), __uint_as_float(rr[1])); }
    float mn;
    if (__builtin_expect(__all(pmax - m_reg <= THR2), 1)) { mn = m_reg; alpha = 1.f; }
    else { mn = fmaxf(m_reg, pmax); alpha = __builtin_amdgcn_exp2f(m_reg - mn); m_reg = mn; }
#pragma unroll
    for (int r = 0; r < 16; ++r) p0[r] = p0[r] - mn;
#pragma unroll
    for (int r = 0; r < 16; ++r) p1[r] = p1[r] - mn;
#pragma unroll
    for (int r = 0; r < 16; ++r) p0[r] = __builtin_amdgcn_exp2f(p0[r]);
}
__device__ __forceinline__ void finishSM(f32x16& p0, f32x16& p1, float alpha, float& l_reg, bf16x8& pa0, bf16x8& pa1, bf16x8& pa2, bf16x8& pa3) {
#pragma unroll
    for (int r = 0; r < 16; ++r) p1[r] = __builtin_amdgcn_exp2f(p1[r]);
    float ps = 0;
#pragma unroll
    for (int r = 0; r < 16; ++r) ps += p0[r];
#pragma unroll
    for (int r = 0; r < 16; ++r) ps += p1[r];
    { auto rr = __builtin_amdgcn_permlane32_swap(__float_as_uint(ps), __float_as_uint(ps), false, false);
      ps = __uint_as_float(rr[0]) + __uint_as_float(rr[1]); }
    l_reg = l_reg * alpha + ps;
#define PK4(P, B_, OUT) do { unsigned a0 = cvt_pk_bf16(P[B_+0], P[B_+1]), a1 = cvt_pk_bf16(P[B_+2], P[B_+3]);                          \
        unsigned b0 = cvt_pk_bf16(P[B_+4], P[B_+5]), b1 = cvt_pk_bf16(P[B_+6], P[B_+7]);                                             \
        auto r0 = __builtin_amdgcn_permlane32_swap(a0, b0, false, false); auto r1 = __builtin_amdgcn_permlane32_swap(a1, b1, false, false); \
        u32x4 w = {r0[0], r1[0], r0[1], r1[1]}; OUT = *reinterpret_cast<bf16x8*>(&w); } while (0)
    PK4(p0, 0, pa0); PK4(p0, 8, pa1); PK4(p1, 0, pa2); PK4(p1, 8, pa3);
#undef PK4
}
template <int KB>
__device__ __forceinline__ void qkt(f32x16& p0, f32x16& p1, lptr K_lds, int r32, int hi, const bf16x8* qr) {
    p0 = f32x16{}; p1 = f32x16{};
    lptr kb[4];
#pragma unroll
    for (int dd = 0; dd < 4; ++dd) kb[dd] = K_lds + KB * SHM_K + KSWZ(r32, (dd * 16 + hi * 8) * 2);
#pragma unroll
    for (int d0 = 0; d0 < 8; ++d0) { lptr a = kb[d0 & 3] + (d0 >> 2) * 128;
        bf16x8 b0 = *reinterpret_cast<const LAS bf16x8*>(a);
        bf16x8 b1 = *reinterpret_cast<const LAS bf16x8*>(a + 32 * 256);
        p0 = __builtin_amdgcn_mfma_f32_32x32x16_bf16(b0, qr[d0], p0, 0, 0, 0);
        p1 = __builtin_amdgcn_mfma_f32_32x32x16_bf16(b1, qr[d0], p1, 0, 0, 0); }
}
template <int VB>
__device__ __forceinline__ void pv_tile(f32x16* o, int vb0, bf16x8 pa0, bf16x8 pa1, bf16x8 pa2, bf16x8 pa3) {
#define TRRD(dst, off) asm volatile("ds_read_b64_tr_b16 %0, %1 offset:%2" : "=&v"(dst) : "v"(vb0), "i"(off) : "memory")
#define PV_D0(d0) do { s16x4 l0, l1, l2, l3, h0, h1, h2, h3; constexpr int b_ = VB * SHM_V + v_rd_off(d0, 0, 0); \
        TRRD(l0, b_); TRRD(h0, b_ + 2048); TRRD(l1, b_ + 4096); TRRD(h1, b_ + 6144); TRRD(l2, b_ + 8192); TRRD(h2, b_ + 10240); TRRD(l3, b_ + 12288); TRRD(h3, b_ + 14336); \
        asm volatile("s_waitcnt lgkmcnt(0)" ::: "memory"); SBAR(); \
        o[d0] = __builtin_amdgcn_mfma_f32_32x32x16_bf16(pa0, (bf16x8){l0[0], l0[1], l0[2], l0[3], h0[0], h0[1], h0[2], h0[3]}, o[d0], 0, 0, 0);   \
        o[d0] = __builtin_amdgcn_mfma_f32_32x32x16_bf16(pa1, (bf16x8){l1[0], l1[1], l1[2], l1[3], h1[0], h1[1], h1[2], h1[3]}, o[d0], 0, 0, 0);   \
        o[d0] = __builtin_amdgcn_mfma_f32_32x32x16_bf16(pa2, (bf16x8){l2[0], l2[1], l2[2], l2[3], h2[0], h2[1], h2[2], h2[3]}, o[d0], 0, 0, 0);   \
        o[d0] = __builtin_amdgcn_mfma_f32_32x32x16_bf16(pa3, (bf16x8){l3[0], l3[1], l3[2], l3[3], h3[0], h3[1], h3[2], h3[3]}, o[d0], 0, 0, 0); } while (0)
    PV_D0(0); PV_D0(1); PV_D0(2); PV_D0(3);
#undef PV_D0
#undef TRRD
}
struct BlockRef { const bf16_t* Q; const bf16_t* K; const bf16_t* V; bf16_t* O; int P0; };
#define ROW(p, k0, rr) ((p) + (size_t)((k0) + (rr)) * D + sc)
#define VMW() asm volatile("s_waitcnt vmcnt(0)" ::: "memory")
#define SLOAD_H(Kp, Vp, k0) do { st_v0 = load8(ROW(Vp, k0, sr)); st_v1 = load8(ROW(Vp, k0, 32 + sr)); st_k0 = load8(ROW(Kp, k0, sr)); st_k1 = load8(ROW(Kp, k0, 32 + sr)); } while (0)
#define SWRITE_H(bf) do { *(LAS bf16x8*)(V_lds + (bf) * SHM_V + vst0) = st_v0; *(LAS bf16x8*)(V_lds + (bf) * SHM_V + vst1) = st_v1; \
                          *(LAS bf16x8*)(K_lds + (bf) * SHM_K + kws) = st_k0; *(LAS bf16x8*)(K_lds + (bf) * SHM_K + kws + 32 * 256) = st_k1; } while (0)
#define SWRITE_HK(bf) do { *(LAS bf16x8*)(K_lds + (bf) * SHM_K + kws) = st_k0; *(LAS bf16x8*)(K_lds + (bf) * SHM_K + kws + 32 * 256) = st_k1; } while (0)
#define SWRITE_HV(bf) do { *(LAS bf16x8*)(V_lds + (bf) * SHM_V + vst0) = st_v0; *(LAS bf16x8*)(V_lds + (bf) * SHM_V + vst1) = st_v1; } while (0)
struct SplitRef { unsigned* arrive; unsigned* ready; float* part; };
__device__ __forceinline__ void block(const BlockRef& cur, const int j0, const int NT, const int split, const SplitRef sp, lptr lds, int tid) {
    const int wid = __builtin_amdgcn_readfirstlane(tid >> 6), lane = tid & 63, r32 = lane & 31, hi = lane >> 5;
    const int qlo = cur.P0 + wid * QBLK, qm = qlo + r32 - 4 * hi;
    lptr V_lds = lds; lptr K_lds = lds + 2 * SHM_V;
    LAS float* wsc = (LAS float*)(lds + OFF_WS) + wid * 64; LAS float* li_l = wsc; LAS float* al_l = wsc + 32;
    const LAS float* Cs = (const LAS float*)(lds + OFF_CS) + 4 * hi;
    float m_reg = -1e30f, l_reg = 0; f32x16 o[4] = {};
    const int sr = tid >> 4, sc = (tid & 15) * 8, vst0 = v_st(sr, sc), vst1 = v_st(32 + sr, sc), kws = KSWZ(sr, sc * 2);
    const int vb0 = (int)(unsigned)(uintptr_t)V_lds + v_rd_base(lane);
    const bf16_t* Kh = cur.K; const bf16_t* Vh = cur.V;
    bf16x8 qr[8], st_v0, st_v1, st_k0, st_k1;
#pragma unroll
    for (int d0 = 0; d0 < 8; ++d0) qr[d0] = load8(cur.Q + (size_t)(wid * QBLK + r32) * D + d0 * 16 + hi * 8);
    SLOAD_H(Kh, Vh, j0 * KVBLK); VMW(); SWRITE_H(0);
    SLOAD_H(Kh, Vh, (j0 + 1) * KVBLK);
    __syncthreads();
#define RESC(a) do { if (__any((a) < 1.f)) { if (hi == 0) al_l[r32] = (a); asm volatile("s_waitcnt lgkmcnt(0)" ::: "memory");              \
                     _Pragma("unroll") for (int d_ = 0; d_ < 4; ++d_) _Pragma("unroll") for (int r = 0; r < 16; ++r) o[d_][r] *= al_l[crow(r, hi)]; } } while (0)
#define KBASE(t) ((j0 + (t)) * KVBLK)
#define MASKT(P0_, P1_, t) do { const int kb_ = KBASE(t); bias_tile(P0_, P1_, Cs + kb_); if (kb_ + KVBLK - 1 > qlo) mask_tile(P0_, P1_, qm - kb_); } while (0)
    f32x16 pA0, pA1, pB0, pB1; float alA, alB; bf16x8 pa0, pa1, pa2, pa3;
    SBAR(); qkt<0>(pA0, pA1, K_lds, r32, hi, qr);
    MASKT(pA0, pA1, 0); partialSM(pA0, pA1, m_reg, alA);
    VMW(); SWRITE_H(1);
    __syncthreads();
#define HALF_STEP(PX0, PX1, alX, PY0, PY1, alY, t, KB, VB, SB) do {                                                      \
        SBAR(); qkt<KB>(PX0, PX1, K_lds, r32, hi, qr);                                             \
        finishSM(PY0, PY1, alY, l_reg, pa0, pa1, pa2, pa3); SBAR();                                                           \
        if ((t) + 1 < NT) { SLOAD_H(Kh, Vh, KBASE((t) + 1)); SBAR(); }                                               \
        pv_tile<VB>(o, vb0, pa0, pa1, pa2, pa3); MASKT(PX0, PX1, (t)); partialSM(PX0, PX1, m_reg, alX);                                        \
        __syncthreads();                                                                                                      \
        if ((t) + 1 < NT) { VMW(); SWRITE_H(SB); }                                                                          \
        RESC(alX); __syncthreads(); } while (0)
    for (int t = 1; t + 1 < NT; t += 2) {
        HALF_STEP(pB0, pB1, alB, pA0, pA1, alA, t, 1, 0, 0);
        HALF_STEP(pA0, pA1, alA, pB0, pB1, alB, t + 1, 0, 1, 1);
    }
    SBAR(); qkt<1>(pB0, pB1, K_lds, r32, hi, qr); SBAR();
    finishSM(pA0, pA1, alA, l_reg, pa0, pa1, pa2, pa3); SBAR();
    pv_tile<0>(o, vb0, pa0, pa1, pa2, pa3);
    MASKT(pB0, pB1, NT - 1); partialSM(pB0, pB1, m_reg, alB); RESC(alB);
    finishSM(pB0, pB1, alB, l_reg, pa0, pa1, pa2, pa3); SBAR(); pv_tile<1>(o, vb0, pa0, pa1, pa2, pa3);
    if (split) {
        LAS int* sh = (LAS int*)(lds + OFF_SH);
        __syncthreads();
        if (tid == 0) sh[2] = (int)__hip_atomic_fetch_add(sp.arrive, 1u, __ATOMIC_RELAXED, __HIP_MEMORY_SCOPE_AGENT);
        __syncthreads();
        const bool first = sh[2] == 0;
        float* pp = sp.part + (size_t)wid * 66 * 64 + lane;
        if (first) {
#pragma unroll
            for (int d_ = 0; d_ < 4; ++d_)
#pragma unroll
                for (int r = 0; r < 16; ++r) __hip_atomic_store(pp + (d_ * 16 + r) * 64, o[d_][r], __ATOMIC_RELAXED, __HIP_MEMORY_SCOPE_AGENT);
            __hip_atomic_store(pp + 64 * 64, m_reg, __ATOMIC_RELAXED, __HIP_MEMORY_SCOPE_AGENT); __hip_atomic_store(pp + 65 * 64, l_reg, __ATOMIC_RELAXED, __HIP_MEMORY_SCOPE_AGENT);
            asm volatile("s_waitcnt vmcnt(0)" ::: "memory");
            __syncthreads();
            if (tid == 0) __hip_atomic_store(sp.ready, 1u, __ATOMIC_RELAXED, __HIP_MEMORY_SCOPE_AGENT);
            return;
        }
        if (wid == 0) {
            unsigned spins = 0;
            while ((unsigned)__builtin_amdgcn_readfirstlane(__hip_atomic_load(sp.ready, __ATOMIC_RELAXED, __HIP_MEMORY_SCOPE_AGENT)) == 0u) { __builtin_amdgcn_s_sleep(2); if (++spins > (1u << 22)) break; }
            __builtin_amdgcn_fence(__ATOMIC_ACQUIRE, "agent");
            asm volatile("s_waitcnt vmcnt(0)" ::: "memory");
        }
        __syncthreads();
        const float om = __hip_atomic_load(pp + 64 * 64, __ATOMIC_RELAXED, __HIP_MEMORY_SCOPE_AGENT), ol = __hip_atomic_load(pp + 65 * 64, __ATOMIC_RELAXED, __HIP_MEMORY_SCOPE_AGENT);
        const float mm = fmaxf(m_reg, om), as = __builtin_amdgcn_exp2f(m_reg - mm), ao = __builtin_amdgcn_exp2f(om - mm);
        { const float t1 = (split == 1) ? ol * ao : l_reg * as; l_reg = (split == 1) ? __builtin_fmaf(l_reg, as, t1) : __builtin_fmaf(ol, ao, t1); } m_reg = mm;
        if (hi == 0) { al_l[r32] = as; li_l[r32] = ao; }
        asm volatile("s_waitcnt lgkmcnt(0)" ::: "memory");
#pragma unroll
        for (int d_ = 0; d_ < 4; ++d_)
#pragma unroll
            for (int r = 0; r < 16; ++r) { const float po = __hip_atomic_load(pp + (d_ * 16 + r) * 64, __ATOMIC_RELAXED, __HIP_MEMORY_SCOPE_AGENT); const float ws_ = al_l[crow(r, hi)], wo_ = li_l[crow(r, hi)];
                const float t1 = (split == 1) ? po * wo_ : o[d_][r] * ws_; o[d_][r] = (split == 1) ? __builtin_fmaf(o[d_][r], ws_, t1) : __builtin_fmaf(po, wo_, t1); }
        asm volatile("s_waitcnt lgkmcnt(0)" ::: "memory");
    }
    if (hi == 0) li_l[r32] = l_reg; asm volatile("s_waitcnt lgkmcnt(0)" ::: "memory");
    bf16_t* Ow = cur.O + (size_t)(wid * QBLK) * DM;
#pragma unroll
    for (int r = 0; r < 16; ++r) { const int orow = crow(r, hi); const float rli = __builtin_amdgcn_rcpf(li_l[orow]);
        float v0 = o[0][r] * rli, v1 = o[1][r] * rli, v2 = o[2][r] * rli, v3 = o[3][r] * rli;
        float ss = (v0 * v0 + v1 * v1) + (v2 * v2 + v3 * v3);
        ss += __shfl_xor(ss, 1); ss += __shfl_xor(ss, 2); ss += __shfl_xor(ss, 4); ss += __shfl_xor(ss, 8); ss += __shfl_xor(ss, 16);
        const float rs = rsqrtf(ss * (1.0f / 128.0f) + EPS);
        v0 *= rs; v1 *= rs; v2 *= rs; v3 *= rs;
        const float n0 = __shfl_xor(v0, 1), n1 = __shfl_xor(v1, 1), n2 = __shfl_xor(v2, 1), n3 = __shfl_xor(v3, 1);
        if ((r32 & 1) == 0) { bf16_t* op = Ow + (size_t)orow * DM + r32;
            *(unsigned*)(op) = cvt_pk_bf16(v0, n0); *(unsigned*)(op + 32) = cvt_pk_bf16(v1, n1); *(unsigned*)(op + 64) = cvt_pk_bf16(v2, n2); *(unsigned*)(op + 96) = cvt_pk_bf16(v3, n3); } }
    __syncthreads();
#undef RESC
#undef KBASE
#undef MASKT
#undef HALF_STEP
}
#undef SWRITE_HK
#undef SWRITE_HV
#undef ROW
#undef VMW
#undef SLOAD_H
#undef SWRITE_H
__device__ __forceinline__ void norm_phase(const bf16_t* FQ, const bf16_t* FK, float* norms, int gw, int ngw, int lane) {
    for (int tt = gw; tt < NB * FOXH * (SEQ / 64); tt += ngw) {
        const size_t ro = ((size_t)tt * 64 + lane) * D;
        float k2 = 0.f, q2 = 0.f;
        bf16x8 kv[16], qv[16];
#pragma unroll
        for (int j = 0; j < 16; ++j) { kv[j] = load8(FK + ro + 8 * j); qv[j] = load8(FQ + ro + 8 * j); }
#pragma unroll
        for (int j = 0; j < 16; ++j) { float f[8];
            unpack8(*reinterpret_cast<const u32x4*>(&kv[j]), f); k2 += ((f[0] * f[0] + f[1] * f[1]) + (f[2] * f[2] + f[3] * f[3])) + ((f[4] * f[4] + f[5] * f[5]) + (f[6] * f[6] + f[7] * f[7]));
            unpack8(*reinterpret_cast<const u32x4*>(&qv[j]), f); q2 += ((f[0] * f[0] + f[1] * f[1]) + (f[2] * f[2] + f[3] * f[3])) + ((f[4] * f[4] + f[5] * f[5]) + (f[6] * f[6] + f[7] * f[7])); }
#pragma unroll
        for (int o = 1; o < 64; o <<= 1) { k2 = fmaxf(k2, __shfl_xor(k2, o)); q2 = fmaxf(q2, __shfl_xor(q2, o)); }
        if (lane == 0) { norms[2 * tt] = k2; norms[2 * tt + 1] = q2; }
    }
}
__device__ __forceinline__ void item_decode(int item, int& qb, int& bh, int& nh, int& half) {
    constexpr int GQ[16] = {13, 12, 11, 10, 9, 8, 15, 7, 14, 6, 5, 4, 3, 2, 1, 0};
    int base = 0; qb = 0; nh = 1; half = 0; bh = 0;
#pragma unroll
    for (int g = 0; g < 16; ++g) { const int q = GQ[g], n = q >= 14 ? 2 : 1, cnt = 32 * n; if (item >= base && item < base + cnt) { const int r = item - base; qb = q; nh = n; bh = r % 32; half = n == 2 ? 1 - r / 32 : 0; } base += cnt; }
}
constexpr int N_ITEMS = 2 * 32 * 2 + 14 * 32;
__device__ __forceinline__ void attn_phase(const bf16_t* FQ, const bf16_t* FK, const bf16_t* FV, const float* cum, const float* norms, bf16_t* Y, unsigned* qctr, unsigned* flags, float* parts, lptr lds, int tid_) {
    LAS int* sh = (LAS int*)(lds + OFF_SH);
    for (;;) {
        int tid = tid_; asm volatile("" : "+v"(tid));
        const int wid = __builtin_amdgcn_readfirstlane(tid >> 6), lane = tid & 63;
        __syncthreads();
        if (tid == 0) sh[0] = (int)__hip_atomic_fetch_add(qctr, 1u, __ATOMIC_RELAXED, __HIP_MEMORY_SCOPE_AGENT);
        __syncthreads();
        const int item = sh[0];
        if (item >= N_ITEMS) break;
        int qb, bh, nh, half; item_decode(item, qb, bh, nh, half);
        const int b = bh >> 3, h = bh & 7, NTall = qb * 4 + 4;
        f32x4 kq_ = {}, qq_ = {};
        if (wid == 0) { kq_ = *(const f32x4*)(norms + (size_t)((bh * 64 + lane) << 2)); qq_ = *(const f32x4*)(norms + (size_t)(((32 + bh) * 64 + lane) << 2)); }
        { LAS float* Cs = (LAS float*)(lds + OFF_CS); const f32x4* cp = (const f32x4*)(cum + (size_t)bh * SEQ);
#pragma unroll
          for (int j = 0; j < 2; ++j) { const int i4 = tid + j * NTHREADS; if (i4 < NTall * 16) { const f32x4 v = cp[i4]; *(LAS f32x4*)(Cs + 4 * i4) = v * (-1.4426950408889634f); } } }
        __syncthreads();
        if (wid == 0) {
            const LAS float* Cs = (const LAS float*)(lds + OFF_CS);
            const bool valid = lane < NTall, diag = valid && lane >= NTall - 4;
            const float k2 = (kq_[0] + kq_[1]) + (kq_[2] + kq_[3]), q2 = (qq_[0] + qq_[1]) + (qq_[2] + qq_[3]);
            float kd2 = diag ? k2 : 0.f, qm2 = diag ? q2 : 0.f;
#pragma unroll
            for (int o = 1; o < 64; o <<= 1) { kd2 = fmaxf(kd2, __shfl_xor(kd2, o)); qm2 = fmaxf(qm2, __shfl_xor(qm2, o)); }
            const float bound = 1.01f * C2 * sqrtf(qm2) * (sqrtf(k2) + sqrtf(kd2)) + (valid ? Cs[64 * lane + 63] : 0.f) - Cs[qb * QB];
            const unsigned long long keep = __ballot(valid && !(bound < -44.0f));
            if (lane == 0) sh[1] = keep ? (int)__builtin_ctzll(keep) : 0;
        }
        __syncthreads();
        const int j0 = sh[1] & ~1, NTe = NTall - j0;
        int jb = j0, nt = NTe;
        if (nh == 2) { const int nA = (NTe >> 1) & ~1; if (half == 0) nt = nA; else { jb = j0 + nA; nt = NTe - nA; } }
        const bf16_t* Qh = FQ + (size_t)bh * SEQ * D; const bf16_t* Kh = FK + (size_t)bh * SEQ * D; const bf16_t* Vh = FV + (size_t)bh * SEQ * D;
        bf16_t* Yh = Y + (size_t)b * SEQ * DM + h * D;
        BlockRef br{Qh + (size_t)qb * QB * D, Kh, Vh, Yh + (size_t)qb * QB * DM, qb * QB};
        const int sb = bh * 16 + qb;
        SplitRef sp{flags + 2 * sb, flags + 2 * sb + 1, parts + (size_t)sb * (NW * 66 * 64)};
        if (PROBE_TILES && tid == 0) __hip_atomic_fetch_add(qctr + 32, (unsigned)nt, __ATOMIC_RELAXED, __HIP_MEMORY_SCOPE_AGENT);
        block(br, jb, nt, nh == 2 ? 1 + half : 0, sp, lds, tid);
    }
}
#undef KSWZ
#undef SBAR
}


namespace mx {
typedef float f32x16 __attribute__((ext_vector_type(16)));
typedef short s16x4 __attribute__((ext_vector_type(4)));
typedef LAS char* lptr;
using fa::v_st; using fa::v_rd_base; using fa::crow; using fa::load8;
template <int OFF> __device__ __forceinline__ s16x4 trrd(int vb) { s16x4 d; asm volatile("ds_read_b64_tr_b16 %0, %1 offset:%2" : "=&v"(d) : "v"(vb), "i"(OFF) : "memory"); return d; }
#define MX_LWAIT() do { asm volatile("s_waitcnt lgkmcnt(0)" ::: "memory"); __builtin_amdgcn_sched_barrier(0); } while (0)
#define MX_RD(l, h, vb, D0, KS) do { l = mx::trrd<(D0) * 512 + (KS) * 4096>(vb); h = mx::trrd<(D0) * 512 + (KS) * 4096 + 2048>(vb); } while (0)
#define MX_CAT(l, h) ((bf16x8){l[0], l[1], l[2], l[3], h[0], h[1], h[2], h[3]})
#define MX_MFMA(a, b, c) __builtin_amdgcn_mfma_f32_32x32x16_bf16((a), (b), (c), 0, 0, 0)
#define MX_PK4(P, B_, OUT) do { unsigned a0 = cvt_pk_bf16(P[B_+0], P[B_+1]), a1 = cvt_pk_bf16(P[B_+2], P[B_+3]); \
        unsigned b0 = cvt_pk_bf16(P[B_+4], P[B_+5]), b1 = cvt_pk_bf16(P[B_+6], P[B_+7]); \
        auto r0 = __builtin_amdgcn_permlane32_swap(a0, b0, false, false); auto r1 = __builtin_amdgcn_permlane32_swap(a1, b1, false, false); \
        u32x4 w = {r0[0], r1[0], r0[1], r1[1]}; OUT = *reinterpret_cast<bf16x8*>(&w); } while (0)
__device__ __forceinline__ bf16x8 scale8(const bf16x8 v, float z) {
    const u32x4 w = *reinterpret_cast<const u32x4*>(&v); float f[8]; unpack8(w, f);
    u32x4 o; o.x = cvt_pk_bf16(f[0] * z, f[1] * z); o.y = cvt_pk_bf16(f[2] * z, f[3] * z); o.z = cvt_pk_bf16(f[4] * z, f[5] * z); o.w = cvt_pk_bf16(f[6] * z, f[7] * z);
    return *reinterpret_cast<const bf16x8*>(&o);
}
__device__ __forceinline__ void retkv_phase(const bf16_t* RK, const bf16_t* RV, bf16_t* kvT, lptr lds, int blk, int G, int tid_) {
    int tid = tid_; asm volatile("" : "+v"(tid));
    const int wid = __builtin_amdgcn_readfirstlane(tid >> 6), lane = tid & 63, r32 = lane & 31, hi = lane >> 5;
    const int sr = tid >> 4, sc = (tid & 15) * 8;
    bf16x8 k8[2], v8[2];
#define KV_LOAD(un) do { const size_t rb_ = (size_t)((un) >> 6) * SEQ + ((un) & 63) * 64; _Pragma("unroll") for (int j = 0; j < 2; ++j) { k8[j] = load8(RK + (rb_ + sr + 32 * j) * HD + sc); v8[j] = load8(RV + (rb_ + sr + 32 * j) * HD + sc); } } while (0)
    if (blk < 16 * 64) KV_LOAD(blk);
    for (int unit = blk; unit < 16 * 64; unit += G) {
        const int bhr = unit >> 6; const float l2g = ret_log2g(bhr & 3);
        __syncthreads();
#pragma unroll
        for (int j = 0; j < 2; ++j) { const int rr = sr + 32 * j;
            *(LAS bf16x8*)(lds + v_st(rr, sc)) = scale8(k8[j], exp2f((float)(63 - rr) * l2g));
            *(LAS bf16x8*)(lds + 16384 + v_st(rr, sc)) = v8[j]; }
        if (unit + G < 16 * 64) KV_LOAD(unit + G);
        __syncthreads();
        const int eb = wid & 3, db0 = 2 * (wid >> 2);
        const int vbK = (int)(unsigned)(uintptr_t)lds + v_rd_base(lane) + db0 * 512, vbV = (int)(unsigned)(uintptr_t)lds + 16384 + v_rd_base(lane) + eb * 512;
        f32x16 c0 = {}, c1 = {};
#define KV_STEP(KS) do { s16x4 al, ah, b0l, b0h, b1l, b1h; MX_RD(al, ah, vbV, 0, KS); MX_RD(b0l, b0h, vbK, 0, KS); MX_RD(b1l, b1h, vbK, 1, KS); MX_LWAIT(); \
            c0 = MX_MFMA(MX_CAT(al, ah), MX_CAT(b0l, b0h), c0); c1 = MX_MFMA(MX_CAT(al, ah), MX_CAT(b1l, b1h), c1); } while (0)
        KV_STEP(0); KV_STEP(1); KV_STEP(2); KV_STEP(3);
#undef KV_STEP
        bf16_t* op = kvT + ((size_t)unit << 14) + 32 * db0 + r32;
#pragma unroll
        for (int r = 0; r < 16; ++r) { const int e = 32 * eb + crow(r, hi); const float n0 = __shfl_xor(c0[r], 1), n1 = __shfl_xor(c1[r], 1);
            if ((r32 & 1) == 0) { *(unsigned*)(op + e * 128) = cvt_pk_bf16(c0[r], n0); *(unsigned*)(op + e * 128 + 32) = cvt_pk_bf16(c1[r], n1); } }
    }
#undef KV_LOAD
}
__device__ __forceinline__ void retscan_phase(const bf16_t* kvT, bf16_t* ST, int blk, int G, int tid) {
    for (int i = blk * NTHREADS + tid; i < 16 * 128 * 64; i += G * NTHREADS) {
        const int bhr = i >> 13, rem2 = (i & 8191) * 2; const float cd = exp2f(64.0f * ret_log2g(bhr & 3));
        float s0 = 0.f, s1 = 0.f;
        for (int n0 = 0; n0 < 64; n0 += 16) {
            unsigned kv[16];
#pragma unroll
            for (int j = 0; j < 16; ++j) kv[j] = *(const unsigned*)(kvT + ((size_t)(bhr * 64 + n0 + j) << 14) + rem2);
#pragma unroll
            for (int j = 0; j < 16; ++j) { *(unsigned*)(ST + ((size_t)(bhr * 64 + n0 + j) << 14) + rem2) = cvt_pk_bf16(s0, s1); s0 = s0 * cd + bf2f(kv[j] & 0xffffu); s1 = s1 * cd + __uint_as_float(kv[j] & 0xffff0000u); }
        }
    }
}
__device__ __forceinline__ void retout_phase(const bf16_t* RQ, const bf16_t* RK, const bf16_t* RV, const bf16_t* RG, const bf16_t* ST, bf16_t* Y, lptr lds, int blk, int G, int tid_) {
    for (int unit = blk; unit < 256; unit += G) {
        int tid = tid_; asm volatile("" : "+v"(tid));
        const int wid = __builtin_amdgcn_readfirstlane(tid >> 6), lane = tid & 63, r32 = lane & 31, hi = lane >> 5;
        const int ci = wid >> 1, tb = wid & 1, bhr = unit >> 4, n = (unit & 15) * 4 + ci, hr = bhr & 3, b = bhr >> 2;
        const float l2g = ret_log2g(hr);
        const size_t rowbase = (size_t)bhr * SEQ + n * 64;
        __syncthreads();
        {
            const int l128 = tb * 64 + lane, row = l128 >> 1, half = l128 & 1; const bf16_t* vp = RV + (rowbase + row) * HD + half * 64; const bf16_t* gp_ = RG + (rowbase + row) * HD + half * 64;
            bf16x8 v[8], gq[8];
#pragma unroll
            for (int j = 0; j < 8; ++j) { v[j] = load8(vp + 8 * j); gq[j] = load8(gp_ + 8 * j); }
#pragma unroll
            for (int j = 0; j < 8; ++j) { *(LAS bf16x8*)(lds + ci * 32768 + v_st(row, half * 64 + 8 * j)) = v[j]; *(LAS bf16x8*)(lds + ci * 32768 + 16384 + row * 256 + half * 128 + 16 * j) = gq[j]; } }
        bf16x8 qf[8], kf0[8];
#pragma unroll
        for (int ks = 0; ks < 8; ++ks) { qf[ks] = load8(RQ + (rowbase + 32 * tb + r32) * HD + 16 * ks + 8 * hi); kf0[ks] = load8(RK + (rowbase + r32) * HD + 16 * ks + 8 * hi); }
        __syncthreads();
        f32x16 p0 = {}, p1 = {};
#pragma unroll
        for (int ks = 0; ks < 8; ++ks) p0 = MX_MFMA(kf0[ks], qf[ks], p0);
        if (tb) {
            bf16x8 kf1[8];
#pragma unroll
            for (int ks = 0; ks < 8; ++ks) kf1[ks] = load8(RK + (rowbase + 32 + r32) * HD + 16 * ks + 8 * hi);
            __builtin_amdgcn_sched_barrier(0);
#pragma unroll
            for (int ks = 0; ks < 8; ++ks) p1 = MX_MFMA(kf1[ks], qf[ks], p1); }
        const int t = 32 * tb + r32;
#pragma unroll
        for (int r = 0; r < 16; ++r) { const int d0 = t - crow(r, hi), d1 = d0 - 32;
            p0[r] = d0 >= 0 ? p0[r] * exp2f((float)d0 * l2g) : 0.f; p1[r] = d1 >= 0 ? p1[r] * exp2f((float)d1 * l2g) : 0.f; }
        bf16x8 pa0, pa1, pa2, pa3;
        MX_PK4(p0, 0, pa0); MX_PK4(p0, 8, pa1); MX_PK4(p1, 0, pa2); MX_PK4(p1, 8, pa3);
        f32x16 o[4] = {};
        const bf16_t* stp = ST + ((size_t)(bhr * 64 + n) << 14) + (size_t)r32 * HD + 8 * hi;
#pragma unroll
        for (int eh = 0; eh < 2; ++eh) {
            bf16x8 sf[16];
#pragma unroll
            for (int i = 0; i < 16; ++i) sf[i] = load8(stp + (2 * eh + (i >> 3)) * 32 * HD + 16 * (i & 7));
            __builtin_amdgcn_sched_barrier(0);
#pragma unroll
            for (int i = 0; i < 16; ++i) o[2 * eh + (i >> 3)] = MX_MFMA(qf[i & 7], sf[i], o[2 * eh + (i >> 3)]);
            __builtin_amdgcn_sched_barrier(0);
        }
#pragma unroll
        for (int r = 0; r < 16; ++r) { const float xi = exp2f((float)(32 * tb + crow(r, hi) + 1) * l2g);
#pragma unroll
            for (int eb = 0; eb < 4; ++eb) o[eb][r] *= xi; }
        const int vb = (int)(unsigned)(uintptr_t)lds + ci * 32768 + v_rd_base(lane);
#define RO_STEP(EB) do { s16x4 l0, h0, l1, h1; MX_RD(l0, h0, vb, EB, 0); MX_RD(l1, h1, vb, EB, 1); MX_LWAIT(); \
            o[EB] = MX_MFMA(pa0, MX_CAT(l0, h0), o[EB]); o[EB] = MX_MFMA(pa1, MX_CAT(l1, h1), o[EB]); \
            if (tb) { s16x4 l2, h2, l3, h3; MX_RD(l2, h2, vb, EB, 2); MX_RD(l3, h3, vb, EB, 3); MX_LWAIT(); \
                o[EB] = MX_MFMA(pa2, MX_CAT(l2, h2), o[EB]); o[EB] = MX_MFMA(pa3, MX_CAT(l3, h3), o[EB]); } } while (0)
        RO_STEP(0); RO_STEP(1); RO_STEP(2); RO_STEP(3);
#undef RO_STEP
        const LAS bf16_t* gp = (const LAS bf16_t*)(lds + ci * 32768 + 16384 + (32 * tb) * 256) + r32; bf16_t* yp = Y + ((size_t)(b * SEQ + n * 64 + 32 * tb)) * DM + 1024 + hr * HD + r32;
#pragma unroll
        for (int r = 0; r < 16; ++r) { const int tr = crow(r, hi);
            float v0 = o[0][r], v1 = o[1][r], v2 = o[2][r], v3 = o[3][r];
            float ss = (v0 * v0 + v1 * v1) + (v2 * v2 + v3 * v3);
            ss += __shfl_xor(ss, 1); ss += __shfl_xor(ss, 2); ss += __shfl_xor(ss, 4); ss += __shfl_xor(ss, 8); ss += __shfl_xor(ss, 16);
            const float rs = rsqrtf(ss * (1.0f / 128.0f) + EPS);
            v0 *= rs * bf2f(gp[tr * HD]); v1 *= rs * bf2f(gp[tr * HD + 32]); v2 *= rs * bf2f(gp[tr * HD + 64]); v3 *= rs * bf2f(gp[tr * HD + 96]);
            const float n0 = __shfl_xor(v0, 1), n1 = __shfl_xor(v1, 1), n2 = __shfl_xor(v2, 1), n3 = __shfl_xor(v3, 1);
            if ((r32 & 1) == 0) { bf16_t* op = yp + (size_t)tr * DM;
                *(unsigned*)(op) = cvt_pk_bf16(v0, n0); *(unsigned*)(op + 32) = cvt_pk_bf16(v1, n1); *(unsigned*)(op + 64) = cvt_pk_bf16(v2, n2); *(unsigned*)(op + 96) = cvt_pk_bf16(v3, n3); } }
    }
}
__device__ __forceinline__ void gmlp_phase(const bf16_t* GU, const bf16_t* GV, const float* lng, const float* lnb, const float* wsp, const float* bsp, bf16_t* Y, lptr lds, int blk, int G, int tid_) {
    for (int pu = blk; pu < 256; pu += G) {
        int tid = tid_; asm volatile("" : "+v"(tid));
        const int wid = __builtin_amdgcn_readfirstlane(tid >> 6), lane = tid & 63, r32 = lane & 31, hi = lane >> 5;
        const int ui = wid >> 2, tb = wid & 3, unit = 2 * pu + ui, g = unit & 3, n = (unit >> 2) & 31, b = unit >> 7;
        const size_t ro = ((size_t)(b * GMG + g) * SEQ + n * 128) * HD;
        __syncthreads();
        {
            const int l256 = tb * 64 + lane, ch = l256 & 15, rsub = l256 >> 4;
            float gg[8], bb[8];
#pragma unroll
            for (int j = 0; j < 8; ++j) { gg[j] = lng[g * 128 + 8 * ch + j]; bb[j] = lnb[g * 128 + 8 * ch + j]; }
            bf16x8 vrow[8], urow[8];
#pragma unroll
            for (int ps = 0; ps < 8; ++ps) { vrow[ps] = load8(GV + ro + (size_t)(ps * 16 + rsub) * HD + 8 * ch); urow[ps] = load8(GU + ro + (size_t)(ps * 16 + rsub) * HD + 8 * ch); }
#pragma unroll
            for (int ps = 0; ps < 8; ++ps) *(LAS bf16x8*)(lds + 65536 + ui * 32768 + (ps * 16 + rsub) * 256 + 16 * ch) = urow[ps];
#pragma unroll
            for (int ps = 0; ps < 8; ++ps) { const int row = ps * 16 + rsub;
                float f[8]; unpack8(*reinterpret_cast<const u32x4*>(&vrow[ps]), f);
                float s = ((f[0] + f[1]) + (f[2] + f[3])) + ((f[4] + f[5]) + (f[6] + f[7]));
                s += __shfl_xor(s, 1); s += __shfl_xor(s, 2); s += __shfl_xor(s, 4); s += __shfl_xor(s, 8);
                const float mu = s * (1.0f / 128.0f); float q = 0.f;
#pragma unroll
                for (int j = 0; j < 8; ++j) { f[j] -= mu; q += f[j] * f[j]; }
                q += __shfl_xor(q, 1); q += __shfl_xor(q, 2); q += __shfl_xor(q, 4); q += __shfl_xor(q, 8);
                const float rs = rsqrtf(q * (1.0f / 128.0f) + EPS);
                u32x4 o; o.x = cvt_pk_bf16(f[0] * rs * gg[0] + bb[0], f[1] * rs * gg[1] + bb[1]); o.y = cvt_pk_bf16(f[2] * rs * gg[2] + bb[2], f[3] * rs * gg[3] + bb[3]);
                o.z = cvt_pk_bf16(f[4] * rs * gg[4] + bb[4], f[5] * rs * gg[5] + bb[5]); o.w = cvt_pk_bf16(f[6] * rs * gg[6] + bb[6], f[7] * rs * gg[7] + bb[7]);
                *(LAS u32x4*)(lds + ui * 32768 + (row >> 6) * 16384 + v_st(row & 63, 8 * ch)) = o; }
        }
        __syncthreads();
        f32x16 acc[4] = {};
        const int vb = (int)(unsigned)(uintptr_t)lds + ui * 32768 + v_rd_base(lane);
        const int t = 32 * tb + r32; const float* wrow = wsp + (size_t)g * 128 * 128 + (size_t)t * 128 + 8 * hi;
        float btv[16];
#pragma unroll
        for (int r = 0; r < 16; ++r) btv[r] = bsp[g * 128 + 32 * tb + crow(r, hi)];
        f32x4 wq[8][2];
#pragma unroll
        for (int ks = 0; ks < 8; ++ks) if (ks <= 2 * tb + 1) { wq[ks][0] = *(const f32x4*)(wrow + 16 * ks); wq[ks][1] = *(const f32x4*)(wrow + 16 * ks + 4); }
#define GM_STEP(KS) do { if ((KS) <= 2 * tb + 1) { const f32x4 w0 = wq[KS][0], w1 = wq[KS][1]; const int sb = 16 * (KS) + 8 * hi; \
            u32x4 aw; aw.x = cvt_pk_bf16(sb + 0 <= t ? w0[0] : 0.f, sb + 1 <= t ? w0[1] : 0.f); aw.y = cvt_pk_bf16(sb + 2 <= t ? w0[2] : 0.f, sb + 3 <= t ? w0[3] : 0.f); \
            aw.z = cvt_pk_bf16(sb + 4 <= t ? w1[0] : 0.f, sb + 5 <= t ? w1[1] : 0.f); aw.w = cvt_pk_bf16(sb + 6 <= t ? w1[2] : 0.f, sb + 7 <= t ? w1[3] : 0.f); \
            const bf16x8 af = *reinterpret_cast<const bf16x8*>(&aw); \
            s16x4 l0, h0, l1, h1, l2, h2, l3, h3; constexpr int TO = ((KS) >> 2) * 16384; \
            l0 = mx::trrd<TO + 0 * 512 + ((KS) & 3) * 4096>(vb); h0 = mx::trrd<TO + 0 * 512 + ((KS) & 3) * 4096 + 2048>(vb); l1 = mx::trrd<TO + 1 * 512 + ((KS) & 3) * 4096>(vb); h1 = mx::trrd<TO + 1 * 512 + ((KS) & 3) * 4096 + 2048>(vb); \
            l2 = mx::trrd<TO + 2 * 512 + ((KS) & 3) * 4096>(vb); h2 = mx::trrd<TO + 2 * 512 + ((KS) & 3) * 4096 + 2048>(vb); l3 = mx::trrd<TO + 3 * 512 + ((KS) & 3) * 4096>(vb); h3 = mx::trrd<TO + 3 * 512 + ((KS) & 3) * 4096 + 2048>(vb); \
            MX_LWAIT(); \
            acc[0] = MX_MFMA(af, MX_CAT(l0, h0), acc[0]); acc[1] = MX_MFMA(af, MX_CAT(l1, h1), acc[1]); acc[2] = MX_MFMA(af, MX_CAT(l2, h2), acc[2]); acc[3] = MX_MFMA(af, MX_CAT(l3, h3), acc[3]); } } while (0)
        GM_STEP(0); GM_STEP(1); GM_STEP(2); GM_STEP(3); GM_STEP(4); GM_STEP(5); GM_STEP(6); GM_STEP(7);
#undef GM_STEP
        const LAS bf16_t* up = (const LAS bf16_t*)(lds + 65536 + ui * 32768 + (32 * tb) * 256) + r32; bf16_t* yp = Y + ((size_t)(b * SEQ + n * 128 + 32 * tb)) * DM + 1536 + g * HD + r32;
#pragma unroll
        for (int r = 0; r < 16; ++r) { const int tr = crow(r, hi); const float bt = btv[r];
            float v0 = bf2f(up[tr * HD]) * (acc[0][r] + bt), v1 = bf2f(up[tr * HD + 32]) * (acc[1][r] + bt), v2 = bf2f(up[tr * HD + 64]) * (acc[2][r] + bt), v3 = bf2f(up[tr * HD + 96]) * (acc[3][r] + bt);
            float ss = (v0 * v0 + v1 * v1) + (v2 * v2 + v3 * v3);
            ss += __shfl_xor(ss, 1); ss += __shfl_xor(ss, 2); ss += __shfl_xor(ss, 4); ss += __shfl_xor(ss, 8); ss += __shfl_xor(ss, 16);
            const float rs = rsqrtf(ss * (1.0f / 128.0f) + EPS);
            v0 *= rs; v1 *= rs; v2 *= rs; v3 *= rs;
            const float n0 = __shfl_xor(v0, 1), n1 = __shfl_xor(v1, 1), n2 = __shfl_xor(v2, 1), n3 = __shfl_xor(v3, 1);
            if ((r32 & 1) == 0) { bf16_t* op = yp + (size_t)tr * DM;
                *(unsigned*)(op) = cvt_pk_bf16(v0, n0); *(unsigned*)(op + 32) = cvt_pk_bf16(v1, n1); *(unsigned*)(op + 64) = cvt_pk_bf16(v2, n2); *(unsigned*)(op + 96) = cvt_pk_bf16(v3, n3); } }
    }
}
__device__ __forceinline__ void fz_phase(const bf16_t* xb, const float* ssq, const bf16_t* wfz, const float* bf, float* logf, LAS float* part  , int blk, int G, int tid_) {
    int tid = tid_; asm volatile("" : "+v"(tid));
    const int wid = __builtin_amdgcn_readfirstlane(tid >> 6), lane = tid & 63, r32 = lane & 31, hi = lane >> 5;
    const int rbl = wid >> 2, kq = wid & 3;
    for (int rb2 = blk; rb2 < MROWS / 64; rb2 += G) {
        const int rb = rb2 * 2 + rbl;
        const bf16_t* ap = xb + (size_t)(32 * rb + r32) * DM + kq * 512 + 8 * hi; const bf16_t* bp = wfz + (size_t)(r32 & 7) * DM + kq * 512 + 8 * hi;
        f32x16 c = {};
#pragma unroll 8
        for (int ks = 0; ks < 32; ++ks) { const bf16x8 a = load8(ap + 16 * ks); bf16x8 bv = load8(bp + 16 * ks); if (r32 >= 8) bv = (bf16x8){0, 0, 0, 0, 0, 0, 0, 0}; c = MX_MFMA(a, bv, c); }
        if (r32 < 8) {
#pragma unroll
            for (int r = 0; r < 16; ++r) part[((rbl * 4 + kq) * 32 + crow(r, hi)) * 8 + r32] = c[r]; }
        __syncthreads();
        {
            const int row64 = tid >> 3, h = tid & 7, rl = row64 >> 5, rr = row64 & 31; const int row = 64 * rb2 + row64;
            const float d = (part[((rl * 4 + 0) * 32 + rr) * 8 + h] + part[((rl * 4 + 1) * 32 + rr) * 8 + h]) + (part[((rl * 4 + 2) * 32 + rr) * 8 + h] + part[((rl * 4 + 3) * 32 + rr) * 8 + h]);
            const f32x4 pp = *(const f32x4*)(ssq + (size_t)row * 32 + h * 4);
            float s = (pp[0] + pp[1]) + (pp[2] + pp[3]); s += __shfl_xor(s, 1); s += __shfl_xor(s, 2); s += __shfl_xor(s, 4);
            const float rs = rsqrtf(s * (1.0f / DM) + EPS);
            logf[((size_t)((row >> 12) * FOXH + h)) * SEQ + (row & 4095)] = logsig_f(d * rs + bf[h]);
        }
        __syncthreads();
    }
}
#undef MX_LWAIT
#undef MX_RD
#undef MX_CAT
#undef MX_MFMA
#undef MX_PK4
}

template <unsigned PHMASK> __global__ void __launch_bounds__(NTHREADS, 2) fwd(Args a) {
    extern __shared__ __attribute__((aligned(16))) unsigned char lds_raw[];
    LAS unsigned char* lds = (LAS unsigned char*)lds_raw;
    const int tid0 = threadIdx.x, G0 = gridDim.x, blk0 = blockIdx.x;
    unsigned char* ws0 = a.ws;
    for (int u = tid0; u < (LDS_BYTES - LDSCTL_OFF) / 4; u += NTHREADS) ((LAS unsigned*)(lds + LDSCTL_OFF))[u] = 0u;
    __syncthreads();
    XcdBarrier bar; bar.bar = (unsigned*)(ws0 + WS_CTL) + CW_BAR; bar.x = 0; bar.st = nullptr;
    if (a.use_bar) bar = xcd_barrier_post((unsigned*)(ws0 + WS_CTL) + CW_BAR, (volatile LAS unsigned*)(lds + MISC_OFF) + 8);
#define GRID_BAR() do { if (a.use_bar) xcd_barrier(bar); } while (0)
    unsigned long long spin_t0 = 0ull, spin_acc = 0ull; (void)spin_t0;
    unsigned long long clk_c = 0ull, clk_r = 0ull;
#define IN(k) (((PHMASK >> (k)) & 1u) != 0u && a.ph_lo <= (k) && (k) < a.ph_hi)
#define REP(k) for (int rep_ = (spin_t0 = (((PROBE_SPIN_MASK >> (k)) & 1u) ? __builtin_amdgcn_s_memrealtime() : 0ull), 0); rep_ < (((PROBE_MASK >> (k)) & 1u) ? 1 + PROBE_REP : 1); ++rep_, spin_acc += (((PROBE_SPIN_MASK >> (k)) & 1u) ? __builtin_amdgcn_s_memrealtime() - spin_t0 : 0ull))

#define LV(x) asm volatile("" : "+v"(x))
#define STAGGER() do { if (STAGGER_TICKS) { const unsigned long long t0_ = __builtin_amdgcn_s_memrealtime(), w_ = (unsigned long long)((blk & 3) * STAGGER_TICKS); while (__builtin_amdgcn_s_memrealtime() - t0_ < w_) __builtin_amdgcn_s_sleep(2); } } while (0)
#define LS(x) asm volatile("" : "+s"(x))
#define PH_ENTER() int tid = tid0, blk = blk0, G = G0; unsigned long long zoff_ = 0ull; LV(tid); LS(blk); LS(G); LS(zoff_); unsigned char* ws = ws0 + zoff_; \
        const int lane = tid & 63, wave = __builtin_amdgcn_readfirstlane(tid >> 6), gw = blk * NWAVES + wave, ngw = G * NWAVES; (void)lane; (void)gw; (void)ngw

    if (a.l_lo == 0 && IN(0)) REP(0) { { PH_ENTER(); prologue_wgu(a, ws, lds, blk, G, tid); } { PH_ENTER(); prologue(a, ws, lds, gw, ngw, wave, lane); GRID_BAR(); } }

    for (int l0 = a.l_lo; l0 < a.l_hi; ++l0) {
#define FFN_PAIR(f, PU, PD) do { \
        if (IN(PU)) REP(PU) { PH_ENTER(); int l = l0; LS(l); STAGGER(); const unsigned long long c0_ = PROBE_CLOCK ? (unsigned long long)__builtin_readcyclecounter() : 0ull, r0_ = PROBE_CLOCK ? __builtin_amdgcn_s_memrealtime() : 0ull; \
            pg8::Gemm g{(const bf16_t*)(ws + WS_XQ), (const bf16_t*)(ws + WS_WGU + (size_t)(l * 2 + (f)) * SZ_WGU), MROWS, NGU, DM / 2}; pg8::StaticOrder S; S.init(MROWS, NGU, G, blk); \
            { pg8::Unit u0; if (S.next(0, u0)) quant_rows((const bf16_t*)(ws + WS_XB), ws + WS_XQ, (float*)(ws + WS_QS), (const float*)(ws + WS_SSQ), (unsigned*)(ws + WS_CTL) + CW_QCNT + (l * 2 + (f)) * 64 + u0.pm, u0.pm, u0.pn & 3, (LAS float*)(lds + RSL_OFF), tid); } \
            EpiSwiGLUq E{(bf16_t*)(ws + WS_HID), (const float*)((const unsigned*)(ws + WS_CTL) + CW_CMAX) + (size_t)(l * 2 + (f)) * NGU, (LAS float*)(lds + RSL_OFF), (PROBE_NULLEPI && rep_ > 0) ? 1 : 0}; \
            if (PROBE_MMAV != 0 && rep_ > 0) pg8::gemm_phase<EpiSwiGLUq, pg8::StaticOrder, true, true, false, true, PROBE_MMAV>(lds, g, S, E, tid); \
            else pg8::gemm_phase<EpiSwiGLUq, pg8::StaticOrder, true, true, false, true>(lds, g, S, E, tid); \
            if (PROBE_CLOCK) { clk_c += (unsigned long long)__builtin_readcyclecounter() - c0_; clk_r += __builtin_amdgcn_s_memrealtime() - r0_; } \
            GRID_BAR(); \
        } \
        if (IN(PD)) REP(PD) { PH_ENTER(); int l = l0; LS(l); \
            pg8::Gemm g{(const bf16_t*)(ws + WS_HID), (const bf16_t*)(ws + WS_WD + (size_t)(l * 2 + (f)) * SZ_WD), MROWS, DM, DFF}; pg8::StaticOrder S; S.init(MROWS, DM, G, blk); \
            EpiResid E{(l == 0 && (f) == 0 && rep_ == 0) ? a.in[0] : (const float*)nullptr, (bf16_t*)(ws + WS_XB), (float*)(ws + WS_SSQ), rep_ == 0 ? 0.5f : 0.f, (PROBE_NULLEPI && rep_ > 0) ? 1 : 0}; \
            pg8::gemm_phase<EpiResid, pg8::StaticOrder, true, true, true>(lds, g, S, E, tid); \
            GRID_BAR(); \
        } } while (0)
        FFN_PAIR(0, 1, 2);
        if (IN(3)) REP(3) { PH_ENTER(); int l = l0; LS(l); STAGGER();
            pg8::Gemm g{(const bf16_t*)(ws + WS_XB), (const bf16_t*)(ws + WS_WIN + (size_t)l * SZ_WIN), MROWS, NWIN, DM}; pg8::StaticOrder S; S.init(MROWS, NWIN, G, blk);
            const float* ropec = (const float*)(ws + WS_ROPE);
            EpiWin E{(const float*)(ws + WS_SSQ), (LAS float*)(lds + RSL_OFF), ropec, ropec + SEQ * 64, (bf16_t*)(ws + WS_FQ), (bf16_t*)(ws + WS_RQ), -1, (float*)(ws + WS_NORM)};
            pg8::gemm_phase<EpiWin, pg8::StaticOrder, true, true>(lds, g, S, E, tid);
            if (NAIVE_MASK & 1) fz_phase((const bf16_t*)(ws + WS_XB), (const float*)(ws + WS_SSQ), (const float*)(ws + WS_WFZ) + (size_t)l * 8 * DM, a.in[7] + l * 8, (float*)(ws + WS_LOGF), blk, G, tid);
            else mx::fz_phase((const bf16_t*)(ws + WS_XB), (const float*)(ws + WS_SSQ), (const bf16_t*)(ws + WS_WFZ) + (size_t)l * 8 * DM, a.in[7] + l * 8, (float*)(ws + WS_LOGF), (LAS float*)lds, blk, G, tid);
            GRID_BAR();
        }
        if (IN(4)) REP(4) { PH_ENTER(); int l = l0; LS(l);
            float* logf = (float*)(ws + WS_LOGF); float* cum = (float*)(ws + WS_CUM); float* rkv = (float*)(ws + WS_RKV);
            bf16_t *RK = (bf16_t*)(ws + WS_RK), *RV = (bf16_t*)(ws + WS_RV), *GU = (bf16_t*)(ws + WS_GU), *GV = (bf16_t*)(ws + WS_GV), *Y = (bf16_t*)(ws + WS_Y);
            for (int bh = blk; bh < NB * FOXH; bh += G) cumsum_unit(logf + (size_t)bh * SEQ, cum + (size_t)bh * SEQ, (LAS float*)lds, tid);
            if (NAIVE_MASK & 2) { for (int un = blk; un < 16 * 64; un += G) { const int bhr = un >> 6, n = un & 63; const size_t ro = ((size_t)bhr * SEQ + n * 64) * HD;
                retkv_unit(RK + ro, RV + ro, rkv + (size_t)un * 128 * 128, ret_log2g(bhr & 3), (LAS float*)lds, tid); } }
            else mx::retkv_phase(RK, RV, (bf16_t*)rkv, (mx::lptr)lds, blk, G, tid);
            if (NAIVE_MASK & 4) { for (int un = blk; un < NB * 32 * GMG; un += G) { const int g = un & 3, n = (un >> 2) & 31, b = un >> 7; const size_t ro = ((size_t)(b * GMG + g) * SEQ + n * 128) * HD;
                gmlp_unit(GU + ro, GV + ro, a.in[8] + l * 512 + g * 128, a.in[9] + l * 512 + g * 128, a.in[10] + ((size_t)l * 4 + g) * 128 * 128, a.in[11] + (l * 4 + g) * 128,
                          Y + ((size_t)(b * SEQ + n * 128)) * DM + 1536 + g * 128, (LAS float*)lds, tid); } }
            else mx::gmlp_phase(GU, GV, a.in[8] + l * 512, a.in[9] + l * 512, a.in[10] + (size_t)l * 4 * 128 * 128, a.in[11] + l * 4 * 128, Y, (mx::lptr)lds, blk, G, tid);
            GRID_BAR();
        }
        if (IN(5)) REP(5) { PH_ENTER();
            float* rkv = (float*)(ws + WS_RKV); float* rsp = (float*)(ws + WS_RSP);
            if (NAIVE_MASK & 2) { for (int i = blk * NTHREADS + tid; i < 16 * 128 * 128; i += G * NTHREADS) { const int bhr = i >> 14, de = i & 16383;
                const float cd = exp2f(64.0f * ret_log2g(bhr & 3)); float st = 0.f;
                for (int n = 0; n < 64; ++n) { const size_t o = ((size_t)(bhr * 64 + n) << 14) + de; rsp[o] = st; st = st * cd + rkv[o]; } } }
            else mx::retscan_phase((const bf16_t*)rkv, (bf16_t*)rsp, blk, G, tid);
            GRID_BAR();
        }
        if (IN(6)) REP(6) {
            { PH_ENTER();
              bf16_t *RQ = (bf16_t*)(ws + WS_RQ), *RK = (bf16_t*)(ws + WS_RK), *RV = (bf16_t*)(ws + WS_RV), *RG = (bf16_t*)(ws + WS_RG), *Y = (bf16_t*)(ws + WS_Y);
              float* rsp = (float*)(ws + WS_RSP);
              if (NAIVE_MASK & 2) { for (int un = blk; un < 16 * 64; un += G) { const int bhr = un >> 6, n = un & 63, b = bhr >> 2, hr = bhr & 3; const size_t ro = ((size_t)bhr * SEQ + n * 64) * HD;
                  retout_unit(RQ + ro, RK + ro, RV + ro, RG + ro, rsp + (size_t)un * 128 * 128, Y + ((size_t)(b * SEQ + n * 64)) * DM + 1024 + hr * 128, ret_log2g(hr), (LAS float*)lds, tid); } }
              else mx::retout_phase(RQ, RK, RV, RG, (const bf16_t*)rsp, Y, (mx::lptr)lds, blk, G, tid); }
            { PH_ENTER(); int l = l0; LS(l);
              fa::attn_phase((const bf16_t*)(ws + WS_FQ), (const bf16_t*)(ws + WS_FK), (const bf16_t*)(ws + WS_FV), (const float*)(ws + WS_CUM), (const float*)(ws + WS_NORM), (bf16_t*)(ws + WS_Y),
                             (unsigned*)(ws + WS_CTL) + CW_QUEUE + 64 * (2 * l + (rep_ & 1)), (unsigned*)(ws + WS_CTL) + CW_FLAGS + (size_t)l * 1024, (float*)(ws + WS_PART), (fa::lptr)lds, tid); }
            GRID_BAR();
        }
        if (IN(7)) REP(7) { PH_ENTER(); int l = l0; LS(l);
            pg8::Gemm g{(const bf16_t*)(ws + WS_Y), (const bf16_t*)(ws + WS_WOUT + (size_t)l * SZ_WOUT), MROWS, DM, DM}; pg8::StaticOrder S; S.init(MROWS, DM, G, blk);
            EpiResid E{(const float*)nullptr, (bf16_t*)(ws + WS_XB), (float*)(ws + WS_SSQ), rep_ == 0 ? 1.0f : 0.f, (PROBE_NULLEPI && rep_ > 0) ? 1 : 0};
            pg8::gemm_phase<EpiResid, pg8::StaticOrder, true, true>(lds, g, S, E, tid);
            GRID_BAR();
        }
        FFN_PAIR(1, 8, 9);
#undef FFN_PAIR
    }
    if (a.l_hi == DEPTH && IN(10)) REP(10) { PH_ENTER();
        const float* fn = a.in[18]; const float* ssq = (const float*)(ws + WS_SSQ);
        f32x4 gn[8];
#pragma unroll
        for (int j = 0; j < 4; ++j) { gn[2 * j] = ((const f32x4*)fn)[(j * 64 + lane) * 2]; gn[2 * j + 1] = ((const f32x4*)fn)[(j * 64 + lane) * 2 + 1]; }
        for (int m = gw; m < MROWS; m += 2 * ngw) {
            const int m2 = m + ngw; const bool has2 = m2 < MROWS; const int mb = has2 ? m2 : m;
            float s0 = lane < 32 ? ssq[(size_t)m * 32 + lane] : 0.f, s1 = lane < 32 ? ssq[(size_t)mb * 32 + lane] : 0.f;
            const u32x4* xa = (const u32x4*)((const bf16_t*)(ws + WS_XB) + (size_t)m * DM); const u32x4* xc = (const u32x4*)((const bf16_t*)(ws + WS_XB) + (size_t)mb * DM);
            u32x4 ra[4], rc[4];
#pragma unroll
            for (int j = 0; j < 4; ++j) { ra[j] = xa[j * 64 + lane]; rc[j] = xc[j * 64 + lane]; }
            s0 = wave_sum(s0); s1 = wave_sum(s1);
            const float rs0 = rsqrtf(s0 * (1.0f / DM) + EPS), rs1 = rsqrtf(s1 * (1.0f / DM) + EPS);
            f32x4* xr0 = (f32x4*)(a.out + (size_t)m * DM); f32x4* xr1 = (f32x4*)(a.out + (size_t)mb * DM);
#pragma unroll
            for (int j = 0; j < 4; ++j) { float f[8]; unpack8(ra[j], f);
                xr0[(j * 64 + lane) * 2] = (f32x4){f[0], f[1], f[2], f[3]} * rs0 * gn[2 * j]; xr0[(j * 64 + lane) * 2 + 1] = (f32x4){f[4], f[5], f[6], f[7]} * rs0 * gn[2 * j + 1]; }
            if (has2) {
#pragma unroll
                for (int j = 0; j < 4; ++j) { float f[8]; unpack8(rc[j], f);
                    xr1[(j * 64 + lane) * 2] = (f32x4){f[0], f[1], f[2], f[3]} * rs1 * gn[2 * j]; xr1[(j * 64 + lane) * 2 + 1] = (f32x4){f[4], f[5], f[6], f[7]} * rs1 * gn[2 * j + 1]; } }
        }
    }
    if (PROBE_CLOCK && blk0 == 0 && tid0 == 0) { const unsigned long long ticks = clk_r ? (clk_c * 10000ull) / clk_r : 0ull;
        const unsigned long long te = __builtin_amdgcn_s_memrealtime(); while (__builtin_amdgcn_s_memrealtime() - te < ticks) __builtin_amdgcn_s_sleep(8); }
    if (PROBE_TILES) { GRID_BAR(); if (blk0 == 0 && tid0 == 0) { unsigned long long tot = 0; for (int l = 0; l < DEPTH; ++l) tot += __hip_atomic_load((unsigned*)(ws0 + WS_CTL) + CW_QUEUE + 64 * (2 * l) + 32, __ATOMIC_RELAXED, __HIP_MEMORY_SCOPE_AGENT);
        const unsigned long long te = __builtin_amdgcn_s_memrealtime(); while (__builtin_amdgcn_s_memrealtime() - te < tot * 10ull) __builtin_amdgcn_s_sleep(8); } }
    if (PROBE_SPIN_MASK != 0u && blk0 == 0 && tid0 == 0) { const unsigned long long te = __builtin_amdgcn_s_memrealtime(); while (__builtin_amdgcn_s_memrealtime() - te < (unsigned long long)PROBE_SPIN_AMP * spin_acc) __builtin_amdgcn_s_sleep(8); }
#undef PH_ENTER
#undef LV
#undef LS
#undef IN
#undef GRID_BAR
}

extern "C" void kernel_launch(void* const* d_in, const int* in_sizes, int n_in, void* d_out, int out_size, void* d_ws, size_t ws_size, hipStream_t stream) {
    static int grid = 0;
    if (grid == 0) {
        if (n_in != 19 || in_sizes[0] != MROWS * DM || out_size != MROWS * DM || ws_size < WS_END) { fprintf(stderr, "kernel_launch: unexpected shapes (n_in %d, in0 %d, out %d, ws %zu < %zu)\n", n_in, n_in > 0 ? in_sizes[0] : -1, out_size, ws_size, (size_t)WS_END); grid = -1; return; }
        int dev = 0, cus = 0;
        if (hipGetDevice(&dev) != hipSuccess || hipDeviceGetAttribute(&cus, hipDeviceAttributeMultiprocessorCount, dev) != hipSuccess) { grid = -1; return; }
#define SETATTR(K) do { if (hipFuncSetAttribute((const void*)(K), hipFuncAttributeMaxDynamicSharedMemorySize, LDS_BYTES) != hipSuccess) { fprintf(stderr, "kernel_launch: hipFuncSetAttribute failed\n"); grid = -1; return; } } while (0)
#if MK_SPLIT
        SETATTR(fwd<1u << 0>); SETATTR(fwd<1u << 1>); SETATTR(fwd<1u << 2>); SETATTR(fwd<1u << 3>); SETATTR(fwd<1u << 4>); SETATTR(fwd<1u << 5>);
        SETATTR(fwd<1u << 6>); SETATTR(fwd<1u << 7>); SETATTR(fwd<1u << 8>); SETATTR(fwd<1u << 9>); SETATTR(fwd<1u << 10>);
#else
        SETATTR(fwd<0x7ffu>);
        int per_cu = 0;
        if (hipOccupancyMaxActiveBlocksPerMultiprocessor(&per_cu, (const void*)fwd<0x7ffu>, NTHREADS, LDS_BYTES) != hipSuccess || per_cu < 1) fprintf(stderr, "kernel_launch: occupancy query reports %d\n", per_cu);
        (void)hipGetLastError();
#endif
        grid = cus;
    }
    if (grid < 0) return;
    (void)hipMemsetAsync((char*)d_ws + WS_CTL, 0, CTL_ZERO_BYTES, stream);
    Args a{};
    for (int i = 0; i < 19; ++i) a.in[i] = (const float*)d_in[i];
    a.out = (float*)d_out; a.ws = (unsigned char*)d_ws; a.pad = 0;
#if MK_SPLIT
    a.use_bar = 0;
#define LAUNCH1(PH, LL, LH) do { Args p = a; p.l_lo = (LL); p.l_hi = (LH); p.ph_lo = (PH); p.ph_hi = (PH) + 1; hipLaunchKernelGGL(fwd<(1u << (PH))>, dim3(grid), dim3(NTHREADS), LDS_BYTES, stream, p); } while (0)
    LAUNCH1(0, 0, 0);
    for (int l = 0; l < DEPTH; ++l) { LAUNCH1(1, l, l + 1); LAUNCH1(2, l, l + 1); LAUNCH1(3, l, l + 1); LAUNCH1(4, l, l + 1); LAUNCH1(5, l, l + 1); LAUNCH1(6, l, l + 1); LAUNCH1(7, l, l + 1); LAUNCH1(8, l, l + 1); LAUNCH1(9, l, l + 1); }
    LAUNCH1(10, DEPTH, DEPTH);
#else
    a.use_bar = 1; a.l_lo = 0; a.l_hi = DEPTH; a.ph_lo = 0; a.ph_hi = 11;
    hipLaunchKernelGGL(fwd<0x7ffu>, dim3(grid), dim3(NTHREADS), LDS_BYTES, stream, a);
#endif
}
```
